# Optimizing an MI355X kernel written in HIP

```python
import math
import jax, jax.numpy as jnp
from jax import lax
import numpy as np

D_MODEL = 1024
BATCH = 16
SEQ = 4096
DEPTH = 1

CHUNK = 64
Q_BLOCK = 128
EPS = 1e-6
M_HEADS = 4
M_DK = 128
M_DV = 256
M_QK = M_HEADS * M_DK
M_V = M_HEADS * M_DV
CONV_W = 4
D_HEADS = 8
D_DH = 64
D_QK = D_HEADS * 2 * D_DH
D_V = D_HEADS * 2 * D_DH
X_HEADS = 4
X_DH = D_MODEL // X_HEADS
N_MEM = 256
N_EXPERTS = 32
TOP_K = 4
D_FF = D_MODEL
SWIGLU_LIMIT = 7.0
SWIGLU_ALPHA = 1.702
N_BRANCHES = 2
IN_SIZES = [M_QK, M_QK, M_V, M_V, 2 * M_HEADS, D_QK, D_QK, D_V, N_BRANCHES * D_MODEL]
N_IN = sum(IN_SIZES)
IN_SPLITS = np.cumsum(IN_SIZES[:-1]).tolist()

kernel_name = "hybrid_mlstm_diffattn_moe_stream_block"


def rmsnorm(x, g):
    xf = x.astype(jnp.float32)
    y = xf * lax.rsqrt(jnp.mean(xf * xf, axis=-1, keepdims=True) + EPS)
    return (y * g.astype(jnp.float32)).astype(x.dtype)


def causal_conv(x, w):
    S = x.shape[1]
    xp = jnp.pad(x, ((0, 0), (CONV_W - 1, 0), (0, 0)))
    return sum(w[j] * xp[:, j:j + S] for j in range(CONV_W))


def mlstm_chunkwise(q, k, v, i_pre, f_pre):
    B, S, H, DK = q.shape
    DV = v.shape[-1]
    NC, L = S // CHUNK, CHUNK
    f32 = jnp.float32
    q = q.astype(f32) * (DK ** -0.5)
    qc = q.reshape(B, NC, L, H, DK).transpose(1, 0, 3, 2, 4)
    kc = k.astype(f32).reshape(B, NC, L, H, DK).transpose(1, 0, 3, 2, 4)
    vc = v.astype(f32).reshape(B, NC, L, H, DV).transpose(1, 0, 3, 2, 4)
    fc = jax.nn.log_sigmoid(f_pre.astype(f32)).reshape(B, NC, L, H).transpose(1, 0, 3, 2)
    ic = i_pre.astype(f32).reshape(B, NC, L, H).transpose(1, 0, 3, 2)
    causal = jnp.tril(jnp.ones((L, L), dtype=bool))

    def step(carry, inp):
        C, n, m = carry
        qb, kb, vb, fb, ib = inp
        b = jnp.cumsum(fb, axis=-1)
        b_last = b[..., -1]
        dm = jnp.where(causal, b[..., :, None] - b[..., None, :] + ib[..., None, :], -jnp.inf)
        inter = b + m[..., None]
        m_t = jnp.maximum(inter, jnp.max(dm, axis=-1))
        w_inter = jnp.exp(inter - m_t)
        s = jnp.einsum('bhtd,bhsd->bhts', qb, kb) * jnp.exp(dm - m_t[..., None])
        num = jnp.einsum('bhts,bhsv->bhtv', s, vb) + w_inter[..., None] * jnp.einsum('bhvd,bhtd->bhtv', C, qb)
        den = jnp.sum(s, axis=-1) + w_inter * jnp.einsum('bhd,bhtd->bht', n, qb)
        h = num / jnp.maximum(jnp.abs(den), jnp.exp(-m_t))[..., None]
        g = b_last[..., None] - b + ib
        m_new = jnp.maximum(b_last + m, jnp.max(g, axis=-1))
        wk = jnp.exp(g - m_new[..., None])
        decay = jnp.exp(b_last + m - m_new)
        C_new = decay[..., None, None] * C + jnp.einsum('bhs,bhsv,bhsd->bhvd', wk, vb, kb)
        n_new = decay[..., None] * n + jnp.einsum('bhs,bhsd->bhd', wk, kb)
        return (C_new, n_new, m_new), h

    init = (jnp.zeros((B, H, DV, DK), f32), jnp.zeros((B, H, DK), f32), jnp.zeros((B, H), f32))
    _, hs = lax.scan(step, init, (qc, kc, vc, fc, ic))
    return hs.transpose(1, 0, 3, 2, 4).reshape(B, S, H, DV).astype(v.dtype)


def diff_attention(q, k, v, lam, gain, lam_init):
    B, S, H = q.shape[:3]
    nb = S // Q_BLOCK
    q = q * (D_DH ** -0.5)
    k_chunk = jnp.arange(S) // CHUNK
    qb = q.reshape(B, nb, Q_BLOCK, H, 2, D_DH).transpose(1, 0, 2, 3, 4, 5)

    def block(args):
        qblk, idx = args
        q_chunk = (idx * Q_BLOCK + jnp.arange(Q_BLOCK)) // CHUNK
        mask = k_chunk[None, :] <= q_chunk[:, None]
        s = jnp.einsum('bqhcd,bkhcd->bhcqk', qblk, k).astype(jnp.float32)
        p = jax.nn.softmax(jnp.where(mask, s, -jnp.inf), axis=-1)
        a = p[:, :, 0] - lam * p[:, :, 1]
        return jnp.einsum('bhqk,bkhv->bqhv', a.astype(v.dtype), v)

    out = lax.map(block, (qb, jnp.arange(nb)))
    out = out.transpose(1, 0, 2, 3, 4).reshape(B, S, H, 2 * D_DH)
    return rmsnorm(out, gain) * (1.0 - lam_init)


def hybrid_mixer(h, w_in, conv_w, b_if, m_gain, lam_p, d_gain, w_bm, w_bd, b_gate, w_out, lam_init):
    B, S, _ = h.shape
    z = h @ w_in
    qm, km, vm, om, ifm, qd, kd, vd, gates = jnp.split(z, IN_SPLITS, axis=-1)
    qk = jax.nn.silu(causal_conv(jnp.concatenate([qm, km], axis=-1), conv_w))
    qm, km = qk[..., :M_QK], qk[..., M_QK:]
    hm = mlstm_chunkwise(qm.reshape(B, S, M_HEADS, M_DK), km.reshape(B, S, M_HEADS, M_DK),
                         vm.reshape(B, S, M_HEADS, M_DV),
                         ifm[..., :M_HEADS] + b_if[:M_HEADS], ifm[..., M_HEADS:] + b_if[M_HEADS:])
    hm = jax.nn.sigmoid(om) * rmsnorm(hm, m_gain).reshape(B, S, M_V)
    branch_m = hm @ w_bm
    lp = lam_p.astype(jnp.float32)
    lam = jnp.exp(jnp.sum(lp[0] * lp[1])) - jnp.exp(jnp.sum(lp[2] * lp[3])) + lam_init
    hd = diff_attention(qd.reshape(B, S, D_HEADS, 2, D_DH), kd.reshape(B, S, D_HEADS, 2, D_DH),
                        vd.reshape(B, S, D_HEADS, 2 * D_DH), lam, d_gain, lam_init)
    branch_d = hd.reshape(B, S, D_V) @ w_bd
    g = jax.nn.sigmoid(gates + b_gate)
    return (g[..., :D_MODEL] * branch_m + g[..., D_MODEL:] * branch_d) @ w_out


def cross_attention(h, memn, wq, wkv, wo):
    B, S, _ = h.shape
    M = memn.shape[1]
    q = (h @ wq).reshape(B, S, X_HEADS, X_DH) * (X_DH ** -0.5)
    kv = memn @ wkv
    k = kv[..., :D_MODEL].reshape(B, M, X_HEADS, X_DH)
    v = kv[..., D_MODEL:].reshape(B, M, X_HEADS, X_DH)
    p = jax.nn.softmax(jnp.einsum('bshd,bmhd->bhsm', q, k).astype(jnp.float32), axis=-1)
    o = jnp.einsum('bhsm,bmhd->bshd', p.astype(v.dtype), v).reshape(B, S, D_MODEL)
    return o @ wo


def moe(h, w_r, b_r, w_gu, b_gu, w_dn, b_dn):
    B, S, D = h.shape
    t = h.reshape(B * S, D)
    logits = (t @ w_r + b_r).astype(jnp.float32)
    top_v, top_i = lax.top_k(logits, TOP_K)
    top_w = jax.nn.softmax(top_v, axis=-1)
    combine = jnp.sum(jax.nn.one_hot(top_i, N_EXPERTS, dtype=jnp.float32) * top_w[..., None], axis=1)

    def expert(acc, p):
        wgu, bgu, wdn, bdn, c = p
        gu = t @ wgu + bgu
        gate = jnp.minimum(gu[:, :D_FF], SWIGLU_LIMIT)
        up = jnp.clip(gu[:, D_FF:], -SWIGLU_LIMIT, SWIGLU_LIMIT)
        y = ((up + 1.0) * (gate * jax.nn.sigmoid(SWIGLU_ALPHA * gate))) @ wdn + bdn
        return acc + c[:, None] * y, None

    acc, _ = lax.scan(expert, jnp.zeros_like(t), (w_gu, b_gu, w_dn, b_dn, combine.T.astype(t.dtype)))
    return acc.reshape(B, S, D)


def setup_inputs(seed: int = 0) -> dict:
    key = jax.random.key(seed)
    ks = jax.random.split(key, 32)
    f32 = jnp.float32
    D, E, L = D_MODEL, N_EXPERTS, DEPTH

    def nrm(k, shape, scale):
        return jax.random.normal(k, shape, f32) * scale

    def gain(k, shape):
        return 1.0 + nrm(k, shape, 0.02)

    f_bias = jnp.broadcast_to(jnp.linspace(3.0, 6.0, M_HEADS, dtype=f32), (L, M_HEADS))
    b_if = jnp.concatenate([nrm(ks[3], (L, M_HEADS), 0.1), f_bias + nrm(ks[4], (L, M_HEADS), 0.1)], axis=-1)
    return {
        "x": nrm(ks[0], (BATCH, SEQ, D), 1.0),
        "mem": nrm(ks[1], (BATCH, N_MEM, D), 1.0),
        "norm_mix": gain(ks[2], (L, D)),
        "w_in": nrm(ks[5], (L, D, N_IN), D ** -0.5),
        "conv_w": nrm(ks[6], (L, CONV_W, 2 * M_QK), CONV_W ** -0.5),
        "b_if": b_if,
        "mlstm_gain": gain(ks[7], (L, M_HEADS, M_DV)),
        "diff_lambda": nrm(ks[8], (L, 4, D_DH), 0.1),
        "diff_gain": gain(ks[9], (L, 2 * D_DH)),
        "w_branch_m": nrm(ks[10], (L, M_V, D), M_V ** -0.5),
        "w_branch_d": nrm(ks[11], (L, D_V, D), D_V ** -0.5),
        "b_gate": nrm(ks[12], (L, N_BRANCHES * D), 0.1),
        "w_out": nrm(ks[13], (L, D, D), D ** -0.5),
        "norm_xattn": gain(ks[14], (L, D)),
        "norm_mem": gain(ks[15], (L, D)),
        "wq_x": nrm(ks[16], (L, D, D), D ** -0.5),
        "wkv_x": nrm(ks[17], (L, D, 2 * D), D ** -0.5),
        "wo_x": nrm(ks[18], (L, D, D), D ** -0.5),
        "norm_ffn": gain(ks[19], (L, D)),
        "w_router": nrm(ks[20], (L, D, E), D ** -0.5),
        "b_router": nrm(ks[21], (L, E), 0.01),
        "w_gu": nrm(ks[22], (L, E, D, 2 * D_FF), D ** -0.5),
        "b_gu": nrm(ks[23], (L, E, 2 * D_FF), 0.02),
        "w_dn": nrm(ks[24], (L, E, D_FF, D), D_FF ** -0.5),
        "b_dn": nrm(ks[25], (L, E, D), 0.02),
        "norm_final": gain(ks[26], (D,)),
    }


def reference(x, mem, norm_mix, w_in, conv_w, b_if, mlstm_gain, diff_lambda, diff_gain,
              w_branch_m, w_branch_d, b_gate, w_out, norm_xattn, norm_mem, wq_x, wkv_x, wo_x,
              norm_ffn, w_router, b_router, w_gu, b_gu, w_dn, b_dn, norm_final):
    for l in range(DEPTH):
        lam_init = 0.8 - 0.6 * math.exp(-0.3 * l)
        x = x + hybrid_mixer(rmsnorm(x, norm_mix[l]), w_in[l], conv_w[l], b_if[l], mlstm_gain[l],
                             diff_lambda[l], diff_gain[l], w_branch_m[l], w_branch_d[l], b_gate[l],
                             w_out[l], lam_init)
        x = x + cross_attention(rmsnorm(x, norm_xattn[l]), rmsnorm(mem, norm_mem[l]),
                                wq_x[l], wkv_x[l], wo_x[l])
        x = x + moe(rmsnorm(x, norm_ffn[l]), w_router[l], b_router[l], w_gu[l], b_gu[l],
                    w_dn[l], b_dn[l])
    return rmsnorm(x, norm_final)
```

```cpp
#include <hip/hip_runtime.h>
#include <cstdio>
#include <cstdint>
#include <cmath>
namespace pg8 {
#define PG8_LAS __attribute__((address_space(3)))
typedef unsigned short bf16_t;
typedef short bf16x8 __attribute__((ext_vector_type(8)));
typedef float f32x4 __attribute__((ext_vector_type(4)));
typedef float f32x2 __attribute__((ext_vector_type(2)));
typedef unsigned u32x4 __attribute__((ext_vector_type(4)));
typedef unsigned u32x2 __attribute__((ext_vector_type(2)));
constexpr int BM = 256, BK = 64, HALF = 128, HTB = HALF * BK * 2  , STAGE_BYTES = 8 * HTB, NXCD = 8, WGM = 8;

__host__ __device__ __forceinline__ int lds_byte(int r, int c) { const int st = (r >> 4) * 2 + (c >> 5), rr = r & 15, cc = c & 31, ob = rr * 64 + cc * 2; return st * 1024 + (ob ^ (((ob >> 9) & 1) << 5)); }
__host__ __device__ __forceinline__ void stage_rc(int b, int& R, int& C) { const int st = b / 1024, sb = b % 1024, swz = sb ^ (((sb >> 9) & 1) << 5); R = (st >> 1) * 16 + swz / 64; C = (st & 1) * 32 + (swz % 64) / 2; }
__host__ __device__ __forceinline__ int perm32(int rho) { const int n = rho >> 4, i = rho & 15; return 8 * (i >> 2) + 4 * n + (i & 3); }

struct Unit { int pm, pn; };

struct StaticOrder {
    int nM, nN, nwg, G, c;
    __device__ __forceinline__ void init_tiles(int nM_, int nN_, int G_, int c_) { nM = nM_; nN = nN_; nwg = nM * nN; G = G_; c = c_; }
    __device__ __forceinline__ bool next(int i, Unit& u) const {
        const long L = (long)i * G + c; if (L >= nwg) return false;
        int wgid = (int)L; { const int q = nwg / NXCD, r = nwg % NXCD, xcd = wgid % NXCD, off = wgid / NXCD; wgid = (xcd < r ? xcd * (q + 1) : r * (q + 1) + (xcd - r) * q) + off; }
        const int nig = WGM * nN, gid = wgid / nig, fm = gid * WGM, gsz = (nM - fm) < WGM ? (nM - fm) : WGM;
        u.pm = fm + ((wgid % nig) % gsz); u.pn = (wgid % nig) / gsz; return true;
    }
    __device__ __forceinline__ void a_ready(const Unit&) const {}
    __device__ __forceinline__ void done(const Unit&) const {}
};

__device__ __forceinline__ unsigned cvt_pk_bf16(float lo, float hi) { unsigned r; asm volatile("v_cvt_pk_bf16_f32 %0, %1, %2" : "=v"(r) : "v"(lo), "v"(hi)); return r; }
__device__ __forceinline__ float bf_lo(unsigned w) { return __uint_as_float(w << 16); }
__device__ __forceinline__ float bf_hi(unsigned w) { return __uint_as_float(w & 0xffff0000u); }
__device__ __forceinline__ float sigmoidf_(float v) { return __builtin_amdgcn_rcpf(1.0f + __builtin_amdgcn_exp2f(-1.4426950408889634f * v)); }


template <class Epi, class Sched, class Ops, bool ALIGN_EPI>
__device__ __forceinline__ void gemm_phase(PG8_LAS unsigned char* lds, const Ops& O, const int K, const Sched& S, const Epi& E) {
    int tid_ = threadIdx.x; asm volatile("" : "+v"(tid_));
    const int tid = tid_, wid = __builtin_amdgcn_readfirstlane(tid >> 6), lane = tid & 63, wr = wid >> 2, wc = wid & 3, fr = lane & 15, fq = lane >> 4;
    int nt_ = K / BK; asm volatile("" : "+s"(nt_)); const int nt = nt_;
    const unsigned lda2 = O.lda2, ldb2 = O.ldb2;
    unsigned voffA[2], voffB[2]; int RA[2], CA2[2];
#pragma unroll
    for (int i = 0; i < 2; ++i) { int R, C; stage_rc(tid * 16 + i * 8192, R, C); const int Rb = Epi::PERM ? ((R & ~31) + perm32(R & 31)) : R;
        RA[i] = R; CA2[i] = C * 2; voffA[i] = (unsigned)R * lda2 + (unsigned)C * 2u; voffB[i] = (unsigned)Rb * ldb2 + (unsigned)C * 2u; }
    const size_t kstep = (size_t)(BK * 2);
    const size_t hstepA = Ops::GATHER ? 0 : (size_t)HALF * lda2, hstepB = (size_t)HALF * ldb2;
    const unsigned ldsw = (unsigned)wid * 1024u;
    const int aoff = lds_byte(wr * 64 + fr, fq * 8), boff = lds_byte(wc * 32 + fr, fq * 8);
    unsigned voC[2][2], voN[2][2];
#define PG8_SA(b, h) (((b) * 2 + (h)) * HTB)
#define PG8_SB(b, h) ((4 + (b) * 2 + (h)) * HTB)
#define PG8_STAGE_B(bufoff, kptr, h) do { _Pragma("unroll") for (int _i = 0; _i < 2; ++_i) \
        __builtin_amdgcn_global_load_lds((const unsigned*)((kptr) + (h) * hstepB + voffB[_i]), (PG8_LAS unsigned*)(lds + (bufoff) + ldsw + _i * 8192), 16, 0, 0); } while (0)
#define PG8_STAGE_A(bufoff, kptr, h) do { _Pragma("unroll") for (int _i = 0; _i < 2; ++_i) \
        __builtin_amdgcn_global_load_lds((const unsigned*)((kptr) + (h) * hstepA + (Ops::GATHER ? voC[h][_i] : voffA[_i])), (PG8_LAS unsigned*)(lds + (bufoff) + ldsw + _i * 8192), 16, 0, 0); } while (0)
#define PG8_LDA(dst, b, h) do { _Pragma("unroll") for (int m = 0; m < 4; ++m) _Pragma("unroll") for (int k = 0; k < 2; ++k) dst[m][k] = *(const PG8_LAS bf16x8*)(lds + PG8_SA(b, h) + aoff + m * 2048 + k * 1024); } while (0)
#define PG8_LDB(dst, b, h) do { _Pragma("unroll") for (int n = 0; n < 2; ++n) _Pragma("unroll") for (int k = 0; k < 2; ++k) dst[n][k] = *(const PG8_LAS bf16x8*)(lds + PG8_SB(b, h) + boff + n * 2048 + k * 1024); } while (0)
#define PG8_MMA(ai, bj, At, Bt) do { __builtin_amdgcn_s_setprio(1); _Pragma("unroll") for (int m = 0; m < 4; ++m) _Pragma("unroll") for (int n = 0; n < 2; ++n) _Pragma("unroll") for (int k = 0; k < 2; ++k) \
        acc[ai][bj][m][n] = __builtin_amdgcn_mfma_f32_16x16x32_bf16(Bt[n][k], At[m][k], acc[ai][bj][m][n], 0, 0, 0); __builtin_amdgcn_s_setprio(0); } while (0)
#define PG8_WAIT_V(n) asm volatile("s_waitcnt vmcnt(" #n ")" ::: "memory")
#define PG8_WAIT_L(n) asm volatile("s_waitcnt lgkmcnt(" #n ")" ::: "memory")
#define PG8_BAR __builtin_amdgcn_s_barrier()
#define PG8_SCHED __builtin_amdgcn_sched_barrier(0)
#define PG8_GLOAD(vo, u) do { if constexpr (Ops::GATHER) { _Pragma("unroll") for (int _h = 0; _h < 2; ++_h) _Pragma("unroll") for (int _i = 0; _i < 2; ++_i) vo[_h][_i] = O.grow(u, _h * HALF + RA[_i]) + (unsigned)CA2[_i]; } } while (0)
    Unit cur, nxt; int ui = 0;
    if (!S.next(0, cur)) return;
    f32x4 acc[2][2][4][2];
#pragma unroll
    for (int a = 0; a < 2; ++a)
#pragma unroll
        for (int b = 0; b < 2; ++b)
#pragma unroll
            for (int m = 0; m < 4; ++m)
#pragma unroll
                for (int n = 0; n < 2; ++n) acc[a][b][m][n] = (f32x4){0.f, 0.f, 0.f, 0.f};
    bf16x8 At[4][2], B0[2][2], B1[2][2];
    const char* cA = O.a_tile(cur); const char* cB = O.b_tile(cur);
    PG8_GLOAD(voC, cur);
    S.a_ready(cur);
    PG8_STAGE_B(PG8_SB(0, 0), cB, 0); PG8_STAGE_B(PG8_SB(0, 1), cB, 1); PG8_STAGE_A(PG8_SA(0, 0), cA, 0); PG8_STAGE_A(PG8_SA(0, 1), cA, 1);
    if (wr == 1) PG8_BAR;
    PG8_WAIT_V(2); PG8_BAR;
    PG8_STAGE_B(PG8_SB(1, 0), cB + kstep, 0); PG8_STAGE_A(PG8_SA(1, 0), cA + kstep, 0); PG8_STAGE_B(PG8_SB(1, 1), cB + kstep, 1);
    PG8_WAIT_V(6); PG8_BAR;
    for (;;) {
        const bool has_next = S.next(ui + 1, nxt);
        const char* nA = has_next ? O.a_tile(nxt) : cA; const char* nB = has_next ? O.b_tile(nxt) : cB;
        if constexpr (Ops::GATHER) { if (has_next) { PG8_GLOAD(voN, nxt); } else {
#pragma unroll
            for (int _h = 0; _h < 2; ++_h)
#pragma unroll
                for (int _i = 0; _i < 2; ++_i) voN[_h][_i] = voC[_h][_i]; } }
        for (int t = 0; t < nt; t += 2) {
            const bool last = (t == nt - 2);
            const char* a1 = cA + (size_t)(t + 1) * kstep;
            const char* a2 = last ? nA : cA + (size_t)(t + 2) * kstep; const char* b2 = last ? nB : cB + (size_t)(t + 2) * kstep;
            const char* a3 = a2 + kstep; const char* b3 = b2 + kstep;
            if (last && has_next) S.a_ready(nxt);
            PG8_LDB(B0, 0, 0); PG8_LDB(B1, 0, 1); PG8_SCHED; PG8_LDA(At, 0, 0); PG8_STAGE_A(PG8_SA(1, 1), a1, 1);
            if constexpr (Ops::GATHER) { if (last) {
#pragma unroll
                for (int _h = 0; _h < 2; ++_h)
#pragma unroll
                    for (int _i = 0; _i < 2; ++_i) voC[_h][_i] = voN[_h][_i]; } }
            PG8_WAIT_V(8); PG8_WAIT_L(0); PG8_BAR; PG8_MMA(0, 0, At, B0); PG8_MMA(0, 1, At, B1); PG8_BAR; PG8_SCHED;
            PG8_LDA(At, 0, 1); PG8_STAGE_B(PG8_SB(0, 0), b2, 0); PG8_STAGE_B(PG8_SB(0, 1), b2, 1); PG8_STAGE_A(PG8_SA(0, 0), a2, 0);
            PG8_WAIT_V(8); PG8_WAIT_L(0); PG8_BAR; PG8_MMA(1, 0, At, B0); PG8_MMA(1, 1, At, B1); PG8_BAR; PG8_SCHED;
            PG8_LDB(B0, 1, 0); PG8_LDB(B1, 1, 1); PG8_SCHED; PG8_LDA(At, 1, 0); PG8_STAGE_A(PG8_SA(0, 1), a2, 1);
            PG8_WAIT_V(8); PG8_WAIT_L(0); PG8_BAR; PG8_MMA(0, 0, At, B0); PG8_MMA(0, 1, At, B1); PG8_BAR; PG8_SCHED;
            PG8_LDA(At, 1, 1); PG8_STAGE_B(PG8_SB(1, 0), b3, 0); PG8_STAGE_B(PG8_SB(1, 1), b3, 1); PG8_STAGE_A(PG8_SA(1, 0), a3, 0);
            PG8_WAIT_V(8); PG8_WAIT_L(0); PG8_BAR; PG8_MMA(1, 0, At, B0); PG8_MMA(1, 1, At, B1); PG8_BAR; PG8_SCHED;
        }
        if constexpr (ALIGN_EPI) { if (wr == 0) PG8_BAR; }
        E(acc, cur, wr, wc, fr, fq); S.done(cur);
        if (!has_next) break;
#pragma unroll
        for (int a = 0; a < 2; ++a)
#pragma unroll
            for (int b = 0; b < 2; ++b)
#pragma unroll
                for (int m = 0; m < 4; ++m)
#pragma unroll
                    for (int n = 0; n < 2; ++n) acc[a][b][m][n] = (f32x4){0.f, 0.f, 0.f, 0.f};
        cur = nxt; cA = nA; cB = nB; ++ui;
        if constexpr (ALIGN_EPI) { if (wr == 1) PG8_BAR; }
    }
    PG8_WAIT_V(0);
    if constexpr (!ALIGN_EPI) { if (wr == 0) PG8_BAR; }
    PG8_BAR;
#undef PG8_SA
#undef PG8_SB
#undef PG8_STAGE_A
#undef PG8_STAGE_B
#undef PG8_LDA
#undef PG8_LDB
#undef PG8_MMA
#undef PG8_WAIT_V
#undef PG8_WAIT_L
#undef PG8_BAR
#undef PG8_SCHED
#undef PG8_GLOAD
}
}
namespace pg8 {
struct OpsPlain { static constexpr bool GATHER = false; const char* A; const char* B; unsigned lda2, ldb2;
    __device__ __forceinline__ const char* a_tile(const Unit& u) const { return A + (size_t)u.pm * 256 * lda2; }
    __device__ __forceinline__ const char* b_tile(const Unit& u) const { return B + (size_t)u.pn * 256 * ldb2; }
    __device__ __forceinline__ unsigned grow(const Unit&, int) const { return 0u; } };
struct OpsBatchB { static constexpr bool GATHER = false; const char* A; const char* B; unsigned lda2, ldb2; size_t bstride;
    __device__ __forceinline__ const char* a_tile(const Unit& u) const { return A + (size_t)u.pm * 256 * lda2; }
    __device__ __forceinline__ const char* b_tile(const Unit& u) const { return B + (size_t)(u.pm >> 4) * bstride + (size_t)u.pn * 256 * ldb2; }
    __device__ __forceinline__ unsigned grow(const Unit&, int) const { return 0u; } };
struct OpsWp { static constexpr bool GATHER = false; const char* kv; const char* wq; unsigned lda2, ldb2;
    __device__ __forceinline__ const char* a_tile(const Unit& u) const { return kv + (size_t)(u.pm >> 2) * 256 * 4096 + (size_t)(u.pm & 3) * 512; }
    __device__ __forceinline__ const char* b_tile(const Unit& u) const { return wq + (size_t)u.pn * 256 * 2048 + (size_t)(u.pm & 3) * 512; }
    __device__ __forceinline__ unsigned grow(const Unit&, int) const { return 0u; } };
struct OpsVp { static constexpr bool GATHER = false; const char* wo; const char* kv; unsigned lda2, ldb2;
    __device__ __forceinline__ const char* a_tile(const Unit& u) const { return wo + (size_t)(u.pm & 3) * 256 * 2048 + (size_t)u.pn * 512; }
    __device__ __forceinline__ const char* b_tile(const Unit& u) const { return kv + (size_t)(u.pm >> 2) * 256 * 4096 + 2048 + (size_t)u.pn * 512; }
    __device__ __forceinline__ unsigned grow(const Unit&, int) const { return 0u; } };
struct OpsG1 { static constexpr bool GATHER = true; const char* A; const char* W; const int* toklist; const int* tile_e; unsigned lda2, ldb2;
    __device__ __forceinline__ const char* a_tile(const Unit&) const { return A; }
    __device__ __forceinline__ const char* b_tile(const Unit& u) const { return W + (size_t)tile_e[u.pm] * ((size_t)2048 * 1024 * 2) + (size_t)u.pn * 256 * 2048; }
    __device__ __forceinline__ unsigned grow(const Unit& u, int r) const { return (unsigned)toklist[u.pm * 256 + r] * 2048u; } };
struct OpsG2 { static constexpr bool GATHER = false; const char* A; const char* W; const int* tile_e; unsigned lda2, ldb2;
    __device__ __forceinline__ const char* a_tile(const Unit& u) const { return A + (size_t)u.pm * 256 * 2048; }
    __device__ __forceinline__ const char* b_tile(const Unit& u) const { return W + (size_t)tile_e[u.pm] * ((size_t)1024 * 1024 * 2) + (size_t)u.pn * 256 * 2048; }
    __device__ __forceinline__ unsigned grow(const Unit&, int) const { return 0u; } };

#define EPI_ARGS const f32x4 (&acc)[2][2][4][2], const Unit& u, int wr, int wc, int fr, int fq
__device__ __forceinline__ u32x4 pack8(const f32x4 a, const f32x4 b) { u32x4 w; w.x = cvt_pk_bf16(a[0], a[1]); w.y = cvt_pk_bf16(a[2], a[3]); w.z = cvt_pk_bf16(b[0], b[1]); w.w = cvt_pk_bf16(b[2], b[3]); return w; }
__device__ __forceinline__ void unpack8(const u32x4 w, f32x4& a, f32x4& b) { a = (f32x4){bf_lo(w.x), bf_hi(w.x), bf_lo(w.y), bf_hi(w.y)}; b = (f32x4){bf_lo(w.z), bf_hi(w.z), bf_lo(w.w), bf_hi(w.w)}; }

struct EpiZ1 { static constexpr bool PERM = true; bf16_t* O; size_t tstride; const float* rs; float qscale; int qtile;
    __device__ __forceinline__ void operator()(EPI_ARGS) const {
        const int t = u.pn >> 2; bf16_t* base = O + (size_t)t * tstride; const float sc = (t == qtile) ? qscale : 1.f;
        const int col0 = (u.pn & 3) * 256 + wc * 32 + 8 * fq;
#pragma unroll
        for (int ai = 0; ai < 2; ++ai)
#pragma unroll
            for (int m = 0; m < 4; ++m) { const int r = u.pm * 256 + ai * 128 + wr * 64 + m * 16 + fr; const float s = rs[r] * sc; bf16_t* rowp = base + (size_t)r * 1024 + col0;
#pragma unroll
                for (int bj = 0; bj < 2; ++bj) *(u32x4*)(rowp + bj * 128) = pack8(acc[ai][bj][m][0] * s, acc[ai][bj][m][1] * s); }
    } };
struct EpiZ3 { static constexpr bool PERM = true; bf16_t* HM; bf16_t* GM; bf16_t* GD; const float* rs; const float* bgate;
    __device__ __forceinline__ void operator()(EPI_ARGS) const {
        const int t = u.pn >> 2; const int col0 = (u.pn & 3) * 256 + wc * 32 + 8 * fq;
        if (t == 0) {
#pragma unroll
            for (int ai = 0; ai < 2; ++ai)
#pragma unroll
                for (int m = 0; m < 4; ++m) { const int r = u.pm * 256 + ai * 128 + wr * 64 + m * 16 + fr; const float s = rs[r]; bf16_t* rowp = HM + (size_t)r * 1024 + col0;
#pragma unroll
                    for (int bj = 0; bj < 2; ++bj) { f32x4 h0, h1; unpack8(*(const u32x4*)(rowp + bj * 128), h0, h1); f32x4 o0, o1;
#pragma unroll
                        for (int i = 0; i < 4; ++i) { o0[i] = sigmoidf_(acc[ai][bj][m][0][i] * s) * h0[i]; o1[i] = sigmoidf_(acc[ai][bj][m][1][i] * s) * h1[i]; }
                        *(u32x4*)(rowp + bj * 128) = pack8(o0, o1); } }
        } else {
            bf16_t* dst = (t == 1) ? GM : GD; const float* bb = bgate + (t - 1) * 1024 + col0;
            f32x4 bv[2][2];
#pragma unroll
            for (int bj = 0; bj < 2; ++bj)
#pragma unroll
                for (int n = 0; n < 2; ++n) bv[bj][n] = *(const f32x4*)(bb + bj * 128 + 4 * n);
#pragma unroll
            for (int ai = 0; ai < 2; ++ai)
#pragma unroll
                for (int m = 0; m < 4; ++m) { const int r = u.pm * 256 + ai * 128 + wr * 64 + m * 16 + fr; const float s = rs[r]; bf16_t* rowp = dst + (size_t)r * 1024 + col0;
#pragma unroll
                    for (int bj = 0; bj < 2; ++bj) { f32x4 o0, o1;
#pragma unroll
                        for (int i = 0; i < 4; ++i) { o0[i] = sigmoidf_(acc[ai][bj][m][0][i] * s + bv[bj][0][i]); o1[i] = sigmoidf_(acc[ai][bj][m][1][i] * s + bv[bj][1][i]); }
                        *(u32x4*)(rowp + bj * 128) = pack8(o0, o1); } }
        }
    } };
struct EpiGate { static constexpr bool PERM = true; const bf16_t* Gt; const bf16_t* ADD; bf16_t* Out;
    __device__ __forceinline__ void operator()(EPI_ARGS) const {
        const int col0 = u.pn * 256 + wc * 32 + 8 * fq;
#pragma unroll
        for (int ai = 0; ai < 2; ++ai)
#pragma unroll
            for (int m = 0; m < 4; ++m) { const size_t ro = (size_t)(u.pm * 256 + ai * 128 + wr * 64 + m * 16 + fr) * 1024 + col0;
#pragma unroll
                for (int bj = 0; bj < 2; ++bj) { f32x4 g0, g1; unpack8(*(const u32x4*)(Gt + ro + bj * 128), g0, g1); f32x4 o0 = g0 * acc[ai][bj][m][0], o1 = g1 * acc[ai][bj][m][1];
                    if (ADD) { f32x4 a0, a1; unpack8(*(const u32x4*)(ADD + ro + bj * 128), a0, a1); o0 += a0; o1 += a1; }
                    *(u32x4*)(Out + ro + bj * 128) = pack8(o0, o1); } }
    } };
struct EpiRes { static constexpr bool PERM = false; const float* base; float* out; bf16_t* xb; float* ss;
    __device__ __forceinline__ void operator()(EPI_ARGS) const {
        const int col0 = u.pn * 256 + wc * 32 + 4 * fq;
#pragma unroll
        for (int ai = 0; ai < 2; ++ai)
#pragma unroll
            for (int m = 0; m < 4; ++m) { const int r = u.pm * 256 + ai * 128 + wr * 64 + m * 16 + fr; const size_t ro = (size_t)r * 1024 + col0; float sq = 0.f;
#pragma unroll
                for (int bj = 0; bj < 2; ++bj)
#pragma unroll
                    for (int n = 0; n < 2; ++n) { const size_t off = ro + bj * 128 + n * 16; const f32x4 o = *(const f32x4*)(base + off) + acc[ai][bj][m][n]; *(f32x4*)(out + off) = o;
                        u32x2 w; w.x = cvt_pk_bf16(o[0], o[1]); w.y = cvt_pk_bf16(o[2], o[3]); *(u32x2*)(xb + off) = w; sq += (o[0] * o[0] + o[1] * o[1]) + (o[2] * o[2] + o[3] * o[3]); }
                sq += __shfl_xor(sq, 16); sq += __shfl_xor(sq, 32);
                if (fq == 0) ss[(size_t)r * 16 + u.pn * 4 + wc] = sq; }
    } };
struct EpiS { static constexpr bool PERM = true; bf16_t* P; const float* rs; float* psum;
    __device__ __forceinline__ void operator()(EPI_ARGS) const {
        const int col0 = u.pn * 256 + wc * 32 + 8 * fq;
#pragma unroll
        for (int ai = 0; ai < 2; ++ai)
#pragma unroll
            for (int m = 0; m < 4; ++m) { const int r = u.pm * 256 + ai * 128 + wr * 64 + m * 16 + fr; const float s = rs[r]; float sum = 0.f;
#pragma unroll
                for (int bj = 0; bj < 2; ++bj) { f32x4 e0, e1;
#pragma unroll
                    for (int i = 0; i < 4; ++i) { e0[i] = __builtin_amdgcn_exp2f(acc[ai][bj][m][0][i] * s); e1[i] = __builtin_amdgcn_exp2f(acc[ai][bj][m][1][i] * s); }
                    sum += ((e0[0] + e0[1]) + (e0[2] + e0[3])) + ((e1[0] + e1[1]) + (e1[2] + e1[3]));
                    *(u32x4*)(P + (size_t)r * 1024 + col0 + bj * 128) = pack8(e0, e1); }
                sum += __shfl_xor(sum, 16); sum += __shfl_xor(sum, 32);
                if (fq == 0) psum[(size_t)r * 16 + u.pn * 4 + wc] = sum; }
    } };
struct EpiPlain { static constexpr bool PERM = true; bf16_t* O; int ldc; float scale;
    __device__ __forceinline__ void operator()(EPI_ARGS) const {
        const int col0 = u.pn * 256 + wc * 32 + 8 * fq;
#pragma unroll
        for (int ai = 0; ai < 2; ++ai)
#pragma unroll
            for (int m = 0; m < 4; ++m) { bf16_t* rowp = O + (size_t)(u.pm * 256 + ai * 128 + wr * 64 + m * 16 + fr) * ldc + col0;
#pragma unroll
                for (int bj = 0; bj < 2; ++bj) *(u32x4*)(rowp + bj * 128) = pack8(acc[ai][bj][m][0] * scale, acc[ai][bj][m][1] * scale); }
    } };
struct EpiG1 { static constexpr bool PERM = true; bf16_t* H; const float* rs; const int* toklist; const int* tile_e; const float* bgu;
    __device__ __forceinline__ void operator()(EPI_ARGS) const {
        const int e = tile_e[u.pm]; const int colh = u.pn * 128 + wc * 32 + 8 * fq; const float* bg = bgu + (size_t)e * 2048 + colh;
        f32x4 bgv[2], buv[2];
#pragma unroll
        for (int n = 0; n < 2; ++n) { bgv[n] = *(const f32x4*)(bg + 4 * n); buv[n] = *(const f32x4*)(bg + 1024 + 4 * n); }
#pragma unroll
        for (int ai = 0; ai < 2; ++ai)
#pragma unroll
            for (int m = 0; m < 4; ++m) { const int slot = u.pm * 256 + ai * 128 + wr * 64 + m * 16 + fr; const float s = rs[toklist[slot]]; f32x4 o[2];
#pragma unroll
                for (int n = 0; n < 2; ++n)
#pragma unroll
                    for (int i = 0; i < 4; ++i) { const float g = fminf(acc[ai][0][m][n][i] * s + bgv[n][i], 7.0f); const float up = fminf(fmaxf(acc[ai][1][m][n][i] * s + buv[n][i], -7.0f), 7.0f);
                        o[n][i] = (up + 1.0f) * (g * sigmoidf_(1.702f * g)); }
                *(u32x4*)(H + (size_t)slot * 1024 + colh) = pack8(o[0], o[1]); }
    } };
struct EpiG2 { static constexpr bool PERM = true; bf16_t* Y; const int* tile_e; const float* bdn;
    __device__ __forceinline__ void operator()(EPI_ARGS) const {
        const int e = tile_e[u.pm]; const int col0 = u.pn * 256 + wc * 32 + 8 * fq; const float* bb = bdn + (size_t)e * 1024 + col0;
        f32x4 bv[2][2];
#pragma unroll
        for (int bj = 0; bj < 2; ++bj)
#pragma unroll
            for (int n = 0; n < 2; ++n) bv[bj][n] = *(const f32x4*)(bb + bj * 128 + 4 * n);
#pragma unroll
        for (int ai = 0; ai < 2; ++ai)
#pragma unroll
            for (int m = 0; m < 4; ++m) { bf16_t* rowp = Y + (size_t)(u.pm * 256 + ai * 128 + wr * 64 + m * 16 + fr) * 1024 + col0;
#pragma unroll
                for (int bj = 0; bj < 2; ++bj) *(u32x4*)(rowp + bj * 128) = pack8(acc[ai][bj][m][0] + bv[bj][0], acc[ai][bj][m][1] + bv[bj][1]); }
    } };
#undef EPI_ARGS
}
constexpr int NWAVES = 8;
constexpr int NB = 16, SEQ = 4096, D = 1024, T = NB * SEQ;
constexpr int NMEM = 256, NE = 32, TOPK = 4;
constexpr float EPS = 1e-6f;
constexpr float LOG2E = 1.4426950408889634f;
constexpr float QD_SCALE = 0.125f * LOG2E;
constexpr float XS_SCALE = 0.0625f * LOG2E;
constexpr float LAM_INIT = 0.2f;

constexpr size_t MiB = 1u << 20;
constexpr size_t WS_CTL = 0, CTL_ZERO_BYTES = 1 * MiB;
constexpr size_t WS_RS0 = 1 * MiB;
constexpr size_t WS_RS1 = 1 * MiB + 256 * 1024;
constexpr size_t WS_RS2 = 1 * MiB + 512 * 1024;
constexpr size_t WS_MISC = 1 * MiB + 768 * 1024;
constexpr size_t WS_IF = 2 * MiB;
constexpr size_t WS_SS1 = 4 * MiB;
constexpr size_t WS_PSUM = 12 * MiB;
constexpr size_t WS_TOPI = 16 * MiB, WS_TOPW = 17 * MiB, WS_SLOT = 18 * MiB;
constexpr size_t WS_TOKL = 19 * MiB;
constexpr int HSLOTS = 139264, HTILES = 544;
constexpr size_t WS_WGT = 22 * MiB;
constexpr size_t WS_WIN = 24 * MiB;
constexpr size_t WS_WBM = 40 * MiB, WS_WBD = 42 * MiB, WS_WOUT = 44 * MiB, WS_WQG = 46 * MiB, WS_WKV = 48 * MiB, WS_WO = 52 * MiB;
constexpr size_t WS_MEMN = 54 * MiB;
constexpr size_t WS_B0 = 64 * MiB, BUF = 128 * MiB;
constexpr size_t WS_B1 = WS_B0 + BUF, WS_B2 = WS_B0 + 2 * BUF, WS_B3 = WS_B0 + 3 * BUF, WS_B4 = WS_B0 + 4 * BUF, WS_B5 = WS_B0 + 5 * BUF;
constexpr size_t WS_KV = WS_B2, WS_WPT = WS_B2 + 16 * MiB, WS_VPT = WS_B2 + 48 * MiB;
constexpr size_t WS_H = WS_B1;
constexpr size_t WS_Y = WS_B1 + 272 * MiB;
constexpr size_t WS_WGU = 832 * MiB, WS_WDN = 960 * MiB, WS_END = 1024 * MiB;
static_assert(WS_Y + 272 * MiB <= WS_WGU, "map");

constexpr int CW_TMO = 0, CW_CODE = 1, CW_BAR = 4096;

constexpr int RING_OFF = 0, RING_BYTES = 131072;
constexpr int LDS_BYTES = 163840;
constexpr int MISC_OFF = LDS_BYTES - 512;

#define GAS __attribute__((address_space(1)))
#define LAS __attribute__((address_space(3)))
typedef unsigned short bf16;
typedef unsigned v4u __attribute__((ext_vector_type(4)));
typedef unsigned v2u __attribute__((ext_vector_type(2)));
typedef float f32x4 __attribute__((ext_vector_type(4)));
typedef GAS unsigned gu32;
#define RLX_AGENT __ATOMIC_RELAXED, __HIP_MEMORY_SCOPE_AGENT
#define LDS_WAIT() asm volatile("s_waitcnt lgkmcnt(0)" ::: "memory")
#define VM_WAIT() asm volatile("s_waitcnt vmcnt(0)" ::: "memory")
__device__ __forceinline__ unsigned pk2(float lo, float hi) { return pg8::cvt_pk_bf16(lo, hi); }
__device__ __forceinline__ float bf2f(bf16 v) { return __uint_as_float((unsigned)v << 16); }

#define XB_TMO      128
#define XB_XCNT(j)  (256  + 64 * (j))
#define XB_XSUB(j)  (1280 + 64 * (j))
#define XB_XGEN(j)  (2304 + 64 * (j))
#define XB_TOP      3328
#define XB_TOPGEN   3392
#define XCD_BAR_WORDS 3456
#define XB_SPIN_CAP (1u << 22)
__device__ __forceinline__ unsigned xb_ld(unsigned* p)              { return __hip_atomic_load(p, __ATOMIC_RELAXED, __HIP_MEMORY_SCOPE_AGENT); }
__device__ __forceinline__ unsigned xb_add(unsigned* p, unsigned v) { return __hip_atomic_fetch_add(p, v, __ATOMIC_RELAXED, __HIP_MEMORY_SCOPE_AGENT); }
__device__ __forceinline__ unsigned xb_xcc_id() { return (unsigned)__builtin_amdgcn_s_getreg((3 << 11) | 20) & 0xFu; }
#define XB_SPIN(cond, bar) do { unsigned _sp = 0; while (cond) { __builtin_amdgcn_s_sleep(1); \
    if ((++_sp & 255u) == 0u) { if (xb_ld(&(bar)[XB_TMO])) break; if (_sp > XB_SPIN_CAP) { atomicAdd(&(bar)[XB_TMO], 1u); break; } } } } while (0)
struct XcdBarrier { unsigned* bar; unsigned x; volatile LAS unsigned* st; };
__device__ __forceinline__ XcdBarrier xcd_barrier_post(unsigned* bar, volatile LAS unsigned* st) {
    XcdBarrier b; b.bar = bar; b.x = xb_xcc_id(); b.st = st;
    if (threadIdx.x == 0) (void)xb_add(&bar[XB_XCNT(b.x)], 1u);
    return b;
}
__device__ __forceinline__ void xcd_barrier_complete(unsigned* bar, unsigned x, unsigned& nloc, unsigned& nx) {
    const unsigned G = gridDim.x * gridDim.y * gridDim.z;
    unsigned sum, cnt, mine, sp = 0u;
    for (;;) {
        sum = 0u; cnt = 0u; mine = 0u;
#pragma unroll
        for (unsigned j = 0; j < 16; ++j) { const unsigned c = xb_ld(&bar[XB_XCNT(j)]); sum += c; cnt += (c > 0u) ? 1u : 0u; mine = (j == x) ? c : mine; }
        if (sum == G) break;
        __builtin_amdgcn_s_sleep(1);
        if ((++sp & 255u) == 0u) { if (xb_ld(&bar[XB_TMO])) break; if (sp > XB_SPIN_CAP) { atomicAdd(&bar[XB_TMO], 1u); break; } }
    }
    nloc = mine > 0u ? mine : 1u; nx = cnt > 0u ? cnt : 1u;
}
__device__ __forceinline__ void xcd_barrier(const XcdBarrier& b) {
    asm volatile("s_waitcnt vmcnt(0)" ::: "memory");
    __syncthreads();
    if (threadIdx.x == 0) {
        unsigned* bar = b.bar;
        __builtin_amdgcn_s_waitcnt(0);
        unsigned nloc = b.st[0], nx = b.st[1];
        if (nloc == 0u) { xcd_barrier_complete(bar, b.x, nloc, nx); b.st[0] = nloc; b.st[1] = nx; }
        const unsigned old = xb_add(&bar[XB_XSUB(b.x)], 1u);
        const unsigned gen = old / nloc;
        if (old + 1u == (gen + 1u) * nloc) {
            __builtin_amdgcn_fence(__ATOMIC_RELEASE, "agent");
            asm volatile("s_waitcnt vmcnt(0)" ::: "memory");
            const unsigned og = xb_add(&bar[XB_TOP], 1u);
            const unsigned tg = og / nx;
            if (og + 1u == (tg + 1u) * nx) xb_add(&bar[XB_TOPGEN], 1u);
            else XB_SPIN(xb_ld(&bar[XB_TOPGEN]) == tg, bar);
            __builtin_amdgcn_fence(__ATOMIC_ACQUIRE, "agent");
            xb_add(&bar[XB_XGEN(b.x)], 1u);
            asm volatile("s_waitcnt vmcnt(0)" ::: "memory");
        } else {
            XB_SPIN(xb_ld(&bar[XB_XGEN(b.x)]) == gen, bar);
            __builtin_amdgcn_fence(__ATOMIC_ACQUIRE, "agent");
            asm volatile("s_waitcnt vmcnt(0)" ::: "memory");
        }
    }
    __syncthreads();
}

enum { I_X = 0, I_MEM, I_NORM_MIX, I_W_IN, I_CONV_W, I_B_IF, I_MGAIN, I_DLAM, I_DGAIN, I_W_BM, I_W_BD, I_B_GATE, I_W_OUT, I_NORM_XATTN, I_NORM_MEM, I_WQ, I_WKV, I_WO,
       I_NORM_FFN, I_W_R, I_B_R, I_W_GU, I_B_GU, I_W_DN, I_B_DN, I_NORM_FINAL, N_INPUTS };
struct Args { const float* in[N_INPUTS]; float* out; unsigned char* ws; int ph_lo, ph_hi; };

__device__ __forceinline__ float wave_sum(float v) {
#pragma unroll
    for (int o = 1; o < 64; o <<= 1) v += __shfl_xor(v, o);
    return v;
}
__device__ __forceinline__ void transpose_item(const float* W, int ldw, int k0, int n0, bf16* WT, int ldt, int drow0, const float* gain, LAS float* scr, int lane) {
#pragma unroll 8
    for (int i = 0; i < 32; ++i) { const int kk = 2 * i + (lane >> 5); float v = W[(size_t)(k0 + kk) * ldw + n0 + (lane & 31)]; if (gain) v *= gain[k0 + kk]; scr[kk * 33 + (lane & 31)] = v; }
    LDS_WAIT(); asm volatile("" ::: "memory");
    const int c = lane & 7;
#pragma unroll
    for (int j = 0; j < 4; ++j) { const int n = (lane >> 3) + 8 * j; const LAS float* s = scr + (8 * c) * 33 + n;
        v4u o; o.x = pk2(s[0 * 33], s[1 * 33]); o.y = pk2(s[2 * 33], s[3 * 33]); o.z = pk2(s[4 * 33], s[5 * 33]); o.w = pk2(s[6 * 33], s[7 * 33]);
        *(v4u*)(WT + (size_t)(drow0 + n) * ldt + k0 + 8 * c) = o; }
    LDS_WAIT(); asm volatile("" ::: "memory");
}
__device__ __forceinline__ int win_src_col(int drow0) {
    return drow0 < 2048 ? drow0 : drow0 < 3072 ? 3080 + (drow0 - 2048) : drow0 < 4096 ? 4104 + (drow0 - 3072) : drow0 < 5120 ? 5128 + (drow0 - 4096) : drow0 < 6144 ? 2048 + (drow0 - 5120) : 6152 + (drow0 - 6144);
}
__device__ __forceinline__ float log_sigmoid_(float x) { return x < 0.f ? x - log1pf(expf(x)) : -log1pf(expf(-x)); }

__device__ __forceinline__ void phase_p0(const Args& a, LAS unsigned char* lds, int tid, int lane, int wave, int vcu, int G) {
    unsigned char* ws = a.ws;
    const int gw = vcu * NWAVES + wave, NGW = G * NWAVES;
    LAS float* scr = (LAS float*)(lds + wave * 16384);
    constexpr int I_IN = 16 * 256, I_SQ = 16 * 32, I_KV = 16 * 64, I_GU = 32 * 16 * 64, I_DN = 32 * 16 * 32;
    constexpr int NITEMS = I_IN + 4 * I_SQ + I_KV + I_GU + I_DN;
    for (int it = gw; it < NITEMS; it += NGW) {
        int r = it;
        if (r < I_IN) { const int kb = r >> 8, nb = r & 255; transpose_item(a.in[I_W_IN], 8200, 64 * kb, win_src_col(32 * nb), (bf16*)(ws + WS_WIN), 1024, 32 * nb, a.in[I_NORM_MIX], scr, lane); continue; } r -= I_IN;
        if (r < I_SQ) { transpose_item(a.in[I_W_BM], 1024, 64 * (r >> 5), 32 * (r & 31), (bf16*)(ws + WS_WBM), 1024, 32 * (r & 31), nullptr, scr, lane); continue; } r -= I_SQ;
        if (r < I_SQ) { transpose_item(a.in[I_W_BD], 1024, 64 * (r >> 5), 32 * (r & 31), (bf16*)(ws + WS_WBD), 1024, 32 * (r & 31), nullptr, scr, lane); continue; } r -= I_SQ;
        if (r < I_SQ) { transpose_item(a.in[I_W_OUT], 1024, 64 * (r >> 5), 32 * (r & 31), (bf16*)(ws + WS_WOUT), 1024, 32 * (r & 31), nullptr, scr, lane); continue; } r -= I_SQ;
        if (r < I_SQ) { transpose_item(a.in[I_WO], 1024, 64 * (r >> 5), 32 * (r & 31), (bf16*)(ws + WS_WO), 1024, 32 * (r & 31), nullptr, scr, lane); continue; } r -= I_SQ;
        if (r < I_KV) { transpose_item(a.in[I_WKV], 2048, 64 * (r >> 6), 32 * (r & 63), (bf16*)(ws + WS_WKV), 1024, 32 * (r & 63), nullptr, scr, lane); continue; } r -= I_KV;
        if (r < I_GU) { const int e = r >> 10, q = r & 1023, kb = q >> 6, nb = q & 63, n0 = 32 * nb;
            const int drow0 = n0 < 1024 ? (n0 >> 7) * 256 + (n0 & 127) : ((n0 - 1024) >> 7) * 256 + 128 + ((n0 - 1024) & 127);
            transpose_item(a.in[I_W_GU] + (size_t)e * 1024 * 2048, 2048, 64 * kb, n0, (bf16*)(ws + WS_WGU) + (size_t)e * 2048 * 1024, 1024, drow0, a.in[I_NORM_FFN], scr, lane); continue; } r -= I_GU;
        { const int e = r >> 9, q = r & 511; transpose_item(a.in[I_W_DN] + (size_t)e * 1024 * 1024, 1024, 64 * (q >> 5), 32 * (q & 31), (bf16*)(ws + WS_WDN) + (size_t)e * 1024 * 1024, 1024, 32 * (q & 31), nullptr, scr, lane); }
    }
    for (int idx = (vcu * 512 + tid); idx < 1024 * 1024 / 4; idx += G * 512) { const int row = idx >> 8; const float g = a.in[I_NORM_XATTN][row];
        const f32x4 v = *(const f32x4*)(a.in[I_WQ] + (size_t)idx * 4); v2u o; o.x = pk2(v[0] * g, v[1] * g); o.y = pk2(v[2] * g, v[3] * g); *(v2u*)((bf16*)(ws + WS_WQG) + (size_t)idx * 4) = o; }
    for (int idx = (vcu * 512 + tid); idx < 32 * 1024; idx += G * 512) { const int e = idx >> 10, k = idx & 1023; ((float*)(ws + WS_WGT))[idx] = a.in[I_NORM_FFN][k] * a.in[I_W_R][k * 32 + e]; }
    __syncthreads();
    LAS float* wif = (LAS float*)lds;
    for (int idx = tid; idx < 8192; idx += 512) { const int j = idx & 7, k = idx >> 3; wif[j * 1024 + k] = a.in[I_NORM_MIX][k] * a.in[I_W_IN][(size_t)k * 8200 + 3072 + j]; }
    __syncthreads();
    for (int m = gw; m < T; m += NGW) {
        const f32x4* xr = (const f32x4*)(a.in[I_X] + (size_t)m * D) + lane;
        f32x4 v[4]; float s = 0.f;
#pragma unroll
        for (int j = 0; j < 4; ++j) { v[j] = xr[64 * j]; s += (v[j][0] * v[j][0] + v[j][1] * v[j][1]) + (v[j][2] * v[j][2] + v[j][3] * v[j][3]); }
        const float rs = 1.0f / sqrtf(wave_sum(s) * (1.f / D) + EPS);
        unsigned long long* o8 = (unsigned long long*)((bf16*)(ws + WS_B0) + (size_t)m * D) + lane;
#pragma unroll
        for (int j = 0; j < 4; ++j) o8[64 * j] = (unsigned long long)pk2(v[j][0], v[j][1]) | ((unsigned long long)pk2(v[j][2], v[j][3]) << 32);
        float gv[8];
#pragma unroll
        for (int g = 0; g < 8; ++g) { float p = 0.f;
#pragma unroll
            for (int j = 0; j < 4; ++j) { const f32x4 w = *(const LAS f32x4*)(wif + g * 1024 + 4 * lane + 256 * j); p += (v[j][0] * w[0] + v[j][1] * w[1]) + (v[j][2] * w[2] + v[j][3] * w[3]); }
            gv[g] = wave_sum(p) * rs + a.in[I_B_IF][g]; }
        if (lane == 0) { ((float*)(ws + WS_RS0))[m] = rs; float* o = (float*)(ws + WS_IF) + (size_t)m * 8;
#pragma unroll
            for (int g = 0; g < 4; ++g) { o[g] = gv[g]; o[4 + g] = log_sigmoid_(gv[4 + g]); } }
    }
    for (int m = gw; m < NB * NMEM; m += NGW) {
        const f32x4* xr = (const f32x4*)(a.in[I_MEM] + (size_t)m * D) + lane; const f32x4* gr = (const f32x4*)a.in[I_NORM_MEM] + lane;
        f32x4 v[4]; float s = 0.f;
#pragma unroll
        for (int j = 0; j < 4; ++j) { v[j] = xr[64 * j]; s += (v[j][0] * v[j][0] + v[j][1] * v[j][1]) + (v[j][2] * v[j][2] + v[j][3] * v[j][3]); }
        const float rs = 1.0f / sqrtf(wave_sum(s) * (1.f / D) + EPS);
        unsigned long long* o8 = (unsigned long long*)((bf16*)(ws + WS_MEMN) + (size_t)m * D) + lane;
#pragma unroll
        for (int j = 0; j < 4; ++j) { const f32x4 g = gr[64 * j]; o8[64 * j] = (unsigned long long)pk2(v[j][0] * rs * g[0], v[j][1] * rs * g[1]) | ((unsigned long long)pk2(v[j][2] * rs * g[2], v[j][3] * rs * g[3]) << 32); }
    }
}

__device__ __forceinline__ void att_naive_unit(const Args& a, LAS unsigned char* lds, int tid, int b, int h, int qblk, float lam) {
    const bf16* QD = (const bf16*)(a.ws + WS_B3); const bf16* KD = (const bf16*)(a.ws + WS_B4); const bf16* VD = (const bf16*)(a.ws + WS_B5); bf16* HD = (bf16*)(a.ws + WS_B3);
    const int row = tid >> 2, c = (tid >> 1) & 1, vh = tid & 1;
    const int qpos = qblk * 128 + row; const size_t tok = (size_t)b * SEQ + qpos;
    float q[64];
    { const v4u* qp = (const v4u*)(QD + tok * 1024 + h * 128 + c * 64);
#pragma unroll
      for (int i = 0; i < 8; ++i) { const v4u w = qp[i]; q[8 * i + 0] = pg8::bf_lo(w.x); q[8 * i + 1] = pg8::bf_hi(w.x); q[8 * i + 2] = pg8::bf_lo(w.y); q[8 * i + 3] = pg8::bf_hi(w.y);
          q[8 * i + 4] = pg8::bf_lo(w.z); q[8 * i + 5] = pg8::bf_hi(w.z); q[8 * i + 6] = pg8::bf_lo(w.w); q[8 * i + 7] = pg8::bf_hi(w.w); } }
    const int kmax = ((qpos >> 6) + 1) << 6, ukmax = qblk * 128 + 128;
    float o[64];
#pragma unroll
    for (int i = 0; i < 64; ++i) o[i] = 0.f;
    float mrun = -INFINITY, l = 0.f;
    LAS float* Ks = (LAS float*)lds; LAS float* Vs = (LAS float*)(lds + 8192);
    for (int kt = 0; kt < ukmax; kt += 16) {
        __syncthreads();
        { const int kr = tid >> 5, cc = (tid & 31) * 4; const size_t ko = ((size_t)b * SEQ + kt + kr) * 1024 + h * 128 + cc;
          const v2u kw = *(const v2u*)(KD + ko), vw = *(const v2u*)(VD + ko);
          *(LAS f32x4*)(Ks + kr * 128 + cc) = (f32x4){pg8::bf_lo(kw.x), pg8::bf_hi(kw.x), pg8::bf_lo(kw.y), pg8::bf_hi(kw.y)};
          *(LAS f32x4*)(Vs + kr * 128 + cc) = (f32x4){pg8::bf_lo(vw.x), pg8::bf_hi(vw.x), pg8::bf_lo(vw.y), pg8::bf_hi(vw.y)}; }
        __syncthreads();
#pragma unroll 1
        for (int j = 0; j < 16; ++j) {
            if (kt + j >= kmax) continue;
            float d = 0.f; const LAS f32x4* kp = (const LAS f32x4*)(Ks + j * 128 + c * 64);
#pragma unroll
            for (int i = 0; i < 16; ++i) { const f32x4 kk = kp[i]; d += (q[4 * i] * kk[0] + q[4 * i + 1] * kk[1]) + (q[4 * i + 2] * kk[2] + q[4 * i + 3] * kk[3]); }
            const float mnew = fmaxf(mrun, d); const float alpha = __builtin_amdgcn_exp2f(mrun - mnew), p = __builtin_amdgcn_exp2f(d - mnew);
            l = l * alpha + p; mrun = mnew;
            const LAS f32x4* vp = (const LAS f32x4*)(Vs + j * 128 + vh * 64);
#pragma unroll
            for (int i = 0; i < 16; ++i) { const f32x4 vv = vp[i]; o[4 * i] = o[4 * i] * alpha + p * vv[0]; o[4 * i + 1] = o[4 * i + 1] * alpha + p * vv[1]; o[4 * i + 2] = o[4 * i + 2] * alpha + p * vv[2]; o[4 * i + 3] = o[4 * i + 3] * alpha + p * vv[3]; }
        }
    }
    const float inv = 1.0f / l; float sq = 0.f;
#pragma unroll
    for (int i = 0; i < 64; ++i) { o[i] *= inv; const float other = __shfl_xor(o[i], 2); o[i] = o[i] - lam * other; sq += o[i] * o[i]; }
    sq += __shfl_xor(sq, 1);
    const float rn = 1.0f / sqrtf(sq * (1.f / 128.f) + EPS) * (1.0f - LAM_INIT);
    if (c == 0) { const float* dg = a.in[I_DGAIN] + vh * 64; v4u* op = (v4u*)(HD + tok * 1024 + h * 128 + vh * 64);
#pragma unroll
        for (int i = 0; i < 8; ++i) { v4u w; w.x = pk2(o[8 * i] * rn * dg[8 * i], o[8 * i + 1] * rn * dg[8 * i + 1]); w.y = pk2(o[8 * i + 2] * rn * dg[8 * i + 2], o[8 * i + 3] * rn * dg[8 * i + 3]);
            w.z = pk2(o[8 * i + 4] * rn * dg[8 * i + 4], o[8 * i + 5] * rn * dg[8 * i + 5]); w.w = pk2(o[8 * i + 6] * rn * dg[8 * i + 6], o[8 * i + 7] * rn * dg[8 * i + 7]); op[i] = w; } }
}
__device__ __forceinline__ float diff_lambda(const Args& a) {
    const float* lp = a.in[I_DLAM]; float s1 = 0.f, s2 = 0.f;
    for (int i = 0; i < 64; ++i) { s1 += lp[i] * lp[64 + i]; s2 += lp[128 + i] * lp[192 + i]; }
    return expf(s1) - expf(s2) + LAM_INIT;
}
__device__ __forceinline__ void phase_att_naive(const Args& a, LAS unsigned char* lds, int tid, int vcu, int G) {
    const float lam = diff_lambda(a);
    for (int i = 0;; ++i) { const int u = i * G + vcu; if (u >= NB * 8 * 32) break;
        const int bh = u >> 5, r = (u & 31), rot = (r + 2 * (i >> 1)) & 31, qblk = (i & 1) ? 31 - rot : rot;
        att_naive_unit(a, lds, tid, bh >> 3, bh & 7, qblk, lam);
        __syncthreads(); }
}

__device__ __forceinline__ float bfdot8(const v4u w, const float* c) {
    return (c[0] * pg8::bf_lo(w.x) + c[1] * pg8::bf_hi(w.x)) + (c[2] * pg8::bf_lo(w.y) + c[3] * pg8::bf_hi(w.y)) + (c[4] * pg8::bf_lo(w.z) + c[5] * pg8::bf_hi(w.z)) + (c[6] * pg8::bf_lo(w.w) + c[7] * pg8::bf_hi(w.w));
}
__device__ __forceinline__ void mlstm_naive_unit(const Args& a, LAS unsigned char* lds, int tid, int lane, int wave, int b, int h) {
    const bf16* QKM = (const bf16*)(a.ws + WS_B1); bf16* VM = (bf16*)(a.ws + WS_B2); const float* IF = (const float*)(a.ws + WS_IF);
    LAS bf16* qs = (LAS bf16*)lds;
    LAS bf16* ks = (LAS bf16*)(lds + 16384);
    LAS bf16* vs = (LAS bf16*)(lds + 32768);
    LAS float* Sm = (LAS float*)(lds + 65536);
    LAS float* hs = (LAS float*)(lds + 81920);
    LAS float* sm = (LAS float*)(lds + 147456);
    LAS float* ig = sm, *lf = sm + 64, *bcum = sm + 128, *aarr = sm + 192, *mt = sm + 256, *wint = sm + 320, *wk = sm + 384, *den = sm + 448, *nvec = sm + 512, *scal = sm + 640, *hsqw = sm + 704;
    const int dv = tid >> 1, half = tid & 1;
    float Creg[64];
#pragma unroll
    for (int j = 0; j < 64; ++j) Creg[j] = 0.f;
    if (tid < 128) nvec[tid] = 0.f;
    if (tid == 0) scal[0] = 0.f;
    const float* cw = a.in[I_CONV_W];
    for (int ch = 0; ch < SEQ / 64; ++ch) {
        const size_t tok0 = (size_t)b * SEQ + ch * 64;
        __syncthreads();
        if (tid < 64) { ig[tid] = IF[(tok0 + tid) * 8 + h]; lf[tid] = IF[(tok0 + tid) * 8 + 4 + h]; }
        { const int col = tid & 127, which = (tid >> 7) & 1, tq = tid >> 8;
          const int chn = which * 512 + h * 128 + col; const float w0 = cw[chn], w1 = cw[1024 + chn], w2 = cw[2048 + chn], w3 = cw[3072 + chn];
          const int t0 = ch * 64 + 32 * tq; float x0, x1, x2;
          x0 = (t0 - 3 >= 0) ? bf2f(QKM[((size_t)b * SEQ + t0 - 3) * 1024 + chn]) : 0.f; x1 = (t0 - 2 >= 0) ? bf2f(QKM[((size_t)b * SEQ + t0 - 2) * 1024 + chn]) : 0.f; x2 = (t0 - 1 >= 0) ? bf2f(QKM[((size_t)b * SEQ + t0 - 1) * 1024 + chn]) : 0.f;
          LAS bf16* dst = which ? ks : qs; const float scl = which ? 1.0f : 0.08838834764831845f;
          for (int t = 0; t < 32; ++t) { const float x3 = bf2f(QKM[((size_t)b * SEQ + t0 + t) * 1024 + chn]); const float cv = w0 * x0 + w1 * x1 + w2 * x2 + w3 * x3; const float sv = cv * pg8::sigmoidf_(cv) * scl;
              dst[(32 * tq + t) * 128 + col] = (bf16)(pk2(sv, 0.f) & 0xffffu); x0 = x1; x1 = x2; x2 = x3; } }
        for (int idx = tid; idx < 64 * 32; idx += 512) { const int t = idx >> 5, c8 = (idx & 31) * 8; *(LAS v4u*)(vs + t * 256 + c8) = *(const v4u*)(VM + (tok0 + t) * 1024 + h * 256 + c8); }
        __syncthreads();
        if (tid == 0) { const float m = scal[0]; float bsum = 0.f, amax = -INFINITY;
            for (int t = 0; t < 64; ++t) { bsum += lf[t]; bcum[t] = bsum; const float av = ig[t] - bsum; aarr[t] = av; amax = fmaxf(amax, av); const float mm = fmaxf(m, amax); mt[t] = bsum + mm; wint[t] = expf(m - mm); }
            const float mm = fmaxf(m, amax), mnew = bsum + mm;
            for (int s = 0; s < 64; ++s) wk[s] = expf(bsum + aarr[s] - mnew);
            scal[1] = expf(bsum + m - mnew); scal[2] = mnew; }
        __syncthreads();
        for (int i = 0; i < 8; ++i) { const int idx = tid + 512 * i, t = idx >> 6, s = idx & 63; float val = 0.f;
            if (s <= t) { float d = 0.f;
#pragma unroll 2
                for (int k8 = 0; k8 < 16; ++k8) { const v4u qw = *(const LAS v4u*)(qs + t * 128 + k8 * 8), kw = *(const LAS v4u*)(ks + s * 128 + k8 * 8);
                    d += (pg8::bf_lo(qw.x) * pg8::bf_lo(kw.x) + pg8::bf_hi(qw.x) * pg8::bf_hi(kw.x)) + (pg8::bf_lo(qw.y) * pg8::bf_lo(kw.y) + pg8::bf_hi(qw.y) * pg8::bf_hi(kw.y))
                       + (pg8::bf_lo(qw.z) * pg8::bf_lo(kw.z) + pg8::bf_hi(qw.z) * pg8::bf_hi(kw.z)) + (pg8::bf_lo(qw.w) * pg8::bf_lo(kw.w) + pg8::bf_hi(qw.w) * pg8::bf_hi(kw.w)); }
                val = d * expf(bcum[t] + aarr[s] - mt[t]); }
            Sm[idx] = val; }
        __syncthreads();
        if (tid < 64) { float rsum = 0.f; for (int s = 0; s < 64; ++s) rsum += Sm[tid * 64 + s];
            float nq = 0.f; for (int k = 0; k < 128; ++k) nq += nvec[k] * bf2f(qs[tid * 128 + k]);
            den[tid] = fmaxf(fabsf(rsum + wint[tid] * nq), expf(-mt[tid])); }
        __syncthreads();
#pragma unroll 1
        for (int t = 0; t < 64; ++t) {
            float part = 0.f;
#pragma unroll
            for (int k8 = 0; k8 < 8; ++k8) part += bfdot8(*(const LAS v4u*)(qs + t * 128 + half * 64 + k8 * 8), &Creg[k8 * 8]);
            float ip = 0.f;
#pragma unroll 4
            for (int s = half * 32; s < half * 32 + 32; ++s) ip += Sm[t * 64 + s] * bf2f(vs[s * 256 + dv]);
            float tot = ip + wint[t] * part; tot += __shfl_xor(tot, 1);
            const float hv = tot / den[t];
            if (half == 0) hs[t * 256 + dv] = hv;
            const float sq = wave_sum(half == 0 ? hv * hv : 0.f);
            if (lane == 0) hsqw[wave * 64 + t] = sq;
        }
        __syncthreads();
        for (int i = 0; i < 32; ++i) { const int idx = tid + 512 * i, t = idx >> 8, dd = idx & 255; float ssum = 0.f;
#pragma unroll
            for (int w = 0; w < 8; ++w) ssum += hsqw[w * 64 + t];
            const float rn = 1.0f / sqrtf(ssum * (1.f / 256.f) + EPS);
            VM[(tok0 + t) * 1024 + h * 256 + dd] = (bf16)(pk2(hs[idx] * rn * a.in[I_MGAIN][h * 256 + dd], 0.f) & 0xffffu); }
        { const float decay = scal[1];
#pragma unroll
          for (int j = 0; j < 64; ++j) Creg[j] *= decay;
#pragma unroll 1
          for (int s = 0; s < 64; ++s) { const float wv = wk[s] * bf2f(vs[s * 256 + dv]);
#pragma unroll
              for (int k8 = 0; k8 < 8; ++k8) { const v4u kw = *(const LAS v4u*)(ks + s * 128 + half * 64 + k8 * 8);
                  Creg[k8 * 8 + 0] += wv * pg8::bf_lo(kw.x); Creg[k8 * 8 + 1] += wv * pg8::bf_hi(kw.x); Creg[k8 * 8 + 2] += wv * pg8::bf_lo(kw.y); Creg[k8 * 8 + 3] += wv * pg8::bf_hi(kw.y);
                  Creg[k8 * 8 + 4] += wv * pg8::bf_lo(kw.z); Creg[k8 * 8 + 5] += wv * pg8::bf_hi(kw.z); Creg[k8 * 8 + 6] += wv * pg8::bf_lo(kw.w); Creg[k8 * 8 + 7] += wv * pg8::bf_hi(kw.w); } }
          float nn = 0.f;
          if (tid < 128) { nn = decay * nvec[tid]; for (int s = 0; s < 64; ++s) nn += wk[s] * bf2f(ks[s * 128 + tid]); }
          __syncthreads();
          if (tid < 128) nvec[tid] = nn;
          if (tid == 0) scal[0] = scal[2]; }
    }
    __syncthreads();
}
__device__ __forceinline__ void phase_mlstm_naive(const Args& a, LAS unsigned char* lds, int tid, int lane, int wave, int vcu, int G) {
    for (int u = vcu; u < NB * 4; u += G) mlstm_naive_unit(a, lds, tid, lane, wave, u >> 2, u & 3);
}

__device__ __forceinline__ void phase_rs1(const Args& a, int tid, int vcu, int G) {
    const float* ss = (const float*)(a.ws + WS_SS1); float* rs = (float*)(a.ws + WS_RS1);
    for (int r = vcu * 512 + tid; r < T; r += G * 512) { const f32x4* p = (const f32x4*)(ss + (size_t)r * 16); const f32x4 s0 = p[0], s1 = p[1], s2 = p[2], s3 = p[3];
        const float s = ((s0[0] + s0[1]) + (s0[2] + s0[3])) + ((s1[0] + s1[1]) + (s1[2] + s1[3])) + ((s2[0] + s2[1]) + (s2[2] + s2[3])) + ((s3[0] + s3[1]) + (s3[2] + s3[3]));
        rs[r] = 1.0f / sqrtf(s * (1.f / D) + EPS); }
}
__device__ __forceinline__ void phase_pnorm(const Args& a, int lane, int wave, int vcu, int G) {
    bf16* P = (bf16*)(a.ws + WS_B3); const float* ps = (const float*)(a.ws + WS_PSUM);
    for (int r = vcu * NWAVES + wave; r < T; r += G * NWAVES) { const int hh = lane >> 4; const f32x4 s = *(const f32x4*)(ps + (size_t)r * 16 + hh * 4);
        const float inv = 1.0f / ((s[0] + s[1]) + (s[2] + s[3]));
        v4u* p = (v4u*)(P + (size_t)r * 1024 + lane * 16);
#pragma unroll
        for (int i = 0; i < 2; ++i) { const v4u w = p[i]; v4u o; o.x = pk2(pg8::bf_lo(w.x) * inv, pg8::bf_hi(w.x) * inv); o.y = pk2(pg8::bf_lo(w.y) * inv, pg8::bf_hi(w.y) * inv);
            o.z = pk2(pg8::bf_lo(w.z) * inv, pg8::bf_hi(w.z) * inv); o.w = pk2(pg8::bf_lo(w.w) * inv, pg8::bf_hi(w.w) * inv); p[i] = o; } }
}
__device__ __forceinline__ void phase_final_plain(const Args& a, const float* src, int lane, int wave, int vcu, int G) {
    for (int m = vcu * NWAVES + wave; m < T; m += G * NWAVES) {
        const f32x4* xr = (const f32x4*)(src + (size_t)m * D) + lane; const f32x4* gr = (const f32x4*)a.in[I_NORM_FINAL] + lane; f32x4* orow = (f32x4*)(a.out + (size_t)m * D) + lane;
        f32x4 v[4]; float s = 0.f;
#pragma unroll
        for (int j = 0; j < 4; ++j) { v[j] = xr[64 * j]; s += (v[j][0] * v[j][0] + v[j][1] * v[j][1]) + (v[j][2] * v[j][2] + v[j][3] * v[j][3]); }
        const float rs = 1.0f / sqrtf(wave_sum(s) * (1.f / D) + EPS);
#pragma unroll
        for (int j = 0; j < 4; ++j) orow[64 * j] = v[j] * rs * gr[64 * j];
    }
}
__device__ __forceinline__ void phase_router(const Args& a, LAS unsigned char* lds, int tid, int lane, int wave) {
    LAS float* wg = (LAS float*)lds;
    LAS int* hist = (LAS int*)(lds + 131072);
    const float* wgt = (const float*)(a.ws + WS_WGT);
    for (int idx = tid; idx < 32 * 1024 / 4; idx += 512) *(LAS f32x4*)(wg + idx * 4) = *(const f32x4*)(wgt + idx * 4);
    if (tid < 32) hist[tid] = 0;
    __syncthreads();
    const int blk = blockIdx.x;
    for (int i = 0; i < 32; ++i) { const int tk = blk * 256 + wave * 32 + i;
        const f32x4* xr = (const f32x4*)(a.out + (size_t)tk * D) + lane;
        f32x4 v[4]; float s = 0.f;
#pragma unroll
        for (int j = 0; j < 4; ++j) { v[j] = xr[64 * j]; s += (v[j][0] * v[j][0] + v[j][1] * v[j][1]) + (v[j][2] * v[j][2] + v[j][3] * v[j][3]); }
        const float rs = 1.0f / sqrtf(wave_sum(s) * (1.f / D) + EPS);
        float lg[32];
#pragma unroll
        for (int e = 0; e < 32; ++e) { float p = 0.f;
#pragma unroll
            for (int j = 0; j < 4; ++j) { const f32x4 w = *(const LAS f32x4*)(wg + e * 1024 + 4 * lane + 256 * j); p += (v[j][0] * w[0] + v[j][1] * w[1]) + (v[j][2] * w[2] + v[j][3] * w[3]); }
            lg[e] = wave_sum(p) * rs + a.in[I_B_R][e]; }
        int bi[4]; float bv[4];
#pragma unroll
        for (int k = 0; k < 4; ++k) { float best = -INFINITY; int be = 0;
#pragma unroll
            for (int e = 0; e < 32; ++e) if (lg[e] > best) { best = lg[e]; be = e; }
#pragma unroll
            for (int e = 0; e < 32; ++e) lg[e] = (e == be) ? -INFINITY : lg[e];
            bi[k] = be; bv[k] = best; }
        const float e1 = expf(bv[1] - bv[0]), e2 = expf(bv[2] - bv[0]), e3 = expf(bv[3] - bv[0]); const float inv = 1.0f / (1.0f + e1 + e2 + e3);
        if (lane == 0) { ((float*)(a.ws + WS_RS2))[tk] = rs;
            int* ti = (int*)(a.ws + WS_TOPI) + (size_t)tk * 4; float* tw = (float*)(a.ws + WS_TOPW) + (size_t)tk * 4;
            ti[0] = bi[0]; ti[1] = bi[1]; ti[2] = bi[2]; ti[3] = bi[3]; tw[0] = inv; tw[1] = e1 * inv; tw[2] = e2 * inv; tw[3] = e3 * inv;
            __hip_atomic_fetch_add(&hist[bi[0]], 1, __ATOMIC_RELAXED, __HIP_MEMORY_SCOPE_WORKGROUP); __hip_atomic_fetch_add(&hist[bi[1]], 1, __ATOMIC_RELAXED, __HIP_MEMORY_SCOPE_WORKGROUP); __hip_atomic_fetch_add(&hist[bi[2]], 1, __ATOMIC_RELAXED, __HIP_MEMORY_SCOPE_WORKGROUP); __hip_atomic_fetch_add(&hist[bi[3]], 1, __ATOMIC_RELAXED, __HIP_MEMORY_SCOPE_WORKGROUP); }
    }
    __syncthreads();
    if (tid < 32) ((int*)(a.ws + WS_MISC))[blk * 32 + tid] = hist[tid];
}
__device__ __forceinline__ void phase_slot(const Args& a, LAS unsigned char* lds, int tid) {
    LAS int* tot = (LAS int*)lds, *bef = tot + 32, *st = tot + 64, *ids = tot + 128;
    const int blk = blockIdx.x, half = blk >> 7; const int* hist = (const int*)(a.ws + WS_MISC);
    int* tile_e = (int*)(a.ws + WS_MISC) + 8192 + half * HTILES; int* ntiles = (int*)(a.ws + WS_MISC) + 8192 + 2 * HTILES;
    int* toklist = (int*)(a.ws + WS_TOKL) + (size_t)half * HSLOTS; int* slot_of = (int*)(a.ws + WS_SLOT); const int* topi = (const int*)(a.ws + WS_TOPI);
    if (tid < 32) { int t = 0, bf = 0; for (int bb = half * 128; bb < half * 128 + 128; ++bb) { const int hv = hist[bb * 32 + tid]; t += hv; if (bb < blk) bf += hv; } tot[tid] = t; bef[tid] = bf; }
    for (int i = tid; i < 1024; i += 512) ids[i] = topi[(size_t)blk * 1024 + i];
    __syncthreads();
    if (tid == 0) { int s = 0; for (int e = 0; e < 32; ++e) { st[e] = s; s += ((tot[e] + 255) >> 8) << 8; } st[32] = s; }
    __syncthreads();
    if (tid < 32) { int cnt = st[tid] + bef[tid];
        for (int i = 0; i < 1024; ++i) if (ids[i] == tid) { const int tk = blk * 256 + (i >> 2); slot_of[(size_t)tk * 4 + (i & 3)] = cnt; toklist[cnt] = tk; ++cnt; }
        if ((blk & 127) == 0) { for (int s = st[tid] + tot[tid]; s < st[tid + 1]; ++s) toklist[s] = half * (T / 2);
            for (int tl = st[tid] >> 8; tl < (st[tid + 1] >> 8); ++tl) tile_e[tl] = tid;
            if (tid == 0) ntiles[half] = st[32] >> 8; } }
}
__device__ __forceinline__ void phase_combine(const Args& a, int half, int lane, int wave, int vcu, int G) {
    const bf16* Y = (const bf16*)(a.ws + WS_Y); const int* slot_of = (const int*)(a.ws + WS_SLOT); const float* tw = (const float*)(a.ws + WS_TOPW);
    for (int m = half * (T / 2) + vcu * NWAVES + wave; m < (half + 1) * (T / 2); m += G * NWAVES) {
        f32x4* xr = (f32x4*)(a.out + (size_t)m * D) + lane; const f32x4* gr = (const f32x4*)a.in[I_NORM_FINAL] + lane;
        f32x4 v[4];
#pragma unroll
        for (int j = 0; j < 4; ++j) v[j] = xr[64 * j];
#pragma unroll
        for (int k = 0; k < 4; ++k) { const int sl = slot_of[(size_t)m * 4 + k]; const float c = tw[(size_t)m * 4 + k]; const v2u* yr = (const v2u*)(Y + (size_t)sl * 1024) + lane;
#pragma unroll
            for (int j = 0; j < 4; ++j) { const v2u w = yr[64 * j]; v[j][0] += c * pg8::bf_lo(w.x); v[j][1] += c * pg8::bf_hi(w.x); v[j][2] += c * pg8::bf_lo(w.y); v[j][3] += c * pg8::bf_hi(w.y); } }
        float s = 0.f;
#pragma unroll
        for (int j = 0; j < 4; ++j) s += (v[j][0] * v[j][0] + v[j][1] * v[j][1]) + (v[j][2] * v[j][2] + v[j][3] * v[j][3]);
        const float rs = 1.0f / sqrtf(wave_sum(s) * (1.f / D) + EPS);
#pragma unroll
        for (int j = 0; j < 4; ++j) xr[64 * j] = v[j] * rs * gr[64 * j];
    }
}
#ifndef DBG_STAGE
#define DBG_STAGE 0
#endif
enum { PH_P0 = 0, PH_Z1, PH_ATT, PH_MLSTM, PH_Z3, PH_BR1, PH_CP1, PH_BR2, PH_CP2, PH_CP3, PH_OUT, PH_RS1, PH_S, PH_PN, PH_PV, PH_ROUTER, PH_SLOT, PH_G1A, PH_G2A, PH_CA, PH_G1B, PH_G2B, PH_CB, N_PHASES };

__global__ void __launch_bounds__(NWAVES * 64, 2) fwd_kernel(Args args) {
    extern __shared__ __attribute__((aligned(16))) unsigned char lds_raw[];
    LAS unsigned char* lds = (LAS unsigned char*)lds_raw;
    volatile LAS unsigned* MISC = (volatile LAS unsigned*)(lds + MISC_OFF);
#define LAUNDER_TID() int tid = threadIdx.x; asm volatile("" : "+v"(tid)); const int lane = tid & 63, wave = __builtin_amdgcn_readfirstlane(tid >> 6)
    const int tid0 = threadIdx.x;
    const int G = gridDim.x; const int bx = blockIdx.x; const int vcu = (G % 8 == 0) ? (bx % 8) * (G / 8) + bx / 8 : bx;
    unsigned char* ws = args.ws;
    if (tid0 < 128) MISC[tid0] = 0u;
    __syncthreads();
    const int lo = args.ph_lo, hi = args.ph_hi;
    XcdBarrier bar; bar.bar = (unsigned*)(ws + WS_CTL) + CW_BAR; bar.x = 0; bar.st = nullptr;
    if (hi - lo > 1) bar = xcd_barrier_post((unsigned*)(ws + WS_CTL) + CW_BAR, MISC + 8);
#ifndef ONLY_PHASE
#define ONLY_PHASE -1
#endif
#ifndef SKIP_MASK
#define SKIP_MASK 0u
#endif
#define IN(k) ((ONLY_PHASE < 0 || ONLY_PHASE == (k)) && !((SKIP_MASK >> (k)) & 1u) && lo <= (k) && (k) < hi)
#define SEAM(k) do { if (IN(k) && IN((k) + 1)) xcd_barrier(bar); } while (0)
    using namespace pg8;
    const bf16_t* B0 = (const bf16_t*)(ws + WS_B0);

    if (IN(PH_P0)) { LAUNDER_TID(); (void)lane; (void)wave; phase_p0(args, lds, tid, lane, wave, vcu, G); } SEAM(PH_P0);
#if DBG_STAGE == 1
    if (IN(PH_Z1)) { LAUNDER_TID(); (void)lane; (void)wave; phase_final_plain(args, args.in[I_X], lane, wave, vcu, G); }
#else
    if (IN(PH_Z1)) {
        OpsPlain O{(const char*)B0, (const char*)(ws + WS_WIN), 2048u, 2048u}; StaticOrder S; S.init_tiles(T / 256, 5120 / 256, G, bx);
        EpiZ1 E{(bf16_t*)(ws + WS_B1), BUF / 2, (const float*)(ws + WS_RS0), QD_SCALE, 2};
        gemm_phase<EpiZ1, StaticOrder, OpsPlain, true>(lds + RING_OFF, O, 1024, S, E);
    } SEAM(PH_Z1);
    if (IN(PH_ATT)) { LAUNDER_TID(); (void)lane; (void)wave; phase_att_naive(args, lds, tid, vcu, G); } SEAM(PH_ATT);
    if (IN(PH_MLSTM)) { LAUNDER_TID(); (void)lane; (void)wave; phase_mlstm_naive(args, lds, tid, lane, wave, vcu, G); } SEAM(PH_MLSTM);
    if (IN(PH_Z3)) {
        OpsPlain O{(const char*)B0, (const char*)(ws + WS_WIN) + (size_t)5120 * 2048, 2048u, 2048u}; StaticOrder S; S.init_tiles(T / 256, 3072 / 256, G, bx);
        EpiZ3 E{(bf16_t*)(ws + WS_B2), (bf16_t*)(ws + WS_B1), (bf16_t*)(ws + WS_B4), (const float*)(ws + WS_RS0), args.in[I_B_GATE]};
        gemm_phase<EpiZ3, StaticOrder, OpsPlain, true>(lds + RING_OFF, O, 1024, S, E);
    } SEAM(PH_Z3);
    if (IN(PH_BR1)) {
        OpsPlain O{(const char*)(ws + WS_B2), (const char*)(ws + WS_WBM), 2048u, 2048u}; StaticOrder S; S.init_tiles(T / 256, 4, G, bx);
        EpiGate E{(const bf16_t*)(ws + WS_B1), nullptr, (bf16_t*)(ws + WS_B5)};
        gemm_phase<EpiGate, StaticOrder, OpsPlain, true>(lds + RING_OFF, O, 1024, S, E);
    } SEAM(PH_BR1);
    if (IN(PH_CP1)) {
        OpsPlain O{(const char*)(ws + WS_MEMN), (const char*)(ws + WS_WKV), 2048u, 2048u}; StaticOrder S; S.init_tiles(NB * NMEM / 256, 8, G, bx);
        EpiPlain E{(bf16_t*)(ws + WS_KV), 2048, 1.0f};
        gemm_phase<EpiPlain, StaticOrder, OpsPlain, true>(lds + RING_OFF, O, 1024, S, E);
    } SEAM(PH_CP1);
    if (IN(PH_BR2)) {
        OpsPlain O{(const char*)(ws + WS_B3), (const char*)(ws + WS_WBD), 2048u, 2048u}; StaticOrder S; S.init_tiles(T / 256, 4, G, bx);
        EpiGate E{(const bf16_t*)(ws + WS_B4), (const bf16_t*)(ws + WS_B5), (bf16_t*)(ws + WS_B0)};
        gemm_phase<EpiGate, StaticOrder, OpsPlain, true>(lds + RING_OFF, O, 1024, S, E);
    } SEAM(PH_BR2);
    if (IN(PH_CP2)) {
        { OpsWp O{(const char*)(ws + WS_KV), (const char*)(ws + WS_WQG), 4096u, 2048u}; StaticOrder S; S.init_tiles(NB * 4, 4, G, bx);
          EpiPlain E{(bf16_t*)(ws + WS_WPT), 1024, XS_SCALE};
          gemm_phase<EpiPlain, StaticOrder, OpsWp, true>(lds + RING_OFF, O, 256, S, E); }
    } SEAM(PH_CP2);
    if (IN(PH_CP3)) {
        { OpsVp O{(const char*)(ws + WS_WO), (const char*)(ws + WS_KV), 2048u, 4096u}; StaticOrder S; S.init_tiles(NB * 4, 4, G, bx);
          EpiPlain E{(bf16_t*)(ws + WS_VPT), 1024, 1.0f};
          gemm_phase<EpiPlain, StaticOrder, OpsVp, true>(lds + RING_OFF, O, 256, S, E); }
    } SEAM(PH_CP3);
    if (IN(PH_OUT)) {
        OpsPlain O{(const char*)B0, (const char*)(ws + WS_WOUT), 2048u, 2048u}; StaticOrder S; S.init_tiles(T / 256, 4, G, bx);
        EpiRes E{args.in[I_X], args.out, (bf16_t*)(ws + WS_B1), (float*)(ws + WS_SS1)};
        gemm_phase<EpiRes, StaticOrder, OpsPlain, true>(lds + RING_OFF, O, 1024, S, E);
    } SEAM(PH_OUT);
#if DBG_STAGE == 2
    if (IN(PH_RS1)) { LAUNDER_TID(); (void)lane; (void)wave; phase_final_plain(args, args.out, lane, wave, vcu, G); }
#else
    if (IN(PH_RS1)) { LAUNDER_TID(); (void)lane; (void)wave; phase_rs1(args, tid, vcu, G); } SEAM(PH_RS1);
    if (IN(PH_S)) {
        OpsBatchB O{(const char*)(ws + WS_B1), (const char*)(ws + WS_WPT), 2048u, 2048u, (size_t)1024 * 1024 * 2}; StaticOrder S; S.init_tiles(T / 256, 4, G, bx);
        EpiS E{(bf16_t*)(ws + WS_B3), (const float*)(ws + WS_RS1), (float*)(ws + WS_PSUM)};
        gemm_phase<EpiS, StaticOrder, OpsBatchB, true>(lds + RING_OFF, O, 1024, S, E);
    } SEAM(PH_S);
    if (IN(PH_PN)) { LAUNDER_TID(); (void)lane; (void)wave; phase_pnorm(args, lane, wave, vcu, G); } SEAM(PH_PN);
    if (IN(PH_PV)) {
        OpsBatchB O{(const char*)(ws + WS_B3), (const char*)(ws + WS_VPT), 2048u, 2048u, (size_t)1024 * 1024 * 2}; StaticOrder S; S.init_tiles(T / 256, 4, G, bx);
        EpiRes E{args.out, args.out, (bf16_t*)(ws + WS_B0), (float*)(ws + WS_SS1)};
        gemm_phase<EpiRes, StaticOrder, OpsBatchB, true>(lds + RING_OFF, O, 1024, S, E);
    } SEAM(PH_PV);
#if DBG_STAGE == 3
    if (IN(PH_ROUTER)) { LAUNDER_TID(); (void)lane; (void)wave; phase_final_plain(args, args.out, lane, wave, vcu, G); }
#else
    if (IN(PH_ROUTER)) { LAUNDER_TID(); (void)lane; (void)wave; phase_router(args, lds, tid, lane, wave); } SEAM(PH_ROUTER);
    if (IN(PH_SLOT)) { LAUNDER_TID(); (void)lane; (void)wave; phase_slot(args, lds, tid); } SEAM(PH_SLOT);
#define MOE_HALF(hf, PG1, PG2, PC) \
    if (IN(PG1)) { const int nT = ((const int*)(ws + WS_MISC))[8192 + 2 * HTILES + (hf)]; const int* tl = (const int*)(ws + WS_TOKL) + (size_t)(hf) * HSLOTS; const int* te = (const int*)(ws + WS_MISC) + 8192 + (hf) * HTILES; \
        OpsG1 O{(const char*)B0, (const char*)(ws + WS_WGU), tl, te, 2048u, 2048u}; StaticOrder S; S.init_tiles(nT, 8, G, bx); \
        EpiG1 E{(bf16_t*)(ws + WS_H), (const float*)(ws + WS_RS2), tl, te, args.in[I_B_GU]}; \
        gemm_phase<EpiG1, StaticOrder, OpsG1, true>(lds + RING_OFF, O, 1024, S, E); } SEAM(PG1); \
    if (IN(PG2)) { const int nT = ((const int*)(ws + WS_MISC))[8192 + 2 * HTILES + (hf)]; const int* te = (const int*)(ws + WS_MISC) + 8192 + (hf) * HTILES; \
        OpsG2 O{(const char*)(ws + WS_H), (const char*)(ws + WS_WDN), te, 2048u, 2048u}; StaticOrder S; S.init_tiles(nT, 4, G, bx); \
        EpiG2 E{(bf16_t*)(ws + WS_Y), te, args.in[I_B_DN]}; \
        gemm_phase<EpiG2, StaticOrder, OpsG2, true>(lds + RING_OFF, O, 1024, S, E); } SEAM(PG2); \
    if (IN(PC)) { LAUNDER_TID(); (void)lane; (void)wave; phase_combine(args, (hf), lane, wave, vcu, G); } SEAM(PC);
    MOE_HALF(0, PH_G1A, PH_G2A, PH_CA)
    MOE_HALF(1, PH_G1B, PH_G2B, PH_CB)
#endif
#endif
#endif
#undef IN
#undef SEAM
}

#ifndef MK_ONE_LAUNCH
#define MK_ONE_LAUNCH 0
#endif
extern "C" void kernel_launch(void* const* d_in, const int* in_sizes, int n_in, void* d_out, int out_size, void* d_ws, size_t ws_size, hipStream_t stream) {
    static int grid = 0;
    if (grid == 0) {
        if (n_in != N_INPUTS || out_size != T * D || ws_size < WS_END) { fprintf(stderr, "kernel_launch: unexpected shapes (n_in %d, out %d, ws %zu)\n", n_in, out_size, ws_size); grid = -1; return; }
        int dev = 0, cus = 0, per_cu = 0;
        if (hipGetDevice(&dev) != hipSuccess || hipDeviceGetAttribute(&cus, hipDeviceAttributeMultiprocessorCount, dev) != hipSuccess) { grid = -1; return; }
        if (hipFuncSetAttribute((const void*)fwd_kernel, hipFuncAttributeMaxDynamicSharedMemorySize, LDS_BYTES) != hipSuccess) { fprintf(stderr, "kernel_launch: hipFuncSetAttribute failed\n"); grid = -1; return; }
        if (hipOccupancyMaxActiveBlocksPerMultiprocessor(&per_cu, (const void*)fwd_kernel, NWAVES * 64, LDS_BYTES) != hipSuccess || per_cu < 1) fprintf(stderr, "kernel_launch: occupancy query reports %d\n", per_cu);
        (void)hipGetLastError();
        grid = cus;
    }
    if (grid < 0) return;
    (void)hipMemsetAsync((char*)d_ws + WS_CTL, 0, CTL_ZERO_BYTES, stream);
    Args a{};
    for (int i = 0; i < N_INPUTS; ++i) a.in[i] = (const float*)d_in[i];
    a.out = (float*)d_out; a.ws = (unsigned char*)d_ws;
#if MK_ONE_LAUNCH
    a.ph_lo = 0; a.ph_hi = N_PHASES;
    hipLaunchKernelGGL(fwd_kernel, dim3(grid), dim3(NWAVES * 64), LDS_BYTES, stream, a);
#else
    for (int p = 0; p < N_PHASES; ++p) { a.ph_lo = p; a.ph_hi = p + 1; hipLaunchKernelGGL(fwd_kernel, dim3(grid), dim3(NWAVES * 64), LDS_BYTES, stream, a); }
#endif
}
```

```cpp
#define MK_ONE_LAUNCH 1
#include <hip/hip_runtime.h>
#include <cstdio>
#include <cstdint>
#include <cmath>
#include <hip/hip_bf16.h>
namespace pg8 {
#define PG8_LAS __attribute__((address_space(3)))
typedef unsigned short bf16_t;
typedef short bf16x8 __attribute__((ext_vector_type(8)));
typedef float f32x4 __attribute__((ext_vector_type(4)));
typedef float f32x2 __attribute__((ext_vector_type(2)));
typedef unsigned u32x4 __attribute__((ext_vector_type(4)));
typedef unsigned u32x2 __attribute__((ext_vector_type(2)));
constexpr int BM = 256, BK = 64, HALF = 128, HTB = HALF * BK * 2  , STAGE_BYTES = 8 * HTB, NXCD = 8, WGM = 8;

__host__ __device__ __forceinline__ int lds_byte(int r, int c) { const int st = (r >> 4) * 2 + (c >> 5), rr = r & 15, cc = c & 31, ob = rr * 64 + cc * 2; return st * 1024 + (ob ^ (((ob >> 9) & 1) << 5)); }
__host__ __device__ __forceinline__ void stage_rc(int b, int& R, int& C) { const int st = b / 1024, sb = b % 1024, swz = sb ^ (((sb >> 9) & 1) << 5); R = (st >> 1) * 16 + swz / 64; C = (st & 1) * 32 + (swz % 64) / 2; }
__host__ __device__ __forceinline__ int perm32(int rho) { const int n = rho >> 4, i = rho & 15; return 8 * (i >> 2) + 4 * n + (i & 3); }

struct Unit { int pm, pn; };

struct StaticOrder {
    int nM, nN, nwg, G, c;
    __device__ __forceinline__ void init_tiles(int nM_, int nN_, int G_, int c_) { nM = nM_; nN = nN_; nwg = nM * nN; G = G_; c = c_; }
    __device__ __forceinline__ bool next(int i, Unit& u) const {
        const long L = (long)i * G + c; if (L >= nwg) return false;
        int wgid = (int)L; { const int q = nwg / NXCD, r = nwg % NXCD, xcd = wgid % NXCD, off = wgid / NXCD; wgid = (xcd < r ? xcd * (q + 1) : r * (q + 1) + (xcd - r) * q) + off; }
        const int nig = WGM * nN, gid = wgid / nig, fm = gid * WGM, gsz = (nM - fm) < WGM ? (nM - fm) : WGM;
        u.pm = fm + ((wgid % nig) % gsz); u.pn = (wgid % nig) / gsz; return true;
    }
    __device__ __forceinline__ void a_ready(const Unit&) const {}
    __device__ __forceinline__ void done(const Unit&) const {}
};

__device__ __forceinline__ unsigned cvt_pk_bf16(float lo, float hi) { unsigned r; asm volatile("v_cvt_pk_bf16_f32 %0, %1, %2" : "=v"(r) : "v"(lo), "v"(hi)); return r; }
__device__ __forceinline__ float bf_lo(unsigned w) { return __uint_as_float(w << 16); }
__device__ __forceinline__ float bf_hi(unsigned w) { return __uint_as_float(w & 0xffff0000u); }
__device__ __forceinline__ float sigmoidf_(float v) { return __builtin_amdgcn_rcpf(1.0f + __builtin_amdgcn_exp2f(-1.4426950408889634f * v)); }


template <class Epi, class Sched, class Ops, bool ALIGN_EPI>
__device__ __forceinline__ void gemm_phase(PG8_LAS unsigned char* lds, const Ops& O, const int K, const Sched& S, const Epi& E) {
    int tid_ = threadIdx.x; asm volatile("" : "+v"(tid_));
    const int tid = tid_, wid = __builtin_amdgcn_readfirstlane(tid >> 6), lane = tid & 63, wr = wid >> 2, wc = wid & 3, fr = lane & 15, fq = lane >> 4;
    int nt_ = K / BK; asm volatile("" : "+s"(nt_)); const int nt = nt_;
    const unsigned lda2 = O.lda2, ldb2 = O.ldb2;
    unsigned voffA[2], voffB[2]; int RA[2], CA2[2];
#pragma unroll
    for (int i = 0; i < 2; ++i) { int R, C; stage_rc(tid * 16 + i * 8192, R, C); const int Rb = Epi::PERM ? ((R & ~31) + perm32(R & 31)) : R;
        RA[i] = R; CA2[i] = C * 2; voffA[i] = (unsigned)R * lda2 + (unsigned)C * 2u; voffB[i] = (unsigned)Rb * ldb2 + (unsigned)C * 2u; }
    const size_t kstep = (size_t)(BK * 2);
    const size_t hstepA = Ops::GATHER ? 0 : (size_t)HALF * lda2, hstepB = (size_t)HALF * ldb2;
    const unsigned ldsw = (unsigned)wid * 1024u;
    const int aoff = lds_byte(wr * 64 + fr, fq * 8), boff = lds_byte(wc * 32 + fr, fq * 8);
    unsigned voC[2][2], voN[2][2];
#define PG8_SA(b, h) (((b) * 2 + (h)) * HTB)
#define PG8_SB(b, h) ((4 + (b) * 2 + (h)) * HTB)
#define PG8_STAGE_B(bufoff, kptr, h) do { _Pragma("unroll") for (int _i = 0; _i < 2; ++_i) \
        __builtin_amdgcn_global_load_lds((const unsigned*)((kptr) + (h) * hstepB + voffB[_i]), (PG8_LAS unsigned*)(lds + (bufoff) + ldsw + _i * 8192), 16, 0, 0); } while (0)
#define PG8_STAGE_A(bufoff, kptr, h) do { _Pragma("unroll") for (int _i = 0; _i < 2; ++_i) \
        __builtin_amdgcn_global_load_lds((const unsigned*)((kptr) + (h) * hstepA + (Ops::GATHER ? voC[h][_i] : voffA[_i])), (PG8_LAS unsigned*)(lds + (bufoff) + ldsw + _i * 8192), 16, 0, 0); } while (0)
#define PG8_LDA(dst, b, h) do { _Pragma("unroll") for (int m = 0; m < 4; ++m) _Pragma("unroll") for (int k = 0; k < 2; ++k) dst[m][k] = *(const PG8_LAS bf16x8*)(lds + PG8_SA(b, h) + aoff + m * 2048 + k * 1024); } while (0)
#define PG8_LDB(dst, b, h) do { _Pragma("unroll") for (int n = 0; n < 2; ++n) _Pragma("unroll") for (int k = 0; k < 2; ++k) dst[n][k] = *(const PG8_LAS bf16x8*)(lds + PG8_SB(b, h) + boff + n * 2048 + k * 1024); } while (0)
#define PG8_MMA(ai, bj, At, Bt) do { __builtin_amdgcn_s_setprio(1); _Pragma("unroll") for (int m = 0; m < 4; ++m) _Pragma("unroll") for (int n = 0; n < 2; ++n) _Pragma("unroll") for (int k = 0; k < 2; ++k) \
        acc[ai][bj][m][n] = __builtin_amdgcn_mfma_f32_16x16x32_bf16(Bt[n][k], At[m][k], acc[ai][bj][m][n], 0, 0, 0); __builtin_amdgcn_s_setprio(0); } while (0)
#define PG8_WAIT_V(n) asm volatile("s_waitcnt vmcnt(" #n ")" ::: "memory")
#define PG8_WAIT_L(n) asm volatile("s_waitcnt lgkmcnt(" #n ")" ::: "memory")
#define PG8_BAR __builtin_amdgcn_s_barrier()
#define PG8_SCHED __builtin_amdgcn_sched_barrier(0)
#define PG8_GLOAD(vo, u) do { if constexpr (Ops::GATHER) { _Pragma("unroll") for (int _h = 0; _h < 2; ++_h) _Pragma("unroll") for (int _i = 0; _i < 2; ++_i) vo[_h][_i] = O.grow(u, _h * HALF + RA[_i]) + (unsigned)CA2[_i]; } } while (0)
    Unit cur, nxt; int ui = 0;
    if (!S.next(0, cur)) return;
    f32x4 acc[2][2][4][2];
#pragma unroll
    for (int a = 0; a < 2; ++a)
#pragma unroll
        for (int b = 0; b < 2; ++b)
#pragma unroll
            for (int m = 0; m < 4; ++m)
#pragma unroll
                for (int n = 0; n < 2; ++n) acc[a][b][m][n] = (f32x4){0.f, 0.f, 0.f, 0.f};
    bf16x8 At[4][2], B0[2][2], B1[2][2];
    const char* cA = O.a_tile(cur); const char* cB = O.b_tile(cur);
    PG8_GLOAD(voC, cur);
    S.a_ready(cur);
    PG8_STAGE_B(PG8_SB(0, 0), cB, 0); PG8_STAGE_B(PG8_SB(0, 1), cB, 1); PG8_STAGE_A(PG8_SA(0, 0), cA, 0); PG8_STAGE_A(PG8_SA(0, 1), cA, 1);
    if (wr == 1) PG8_BAR;
    PG8_WAIT_V(2); PG8_BAR;
    PG8_STAGE_B(PG8_SB(1, 0), cB + kstep, 0); PG8_STAGE_A(PG8_SA(1, 0), cA + kstep, 0); PG8_STAGE_B(PG8_SB(1, 1), cB + kstep, 1);
    PG8_WAIT_V(6); PG8_BAR;
    for (;;) {
        const bool has_next = S.next(ui + 1, nxt);
        const char* nA = has_next ? O.a_tile(nxt) : cA; const char* nB = has_next ? O.b_tile(nxt) : cB;
        if constexpr (Ops::GATHER) { if (has_next) { PG8_GLOAD(voN, nxt); } else {
#pragma unroll
            for (int _h = 0; _h < 2; ++_h)
#pragma unroll
                for (int _i = 0; _i < 2; ++_i) voN[_h][_i] = voC[_h][_i]; } }
        for (int t = 0; t < nt; t += 2) {
            const bool last = (t == nt - 2);
            const char* a1 = cA + (size_t)(t + 1) * kstep;
            const char* a2 = last ? nA : cA + (size_t)(t + 2) * kstep; const char* b2 = last ? nB : cB + (size_t)(t + 2) * kstep;
            const char* a3 = a2 + kstep; const char* b3 = b2 + kstep;
            if (last && has_next) S.a_ready(nxt);
            PG8_LDB(B0, 0, 0); PG8_LDB(B1, 0, 1); PG8_SCHED; PG8_LDA(At, 0, 0); PG8_STAGE_A(PG8_SA(1, 1), a1, 1);
            if constexpr (Ops::GATHER) { if (last) {
#pragma unroll
                for (int _h = 0; _h < 2; ++_h)
#pragma unroll
                    for (int _i = 0; _i < 2; ++_i) voC[_h][_i] = voN[_h][_i]; } }
            PG8_WAIT_V(8); PG8_WAIT_L(0); PG8_BAR; PG8_MMA(0, 0, At, B0); PG8_MMA(0, 1, At, B1); PG8_BAR; PG8_SCHED;
            PG8_LDA(At, 0, 1); PG8_STAGE_B(PG8_SB(0, 0), b2, 0); PG8_STAGE_B(PG8_SB(0, 1), b2, 1); PG8_STAGE_A(PG8_SA(0, 0), a2, 0);
            PG8_WAIT_V(8); PG8_WAIT_L(0); PG8_BAR; PG8_MMA(1, 0, At, B0); PG8_MMA(1, 1, At, B1); PG8_BAR; PG8_SCHED;
            PG8_LDB(B0, 1, 0); PG8_LDB(B1, 1, 1); PG8_SCHED; PG8_LDA(At, 1, 0); PG8_STAGE_A(PG8_SA(0, 1), a2, 1);
            PG8_WAIT_V(8); PG8_WAIT_L(0); PG8_BAR; PG8_MMA(0, 0, At, B0); PG8_MMA(0, 1, At, B1); PG8_BAR; PG8_SCHED;
            PG8_LDA(At, 1, 1); PG8_STAGE_B(PG8_SB(1, 0), b3, 0); PG8_STAGE_B(PG8_SB(1, 1), b3, 1); PG8_STAGE_A(PG8_SA(1, 0), a3, 0);
            PG8_WAIT_V(8); PG8_WAIT_L(0); PG8_BAR; PG8_MMA(1, 0, At, B0); PG8_MMA(1, 1, At, B1); PG8_BAR; PG8_SCHED;
        }
        if constexpr (ALIGN_EPI) { if (wr == 0) PG8_BAR; }
        E(acc, cur, wr, wc, fr, fq); S.done(cur);
        if (!has_next) break;
#pragma unroll
        for (int a = 0; a < 2; ++a)
#pragma unroll
            for (int b = 0; b < 2; ++b)
#pragma unroll
                for (int m = 0; m < 4; ++m)
#pragma unroll
                    for (int n = 0; n < 2; ++n) acc[a][b][m][n] = (f32x4){0.f, 0.f, 0.f, 0.f};
        cur = nxt; cA = nA; cB = nB; ++ui;
        if constexpr (ALIGN_EPI) { if (wr == 1) PG8_BAR; }
    }
    PG8_WAIT_V(0);
    if constexpr (!ALIGN_EPI) { if (wr == 0) PG8_BAR; }
    PG8_BAR;
#undef PG8_SA
#undef PG8_SB
#undef PG8_STAGE_A
#undef PG8_STAGE_B
#undef PG8_LDA
#undef PG8_LDB
#undef PG8_MMA
#undef PG8_WAIT_V
#undef PG8_WAIT_L
#undef PG8_BAR
#undef PG8_SCHED
#undef PG8_GLOAD
}
}
namespace pg8 {
struct OpsPlain { static constexpr bool GATHER = false; const char* A; const char* B; unsigned lda2, ldb2;
    __device__ __forceinline__ const char* a_tile(const Unit& u) const { return A + (size_t)u.pm * 256 * lda2; }
    __device__ __forceinline__ const char* b_tile(const Unit& u) const { return B + (size_t)u.pn * 256 * ldb2; }
    __device__ __forceinline__ unsigned grow(const Unit&, int) const { return 0u; } };
struct OpsBatchB { static constexpr bool GATHER = false; const char* A; const char* B; unsigned lda2, ldb2; size_t bstride;
    __device__ __forceinline__ const char* a_tile(const Unit& u) const { return A + (size_t)u.pm * 256 * lda2; }
    __device__ __forceinline__ const char* b_tile(const Unit& u) const { return B + (size_t)(u.pm >> 4) * bstride + (size_t)u.pn * 256 * ldb2; }
    __device__ __forceinline__ unsigned grow(const Unit&, int) const { return 0u; } };
struct OpsWp { static constexpr bool GATHER = false; const char* kv; const char* wq; unsigned lda2, ldb2;
    __device__ __forceinline__ const char* a_tile(const Unit& u) const { return kv + (size_t)(u.pm >> 2) * 256 * 4096 + (size_t)(u.pm & 3) * 512; }
    __device__ __forceinline__ const char* b_tile(const Unit& u) const { return wq + (size_t)u.pn * 256 * 2048 + (size_t)(u.pm & 3) * 512; }
    __device__ __forceinline__ unsigned grow(const Unit&, int) const { return 0u; } };
struct OpsVp { static constexpr bool GATHER = false; const char* wo; const char* kv; unsigned lda2, ldb2;
    __device__ __forceinline__ const char* a_tile(const Unit& u) const { return wo + (size_t)(u.pm & 3) * 256 * 2048 + (size_t)u.pn * 512; }
    __device__ __forceinline__ const char* b_tile(const Unit& u) const { return kv + (size_t)(u.pm >> 2) * 256 * 4096 + 2048 + (size_t)u.pn * 512; }
    __device__ __forceinline__ unsigned grow(const Unit&, int) const { return 0u; } };
struct OpsG1 { static constexpr bool GATHER = true; const char* A; const char* W; const int* toklist; const int* tile_e; unsigned lda2, ldb2;
    __device__ __forceinline__ const char* a_tile(const Unit&) const { return A; }
    __device__ __forceinline__ const char* b_tile(const Unit& u) const { return W + (size_t)tile_e[u.pm] * ((size_t)2048 * 1024 * 2) + (size_t)u.pn * 256 * 2048; }
    __device__ __forceinline__ unsigned grow(const Unit& u, int r) const { return (unsigned)toklist[u.pm * 256 + r] * 2048u; } };
struct OpsG2 { static constexpr bool GATHER = false; const char* A; const char* W; const int* tile_e; unsigned lda2, ldb2;
    __device__ __forceinline__ const char* a_tile(const Unit& u) const { return A + (size_t)u.pm * 256 * 2048; }
    __device__ __forceinline__ const char* b_tile(const Unit& u) const { return W + (size_t)tile_e[u.pm] * ((size_t)1024 * 1024 * 2) + (size_t)u.pn * 256 * 2048; }
    __device__ __forceinline__ unsigned grow(const Unit&, int) const { return 0u; } };

#define EPI_ARGS const f32x4 (&acc)[2][2][4][2], const Unit& u, int wr, int wc, int fr, int fq
__device__ __forceinline__ u32x4 pack8(const f32x4 a, const f32x4 b) { u32x4 w; w.x = cvt_pk_bf16(a[0], a[1]); w.y = cvt_pk_bf16(a[2], a[3]); w.z = cvt_pk_bf16(b[0], b[1]); w.w = cvt_pk_bf16(b[2], b[3]); return w; }
__device__ __forceinline__ void unpack8(const u32x4 w, f32x4& a, f32x4& b) { a = (f32x4){bf_lo(w.x), bf_hi(w.x), bf_lo(w.y), bf_hi(w.y)}; b = (f32x4){bf_lo(w.z), bf_hi(w.z), bf_lo(w.w), bf_hi(w.w)}; }

struct EpiZ1 { static constexpr bool PERM = true; bf16_t* O; size_t tstride; const float* rs; float qscale; int qtile;
    __device__ __forceinline__ void operator()(EPI_ARGS) const {
        const int t = u.pn >> 2; bf16_t* base = O + (size_t)t * tstride; const float sc = (t == qtile) ? qscale : 1.f;
        const int col0 = (u.pn & 3) * 256 + wc * 32 + 8 * fq;
#pragma unroll
        for (int ai = 0; ai < 2; ++ai)
#pragma unroll
            for (int m = 0; m < 4; ++m) { const int r = u.pm * 256 + ai * 128 + wr * 64 + m * 16 + fr; const float s = rs[r] * sc; bf16_t* rowp = base + (size_t)r * 1024 + col0;
#pragma unroll
                for (int bj = 0; bj < 2; ++bj) *(u32x4*)(rowp + bj * 128) = pack8(acc[ai][bj][m][0] * s, acc[ai][bj][m][1] * s); }
    } };
struct EpiZ3 { static constexpr bool PERM = true; bf16_t* HM; bf16_t* GM; bf16_t* GD; const float* rs; const float* bgate;
    __device__ __forceinline__ void operator()(EPI_ARGS) const {
        const int t = u.pn >> 2; const int col0 = (u.pn & 3) * 256 + wc * 32 + 8 * fq;
        if (t == 0) {
#pragma unroll
            for (int ai = 0; ai < 2; ++ai)
#pragma unroll
                for (int m = 0; m < 4; ++m) { const int r = u.pm * 256 + ai * 128 + wr * 64 + m * 16 + fr; const float s = rs[r]; bf16_t* rowp = HM + (size_t)r * 1024 + col0;
#pragma unroll
                    for (int bj = 0; bj < 2; ++bj) { f32x4 h0, h1; unpack8(*(const u32x4*)(rowp + bj * 128), h0, h1); f32x4 o0, o1;
#pragma unroll
                        for (int i = 0; i < 4; ++i) { o0[i] = sigmoidf_(acc[ai][bj][m][0][i] * s) * h0[i]; o1[i] = sigmoidf_(acc[ai][bj][m][1][i] * s) * h1[i]; }
                        *(u32x4*)(rowp + bj * 128) = pack8(o0, o1); } }
        } else {
            bf16_t* dst = (t == 1) ? GM : GD; const float* bb = bgate + (t - 1) * 1024 + col0;
            f32x4 bv[2][2];
#pragma unroll
            for (int bj = 0; bj < 2; ++bj)
#pragma unroll
                for (int n = 0; n < 2; ++n) bv[bj][n] = *(const f32x4*)(bb + bj * 128 + 4 * n);
#pragma unroll
            for (int ai = 0; ai < 2; ++ai)
#pragma unroll
                for (int m = 0; m < 4; ++m) { const int r = u.pm * 256 + ai * 128 + wr * 64 + m * 16 + fr; const float s = rs[r]; bf16_t* rowp = dst + (size_t)r * 1024 + col0;
#pragma unroll
                    for (int bj = 0; bj < 2; ++bj) { f32x4 o0, o1;
#pragma unroll
                        for (int i = 0; i < 4; ++i) { o0[i] = sigmoidf_(acc[ai][bj][m][0][i] * s + bv[bj][0][i]); o1[i] = sigmoidf_(acc[ai][bj][m][1][i] * s + bv[bj][1][i]); }
                        *(u32x4*)(rowp + bj * 128) = pack8(o0, o1); } }
        }
    } };
struct EpiGate { static constexpr bool PERM = true; const bf16_t* Gt; const bf16_t* ADD; bf16_t* Out;
    __device__ __forceinline__ void operator()(EPI_ARGS) const {
        const int col0 = u.pn * 256 + wc * 32 + 8 * fq;
#pragma unroll
        for (int ai = 0; ai < 2; ++ai)
#pragma unroll
            for (int m = 0; m < 4; ++m) { const size_t ro = (size_t)(u.pm * 256 + ai * 128 + wr * 64 + m * 16 + fr) * 1024 + col0;
#pragma unroll
                for (int bj = 0; bj < 2; ++bj) { f32x4 g0, g1; unpack8(*(const u32x4*)(Gt + ro + bj * 128), g0, g1); f32x4 o0 = g0 * acc[ai][bj][m][0], o1 = g1 * acc[ai][bj][m][1];
                    if (ADD) { f32x4 a0, a1; unpack8(*(const u32x4*)(ADD + ro + bj * 128), a0, a1); o0 += a0; o1 += a1; }
                    *(u32x4*)(Out + ro + bj * 128) = pack8(o0, o1); } }
    } };
struct EpiRes { static constexpr bool PERM = false; const float* base; float* out; bf16_t* xb; float* ss;
    __device__ __forceinline__ void operator()(EPI_ARGS) const {
        const int col0 = u.pn * 256 + wc * 32 + 4 * fq;
#pragma unroll
        for (int ai = 0; ai < 2; ++ai)
#pragma unroll
            for (int m = 0; m < 4; ++m) { const int r = u.pm * 256 + ai * 128 + wr * 64 + m * 16 + fr; const size_t ro = (size_t)r * 1024 + col0; float sq = 0.f;
#pragma unroll
                for (int bj = 0; bj < 2; ++bj)
#pragma unroll
                    for (int n = 0; n < 2; ++n) { const size_t off = ro + bj * 128 + n * 16; const f32x4 o = *(const f32x4*)(base + off) + acc[ai][bj][m][n]; *(f32x4*)(out + off) = o;
                        u32x2 w; w.x = cvt_pk_bf16(o[0], o[1]); w.y = cvt_pk_bf16(o[2], o[3]); *(u32x2*)(xb + off) = w; sq += (o[0] * o[0] + o[1] * o[1]) + (o[2] * o[2] + o[3] * o[3]); }
                sq += __shfl_xor(sq, 16); sq += __shfl_xor(sq, 32);
                if (fq == 0) ss[(size_t)r * 16 + u.pn * 4 + wc] = sq; }
    } };
struct EpiS { static constexpr bool PERM = true; bf16_t* P; const float* rs; float* psum;
    __device__ __forceinline__ void operator()(EPI_ARGS) const {
        const int col0 = u.pn * 256 + wc * 32 + 8 * fq;
#pragma unroll
        for (int ai = 0; ai < 2; ++ai)
#pragma unroll
            for (int m = 0; m < 4; ++m) { const int r = u.pm * 256 + ai * 128 + wr * 64 + m * 16 + fr; const float s = rs[r]; float sum = 0.f;
#pragma unroll
                for (int bj = 0; bj < 2; ++bj) { f32x4 e0, e1;
#pragma unroll
                    for (int i = 0; i < 4; ++i) { e0[i] = __builtin_amdgcn_exp2f(acc[ai][bj][m][0][i] * s); e1[i] = __builtin_amdgcn_exp2f(acc[ai][bj][m][1][i] * s); }
                    sum += ((e0[0] + e0[1]) + (e0[2] + e0[3])) + ((e1[0] + e1[1]) + (e1[2] + e1[3]));
                    *(u32x4*)(P + (size_t)r * 1024 + col0 + bj * 128) = pack8(e0, e1); }
                sum += __shfl_xor(sum, 16); sum += __shfl_xor(sum, 32);
                if (fq == 0) psum[(size_t)r * 16 + u.pn * 4 + wc] = sum; }
    } };
struct EpiPlain { static constexpr bool PERM = true; bf16_t* O; int ldc; float scale;
    __device__ __forceinline__ void operator()(EPI_ARGS) const {
        const int col0 = u.pn * 256 + wc * 32 + 8 * fq;
#pragma unroll
        for (int ai = 0; ai < 2; ++ai)
#pragma unroll
            for (int m = 0; m < 4; ++m) { bf16_t* rowp = O + (size_t)(u.pm * 256 + ai * 128 + wr * 64 + m * 16 + fr) * ldc + col0;
#pragma unroll
                for (int bj = 0; bj < 2; ++bj) *(u32x4*)(rowp + bj * 128) = pack8(acc[ai][bj][m][0] * scale, acc[ai][bj][m][1] * scale); }
    } };
struct EpiG1 { static constexpr bool PERM = true; bf16_t* H; const float* rs; const int* toklist; const int* tile_e; const float* bgu;
    __device__ __forceinline__ void operator()(EPI_ARGS) const {
        const int e = tile_e[u.pm]; const int colh = u.pn * 128 + wc * 32 + 8 * fq; const float* bg = bgu + (size_t)e * 2048 + colh;
        f32x4 bgv[2], buv[2];
#pragma unroll
        for (int n = 0; n < 2; ++n) { bgv[n] = *(const f32x4*)(bg + 4 * n); buv[n] = *(const f32x4*)(bg + 1024 + 4 * n); }
#pragma unroll
        for (int ai = 0; ai < 2; ++ai)
#pragma unroll
            for (int m = 0; m < 4; ++m) { const int slot = u.pm * 256 + ai * 128 + wr * 64 + m * 16 + fr; const float s = rs[toklist[slot]]; f32x4 o[2];
#pragma unroll
                for (int n = 0; n < 2; ++n)
#pragma unroll
                    for (int i = 0; i < 4; ++i) { const float g = fminf(acc[ai][0][m][n][i] * s + bgv[n][i], 7.0f); const float up = fminf(fmaxf(acc[ai][1][m][n][i] * s + buv[n][i], -7.0f), 7.0f);
                        o[n][i] = (up + 1.0f) * (g * sigmoidf_(1.702f * g)); }
                *(u32x4*)(H + (size_t)slot * 1024 + colh) = pack8(o[0], o[1]); }
    } };
struct EpiG2 { static constexpr bool PERM = true; bf16_t* Y; const int* tile_e; const float* bdn;
    __device__ __forceinline__ void operator()(EPI_ARGS) const {
        const int e = tile_e[u.pm]; const int col0 = u.pn * 256 + wc * 32 + 8 * fq; const float* bb = bdn + (size_t)e * 1024 + col0;
        f32x4 bv[2][2];
#pragma unroll
        for (int bj = 0; bj < 2; ++bj)
#pragma unroll
            for (int n = 0; n < 2; ++n) bv[bj][n] = *(const f32x4*)(bb + bj * 128 + 4 * n);
#pragma unroll
        for (int ai = 0; ai < 2; ++ai)
#pragma unroll
            for (int m = 0; m < 4; ++m) { bf16_t* rowp = Y + (size_t)(u.pm * 256 + ai * 128 + wr * 64 + m * 16 + fr) * 1024 + col0;
#pragma unroll
                for (int bj = 0; bj < 2; ++bj) *(u32x4*)(rowp + bj * 128) = pack8(acc[ai][bj][m][0] + bv[bj][0], acc[ai][bj][m][1] + bv[bj][1]); }
    } };
#undef EPI_ARGS
}
constexpr int NWAVES = 8;
constexpr int NB = 16, SEQ = 4096, D = 1024, T = NB * SEQ;
constexpr int NMEM = 256, NE = 32, TOPK = 4;
constexpr float EPS = 1e-6f;
constexpr float LOG2E = 1.4426950408889634f;
constexpr float QD_SCALE = 0.125f * LOG2E;
constexpr float XS_SCALE = 0.0625f * LOG2E;
constexpr float LAM_INIT = 0.2f;

constexpr size_t MiB = 1u << 20;
constexpr size_t WS_CTL = 0, CTL_ZERO_BYTES = 1 * MiB;
constexpr size_t WS_RS0 = 1 * MiB;
constexpr size_t WS_RS1 = 1 * MiB + 256 * 1024;
constexpr size_t WS_RS2 = 1 * MiB + 512 * 1024;
constexpr size_t WS_MISC = 1 * MiB + 768 * 1024;
constexpr size_t WS_IF = 2 * MiB;
constexpr size_t WS_SS1 = 4 * MiB;
constexpr size_t WS_PSUM = 12 * MiB;
constexpr size_t WS_TOPI = 16 * MiB, WS_TOPW = 17 * MiB, WS_SLOT = 18 * MiB;
constexpr size_t WS_TOKL = 19 * MiB;
constexpr int HSLOTS = 139264, HTILES = 544;
constexpr size_t WS_WGT = 22 * MiB;
constexpr size_t WS_WIN = 24 * MiB;
constexpr size_t WS_WBM = 40 * MiB, WS_WBD = 42 * MiB, WS_WOUT = 44 * MiB, WS_WQG = 46 * MiB, WS_WKV = 48 * MiB, WS_WO = 52 * MiB;
constexpr size_t WS_MEMN = 54 * MiB;
constexpr size_t WS_B0 = 64 * MiB, BUF = 128 * MiB;
constexpr size_t WS_B1 = WS_B0 + BUF, WS_B2 = WS_B0 + 2 * BUF, WS_B3 = WS_B0 + 3 * BUF, WS_B4 = WS_B0 + 4 * BUF, WS_B5 = WS_B0 + 5 * BUF;
constexpr size_t WS_KV = WS_B2, WS_WPT = WS_B2 + 16 * MiB, WS_VPT = WS_B2 + 48 * MiB;
constexpr size_t WS_H = WS_B1;
constexpr size_t WS_Y = WS_B1 + 272 * MiB;
constexpr size_t WS_WGU = 832 * MiB, WS_WDN = 960 * MiB, WS_END = 1024 * MiB;
static_assert(WS_Y + 272 * MiB <= WS_WGU, "map");

constexpr int CW_TMO = 0, CW_CODE = 1, CW_BAR = 4096;

constexpr int RING_OFF = 0, RING_BYTES = 131072;
constexpr int LDS_BYTES = 163840;
constexpr int MISC_OFF = LDS_BYTES - 512;

#define GAS __attribute__((address_space(1)))
#define LAS __attribute__((address_space(3)))
typedef unsigned short bf16;
typedef unsigned v4u __attribute__((ext_vector_type(4)));
typedef unsigned v2u __attribute__((ext_vector_type(2)));
typedef float f32x4 __attribute__((ext_vector_type(4)));
typedef GAS unsigned gu32;
#define RLX_AGENT __ATOMIC_RELAXED, __HIP_MEMORY_SCOPE_AGENT
#define LDS_WAIT() asm volatile("s_waitcnt lgkmcnt(0)" ::: "memory")
#define VM_WAIT() asm volatile("s_waitcnt vmcnt(0)" ::: "memory")
__device__ __forceinline__ unsigned pk2(float lo, float hi) { return pg8::cvt_pk_bf16(lo, hi); }
__device__ __forceinline__ float bf2f(bf16 v) { return __uint_as_float((unsigned)v << 16); }

#define XB_TMO      128
#define XB_XCNT(j)  (256  + 64 * (j))
#define XB_XSUB(j)  (1280 + 64 * (j))
#define XB_XGEN(j)  (2304 + 64 * (j))
#define XB_TOP      3328
#define XB_TOPGEN   3392
#define XCD_BAR_WORDS 3456
#define XB_SPIN_CAP (1u << 22)
__device__ __forceinline__ unsigned xb_ld(unsigned* p)              { return __hip_atomic_load(p, __ATOMIC_RELAXED, __HIP_MEMORY_SCOPE_AGENT); }
__device__ __forceinline__ unsigned xb_add(unsigned* p, unsigned v) { return __hip_atomic_fetch_add(p, v, __ATOMIC_RELAXED, __HIP_MEMORY_SCOPE_AGENT); }
__device__ __forceinline__ unsigned xb_xcc_id() { return (unsigned)__builtin_amdgcn_s_getreg((3 << 11) | 20) & 0xFu; }
#define XB_SPIN(cond, bar) do { unsigned _sp = 0; while (cond) { __builtin_amdgcn_s_sleep(1); \
    if ((++_sp & 255u) == 0u) { if (xb_ld(&(bar)[XB_TMO])) break; if (_sp > XB_SPIN_CAP) { atomicAdd(&(bar)[XB_TMO], 1u); break; } } } } while (0)
struct XcdBarrier { unsigned* bar; unsigned x; volatile LAS unsigned* st; };
__device__ __forceinline__ XcdBarrier xcd_barrier_post(unsigned* bar, volatile LAS unsigned* st) {
    XcdBarrier b; b.bar = bar; b.x = xb_xcc_id(); b.st = st;
    if (threadIdx.x == 0) (void)xb_add(&bar[XB_XCNT(b.x)], 1u);
    return b;
}
__device__ __forceinline__ void xcd_barrier_complete(unsigned* bar, unsigned x, unsigned& nloc, unsigned& nx) {
    const unsigned G = gridDim.x * gridDim.y * gridDim.z;
    unsigned sum, cnt, mine, sp = 0u;
    for (;;) {
        sum = 0u; cnt = 0u; mine = 0u;
#pragma unroll
        for (unsigned j = 0; j < 16; ++j) { const unsigned c = xb_ld(&bar[XB_XCNT(j)]); sum += c; cnt += (c > 0u) ? 1u : 0u; mine = (j == x) ? c : mine; }
        if (sum == G) break;
        __builtin_amdgcn_s_sleep(1);
        if ((++sp & 255u) == 0u) { if (xb_ld(&bar[XB_TMO])) break; if (sp > XB_SPIN_CAP) { atomicAdd(&bar[XB_TMO], 1u); break; } }
    }
    nloc = mine > 0u ? mine : 1u; nx = cnt > 0u ? cnt : 1u;
}
__device__ __forceinline__ void xcd_barrier(const XcdBarrier& b) {
    asm volatile("s_waitcnt vmcnt(0)" ::: "memory");
    __syncthreads();
    if (threadIdx.x == 0) {
        unsigned* bar = b.bar;
        __builtin_amdgcn_s_waitcnt(0);
        unsigned nloc = b.st[0], nx = b.st[1];
        if (nloc == 0u) { xcd_barrier_complete(bar, b.x, nloc, nx); b.st[0] = nloc; b.st[1] = nx; }
        const unsigned old = xb_add(&bar[XB_XSUB(b.x)], 1u);
        const unsigned gen = old / nloc;
        if (old + 1u == (gen + 1u) * nloc) {
            __builtin_amdgcn_fence(__ATOMIC_RELEASE, "agent");
            asm volatile("s_waitcnt vmcnt(0)" ::: "memory");
            const unsigned og = xb_add(&bar[XB_TOP], 1u);
            const unsigned tg = og / nx;
            if (og + 1u == (tg + 1u) * nx) xb_add(&bar[XB_TOPGEN], 1u);
            else XB_SPIN(xb_ld(&bar[XB_TOPGEN]) == tg, bar);
            __builtin_amdgcn_fence(__ATOMIC_ACQUIRE, "agent");
            xb_add(&bar[XB_XGEN(b.x)], 1u);
            asm volatile("s_waitcnt vmcnt(0)" ::: "memory");
        } else {
            XB_SPIN(xb_ld(&bar[XB_XGEN(b.x)]) == gen, bar);
            __builtin_amdgcn_fence(__ATOMIC_ACQUIRE, "agent");
            asm volatile("s_waitcnt vmcnt(0)" ::: "memory");
        }
    }
    __syncthreads();
}

enum { I_X = 0, I_MEM, I_NORM_MIX, I_W_IN, I_CONV_W, I_B_IF, I_MGAIN, I_DLAM, I_DGAIN, I_W_BM, I_W_BD, I_B_GATE, I_W_OUT, I_NORM_XATTN, I_NORM_MEM, I_WQ, I_WKV, I_WO,
       I_NORM_FFN, I_W_R, I_B_R, I_W_GU, I_B_GU, I_W_DN, I_B_DN, I_NORM_FINAL, N_INPUTS };
struct Args { const float* in[N_INPUTS]; float* out; unsigned char* ws; int ph_lo, ph_hi; };

__device__ __forceinline__ float wave_sum(float v) {
#pragma unroll
    for (int o = 1; o < 64; o <<= 1) v += __shfl_xor(v, o);
    return v;
}
#include <hip/hip_bf16.h>
#include <cmath>
namespace attn_body {
using bf16=__hip_bfloat16;
using bf16x8=__attribute__((ext_vector_type(8)))short;
using s16x4=__attribute__((ext_vector_type(4)))short;
using f32x16=__attribute__((ext_vector_type(16)))float;
using u32x4=__attribute__((ext_vector_type(4)))unsigned;
constexpr int BATCH=16,NHEAD=16,SEQ=4096,D=64,DM=NHEAD*D;
constexpr int NW=8,QBLK=32,QB=QBLK*NW,KVBLK=64,NQB=SEQ/QB;
constexpr int ATTN_PITCH=DM, ATTN_UNIT_ROWS=QB;
__device__ __forceinline__ int crow(int r,int hi){return (r&3)+8*(r>>2)+4*hi;}
#define SBAR() __builtin_amdgcn_sched_barrier(0)
__device__ __forceinline__ void cmask(f32x16&p0,f32x16&p1,int jb,int wchunk){
  if(jb>wchunk){ const float NEG=-INFINITY;
  #pragma unroll
  for(int r=0;r<16;++r){p0[r]=NEG;p1[r]=NEG;} }
}

constexpr int NSLOT=3, SLOTB=8192;
constexpr int LDS_K=0, LDS_V=NSLOT*SLOTB, LDS_WS=2*NSLOT*SLOTB, LDS_OST=LDS_WS+NW*64*4, LDS_OS=86016, LDS_BYTES=LDS_OS+NW*8192;
constexpr float C2=0.125f*1.4426950408889634f;
__device__ __forceinline__ void glds16(const void*gsrc,unsigned lds_dst){unsigned keep;
  asm volatile("s_mov_b32 %0, m0\n\ts_mov_b32 m0, %2\n\ts_nop 0\n\tglobal_load_lds_dwordx4 %1, off\n\ts_mov_b32 m0, %0":"=&s"(keep):"v"(gsrc),"s"(lds_dst):"memory");}
__device__ __forceinline__ float max3f(float a,float b,float c){float r;asm("v_max3_f32 %0, %1, %2, %3":"=v"(r):"v"(a),"v"(b),"v"(c));return r;}
__device__ __forceinline__ float max2f(float a,float b){float r;asm("v_max_f32_e32 %0, %1, %2":"=v"(r):"v"(a),"v"(b));return r;}
__device__ __forceinline__ float fadd_s(float a,float b){float r;asm("v_add_f32_e32 %0, %1, %2":"=v"(r):"v"(a),"v"(b));return r;}
__device__ __forceinline__ float fsub_s(float a,float b){float r;asm("v_sub_f32_e32 %0, %1, %2":"=v"(r):"v"(a),"v"(b));return r;}
typedef float f32x2_t __attribute__((ext_vector_type(2))); typedef __bf16 bf16x2_t __attribute__((ext_vector_type(2)));
__device__ __forceinline__ unsigned cvtpk_s(float lo,float hi){f32x2_t v={lo,hi};bf16x2_t b=__builtin_convertvector(v,bf16x2_t);return __builtin_bit_cast(unsigned,b);}
#define WAIT_BAR(N) asm volatile("s_waitcnt vmcnt(" #N ") lgkmcnt(0)\n\ts_barrier":::"memory")

__device__ __forceinline__ void qkt(f32x16&p0,f32x16&p1,const char*Kslot,const bf16x8*qr,const f32x16&negm,int r32,int hi){
  const char*kb=Kslot+hi*1024+r32*16;
  #pragma unroll
  for(int d0=0;d0<4;++d0){
    const bf16x8 b0=*reinterpret_cast<const bf16x8*>(kb+d0*2048);
    const bf16x8 b1=*reinterpret_cast<const bf16x8*>(kb+d0*2048+512);
    if(d0==0){p0=__builtin_amdgcn_mfma_f32_32x32x16_bf16(b0,qr[0],negm,0,0,0);p1=__builtin_amdgcn_mfma_f32_32x32x16_bf16(b1,qr[0],negm,0,0,0);}
    else{p0=__builtin_amdgcn_mfma_f32_32x32x16_bf16(b0,qr[d0],p0,0,0,0);p1=__builtin_amdgcn_mfma_f32_32x32x16_bf16(b1,qr[d0],p1,0,0,0);}}
}
typedef __attribute__((address_space(3))) const char* lds_cptr;
typedef short v4i16_t __attribute__((ext_vector_type(4)));
__device__ __forceinline__ void kload8(bf16x8*kf,lds_cptr kp){
  kf[0]=*(const __attribute__((address_space(3))) bf16x8*)(kp);      kf[1]=*(const __attribute__((address_space(3))) bf16x8*)(kp+512);
  kf[2]=*(const __attribute__((address_space(3))) bf16x8*)(kp+2048); kf[3]=*(const __attribute__((address_space(3))) bf16x8*)(kp+2560);
  kf[4]=*(const __attribute__((address_space(3))) bf16x8*)(kp+4096); kf[5]=*(const __attribute__((address_space(3))) bf16x8*)(kp+4608);
  kf[6]=*(const __attribute__((address_space(3))) bf16x8*)(kp+6144); kf[7]=*(const __attribute__((address_space(3))) bf16x8*)(kp+6656);
}
__device__ __forceinline__ void kload2(bf16x8*kf,lds_cptr kp,int j){ kf[2*j]=*(const __attribute__((address_space(3))) bf16x8*)(kp+j*2048); kf[2*j+1]=*(const __attribute__((address_space(3))) bf16x8*)(kp+j*2048+512); }
__device__ __forceinline__ s16x4 vtr(lds_cptr p){ return __builtin_bit_cast(s16x4,__builtin_amdgcn_ds_read_tr16_b64_v4i16((__attribute__((address_space(3))) v4i16_t*)p)); }
__device__ __forceinline__ float rowmax(const f32x16&p0,const f32x16&p1){
  float a=max3f(p0[0],p0[1],p1[0]),b=max3f(p0[2],p0[3],p1[1]);a=max3f(a,p1[2],p1[3]);
  #pragma unroll
  for(int r=4;r<16;r+=4){a=max3f(a,p0[r],p0[r+1]);b=max3f(b,p0[r+2],p0[r+3]);a=max3f(a,p1[r],p1[r+1]);b=max3f(b,p1[r+2],p1[r+3]);}
  const float m=max2f(a,b);
  auto rr=__builtin_amdgcn_permlane32_swap(__float_as_uint(m),__float_as_uint(m),false,false);
  return max2f(__uint_as_float(rr[0]),__uint_as_float(rr[1]));
}
__device__ __forceinline__ void pv(f32x16*o,int vb,bf16x8 pa0,bf16x8 pa1,bf16x8 pa2,bf16x8 pa3){
  #pragma unroll
  for(int d0=0;d0<2;++d0){s16x4 lo[4],hi[4];
    #pragma unroll
    for(int ks=0;ks<4;++ks){
      asm volatile("ds_read_b64_tr_b16 %0,%1 offset:%c2":"=&v"(lo[ks]):"v"(vb),"i"(d0*4096+ks*1024):"memory");
      asm volatile("ds_read_b64_tr_b16 %0,%1 offset:%c2":"=&v"(hi[ks]):"v"(vb),"i"(d0*4096+ks*1024+512):"memory");}
    asm volatile("s_waitcnt lgkmcnt(0)":::"memory");SBAR();
    #define PK(k) (bf16x8){lo[k][0],lo[k][1],lo[k][2],lo[k][3],hi[k][0],hi[k][1],hi[k][2],hi[k][3]}
    o[d0]=__builtin_amdgcn_mfma_f32_32x32x16_bf16(pa0,PK(0),o[d0],0,0,0);
    o[d0]=__builtin_amdgcn_mfma_f32_32x32x16_bf16(pa1,PK(1),o[d0],0,0,0);
    o[d0]=__builtin_amdgcn_mfma_f32_32x32x16_bf16(pa2,PK(2),o[d0],0,0,0);
    o[d0]=__builtin_amdgcn_mfma_f32_32x32x16_bf16(pa3,PK(3),o[d0],0,0,0);
    #undef PK
  }
}

#ifndef ATTN_STORE16
#define ATTN_STORE16(p,v) (*(u32x4*)(p)=(v))
#endif
template<int THRL> __device__ __forceinline__ void attn_unit(int b,int h,int hv,int qb,int pass,float lam,const float*dgain,const bf16*Q,const bf16*K,const bf16*V,bf16*O,char*shm){
  const int tid=threadIdx.x,lane=tid&63,r32=lane&31,hi=lane>>5; const int wid=__builtin_amdgcn_readfirstlane(tid>>6);
  const long rowbase=(long)b*SEQ; const int q0=qb*QB;
  const bf16*Qw=Q+(rowbase+q0+wid*QBLK)*DM+h*D;
  const bf16*Kh=K+rowbase*DM+h*D,*Vh=V+rowbase*DM+hv*D;
  const unsigned lds0=(unsigned)(uintptr_t)shm;
  float*wsf=(float*)(shm+LDS_WS)+wid*64;
  const bf16*ksrc=Kh+(long)lane*DM+wid*8;
  const bf16*vsrc=Vh+(long)(16*(wid&3)+(lane>>2))*DM+(wid>>2)*32+(lane&3)*8;
  const unsigned kdst=lds0+LDS_K+wid*1024, vdst=lds0+LDS_V+wid*1024;
  #define DMA_K(t,slot) glds16(ksrc+(long)(t)*KVBLK*DM,(unsigned)__builtin_amdgcn_readfirstlane(kdst+(slot)))
  #define DMA_V(t,slot) glds16(vsrc+(long)(t)*KVBLK*DM,(unsigned)__builtin_amdgcn_readfirstlane(vdst+(slot)))
  const int vb0=(int)(lds0+LDS_V)+((lane>>4)&1)*32+(lane&3)*8+(4*hi+((lane&15)>>2))*64;
  const char*Kbase=shm+LDS_K; bf16x8 kf[8];
  const lds_cptr shm3=(lds_cptr)shm; const lds_cptr kp0=shm3+LDS_K+hi*1024+r32*16; const lds_cptr vp0=shm3+LDS_V+((lane>>4)&1)*32+(lane&3)*8+(4*hi+((lane&15)>>2))*64;
  const int NT=(q0+QB)/KVBLK;
  DMA_K(0,0);DMA_V(0,0);DMA_K(1,SLOTB);
  bf16x8 qr[4];
  #pragma unroll
  for(int d0=0;d0<4;++d0)qr[d0]=*reinterpret_cast<const bf16x8*>(&Qw[(long)r32*DM+d0*16+hi*8]);
  float mhat=0.f,l_reg=0.f;f32x16 o[2];o[0]=f32x16{};o[1]=f32x16{};f32x16 negm=f32x16{};asm volatile("":"+v"(negm));
  #define CMASK(P0,P1,t) do{int jb_=(t)-(NT-4); if(jb_>=0)cmask(P0,P1,jb_,wid>>1);}while(0)
  bool resc=false;
  #define START(P0,P1) do{ const float rm=rowmax(P0,P1); resc=false; \
    { const float dl=rm; mhat=fadd_s(mhat,dl); \
      _Pragma("unroll") for(int r=0;r<16;++r){P0[r]=fsub_s(P0[r],dl);P1[r]=fsub_s(P1[r],dl);} \
      _Pragma("unroll") for(int r=0;r<16;++r)negm[r]=-mhat; asm volatile("":"+v"(negm)); } \
    _Pragma("unroll") for(int r=0;r<16;++r)P0[r]=__builtin_amdgcn_exp2f(P0[r]); }while(0)
  #define RESC() do{ if(resc){ asm volatile("s_waitcnt lgkmcnt(0)":::"memory"); \
      _Pragma("unroll") for(int d_=0;d_<2;++d_) _Pragma("unroll") for(int r=0;r<16;++r)o[d_][r]*=wsf[crow(r,hi)]; } }while(0)
  f32x16 pA0,pA1,pB0,pB1;
  int sl_prev=0,sl_cur=0,sl_next=SLOTB;
  #define ROT() do{sl_prev=sl_cur;sl_cur=sl_next;sl_next=(sl_next==(NSLOT-1)*SLOTB)?0:sl_next+SLOTB;}while(0)
  DMA_K(2,2*SLOTB);
  WAIT_BAR(3);
  qkt(pA0,pA1,Kbase,qr,negm,r32,hi);asm volatile("s_nop 15\n\ts_nop 7":"+v"(pA0),"+v"(pA1));CMASK(pA0,pA1,0);
  START(pA0,pA1);
  _Pragma("unroll") for(int r=0;r<16;++r)pA1[r]=__builtin_amdgcn_exp2f(pA1[r]);
  WAIT_BAR(0);
  DMA_K(3,0);DMA_V(1,SLOTB);
  ROT();
  kload8(kf,kp0+sl_cur);
  WAIT_BAR(2);
  s16x4 vlo[8],vhi[8]; u32x4 pw0,pw1,pw2,pw3;
  #define PKW(P,B) cvtpk_s(P[B],P[B+1])
  #define PAF(k) __builtin_bit_cast(bf16x8,pw##k)
  #define VFR(i) (bf16x8){vlo[i][0],vlo[i][1],vlo[i][2],vlo[i][3],vhi[i][0],vhi[i][1],vhi[i][2],vhi[i][3]}
  #define PIN(x) asm volatile("":"+v"(x))
  #define MX3(a,b,c) __builtin_fmaxf(__builtin_fmaxf((a),(b)),(c))
  #define GAPA(MF,A0,A1,A2,A3,W0,W1,PW) do{ MF; sacc+=A0; sacc+=A1; sacc+=A2; sacc+=A3; PIN(sacc); W0; W1; PIN(PW); SBAR(); }while(0)
  #define EX(v) __builtin_amdgcn_exp2f(v)
  #define GAPB(MF,X,B) do{ MF; X[B]=EX(X[B]); X[B+1]=EX(X[B+1]); X[B+2]=EX(X[B+2]); X[B+3]=EX(X[B+3]); PIN(X); SBAR(); }while(0)
  #define VRD(i) do{ vlo[i]=vtr(vp_+(((i)>>2)*4096+((i)&3)*1024)); vhi[i]=vtr(vp_+(((i)>>2)*4096+((i)&3)*1024+512)); }while(0)
  #define KRD(G,j) do{ if(G){ kload2(kf,kp0+sl_next,j); SBAR(); } }while(0)
  #define STEP(C0,C1,P0,P1,t,GK,GV,GL) do{ SBAR(); \
    const lds_cptr vp_=vp0+sl_prev; \
    VRD(0); SBAR(); float sacc=(P0[0]+P0[1]); \
    GAPA(C0=__builtin_amdgcn_mfma_f32_32x32x16_bf16(kf[0],qr[0],negm,0,0,0), P0[2],P0[3],P0[4],P0[5],     pw0[0]=PKW(P0,0), pw0[1]=PKW(P0,2), pw0); \
    VRD(4); SBAR(); GAPA(C1=__builtin_amdgcn_mfma_f32_32x32x16_bf16(kf[1],qr[0],negm,0,0,0), P0[6],P0[7],P0[8],P0[9],     pw0[2]=PKW(P0,4), pw0[3]=PKW(P0,6), pw0); \
    VRD(1); SBAR(); GAPA(C0=__builtin_amdgcn_mfma_f32_32x32x16_bf16(kf[2],qr[1],C0,0,0,0),   P0[10],P0[11],P0[12],P0[13], pw1[0]=PKW(P0,8), pw1[1]=PKW(P0,10), pw1); \
    VRD(5); SBAR(); GAPA(C1=__builtin_amdgcn_mfma_f32_32x32x16_bf16(kf[3],qr[1],C1,0,0,0),   P0[14],P0[15],P1[0],P1[1],   pw1[2]=PKW(P0,12),pw1[3]=PKW(P0,14), pw1); \
    VRD(2); SBAR(); GAPA(C0=__builtin_amdgcn_mfma_f32_32x32x16_bf16(kf[4],qr[2],C0,0,0,0),   P1[2],P1[3],P1[4],P1[5],     pw2[0]=PKW(P1,0), pw2[1]=PKW(P1,2), pw2); \
    VRD(6); SBAR(); GAPA(C1=__builtin_amdgcn_mfma_f32_32x32x16_bf16(kf[5],qr[2],C1,0,0,0),   P1[6],P1[7],P1[8],P1[9],     pw2[2]=PKW(P1,4), pw2[3]=PKW(P1,6), pw2); \
    VRD(3); SBAR(); GAPA(C0=__builtin_amdgcn_mfma_f32_32x32x16_bf16(kf[6],qr[3],C0,0,0,0),   P1[10],P1[11],P1[12],P1[13], pw3[0]=PKW(P1,8), pw3[1]=PKW(P1,10), pw3); \
    VRD(7); SBAR(); GAPA(C1=__builtin_amdgcn_mfma_f32_32x32x16_bf16(kf[7],qr[3],C1,0,0,0),   P1[14],P1[15],0.f,0.f,       pw3[2]=PKW(P1,12),pw3[3]=PKW(P1,14), pw3); \
    l_reg+=sacc; \
    if(GK){DMA_K((t)+3,sl_cur);} if(GV){DMA_V((t)+1,sl_next);} \
    CMASK(C0,C1,t); \
    { float a=MX3(C0[0],C0[1],C1[0]),b=MX3(C0[2],C0[3],C1[1]); a=MX3(a,C1[2],C1[3]); \
      _Pragma("unroll") for(int r=4;r<16;r+=4){a=MX3(a,C0[r],C0[r+1]);b=MX3(b,C0[r+2],C0[r+3]);a=MX3(a,C1[r],C1[r+1]);b=MX3(b,C1[r+2],C1[r+3]);} \
      float rm=__builtin_fmaxf(a,b); { auto rr=__builtin_amdgcn_permlane32_swap(__float_as_uint(rm),__float_as_uint(rm),false,false); rm=__builtin_fmaxf(__uint_as_float(rr[0]),__uint_as_float(rr[1])); } \
      resc=false; \
      if(__builtin_expect(__any(rm>(float)THRL),0)){ const float dl=__builtin_fmaxf(rm,0.f); mhat+=dl; \
        _Pragma("unroll") for(int r=0;r<16;++r){C0[r]-=dl;C1[r]-=dl;} \
        _Pragma("unroll") for(int r=0;r<16;++r)negm[r]=-mhat; asm volatile("":"+v"(negm)); \
        const float f=__builtin_amdgcn_exp2f(-dl); l_reg*=f; if(hi==0)wsf[r32]=f; resc=true; } } \
    SBAR(); \
    GAPB(o[0]=__builtin_amdgcn_mfma_f32_32x32x16_bf16(PAF(0),VFR(0),o[0],0,0,0), C0,0); \
    GAPB(o[1]=__builtin_amdgcn_mfma_f32_32x32x16_bf16(PAF(0),VFR(4),o[1],0,0,0), C0,4); \
    KRD(GL,0); GAPB(o[0]=__builtin_amdgcn_mfma_f32_32x32x16_bf16(PAF(1),VFR(1),o[0],0,0,0), C0,8); \
    KRD(GL,1); GAPB(o[1]=__builtin_amdgcn_mfma_f32_32x32x16_bf16(PAF(1),VFR(5),o[1],0,0,0), C0,12); \
    KRD(GL,2); GAPB(o[0]=__builtin_amdgcn_mfma_f32_32x32x16_bf16(PAF(2),VFR(2),o[0],0,0,0), C1,0); \
    KRD(GL,3); GAPB(o[1]=__builtin_amdgcn_mfma_f32_32x32x16_bf16(PAF(2),VFR(6),o[1],0,0,0), C1,4); \
    GAPB(o[0]=__builtin_amdgcn_mfma_f32_32x32x16_bf16(PAF(3),VFR(3),o[0],0,0,0), C1,8); \
    GAPB(o[1]=__builtin_amdgcn_mfma_f32_32x32x16_bf16(PAF(3),VFR(7),o[1],0,0,0), C1,12); \
    }while(0)
  int t=1;
  #undef CMASK
  #define CMASK(P0,P1,t) do{}while(0)
  for(;t+5<NT;t+=2){
    STEP(pB0,pB1,pA0,pA1,t,true,true,true);     WAIT_BAR(2); RESC(); ROT();
    STEP(pA0,pA1,pB0,pB1,t+1,true,true,true);   WAIT_BAR(2); RESC(); ROT();
  }
  #undef CMASK
  #define CMASK(P0,P1,t) do{int jb_=(t)-(NT-4); if(jb_>=0)cmask(P0,P1,jb_,wid>>1);}while(0)
  #define ENDW(tt) do{ if((tt)+3<NT){WAIT_BAR(2);} else if((tt)+2<NT){WAIT_BAR(1);} else {WAIT_BAR(0);} }while(0)
  for(;t+1<NT;t+=2){
    STEP(pB0,pB1,pA0,pA1,t,(t+3<NT),(t+1<NT),(t+1<NT));       ENDW(t);   RESC(); ROT();
    STEP(pA0,pA1,pB0,pB1,t+1,(t+4<NT),(t+2<NT),(t+2<NT));     ENDW(t+1); RESC(); ROT();
  }
  STEP(pB0,pB1,pA0,pA1,NT-1,false,false,false); RESC();
  { float sacc=pB0[0]+pB0[1]; _Pragma("unroll") for(int r=2;r<16;++r)sacc+=pB0[r]; _Pragma("unroll") for(int r=0;r<16;++r)sacc+=pB1[r]; l_reg+=sacc;
    pw0=(u32x4){PKW(pB0,0),PKW(pB0,2),PKW(pB0,4),PKW(pB0,6)};pw1=(u32x4){PKW(pB0,8),PKW(pB0,10),PKW(pB0,12),PKW(pB0,14)};pw2=(u32x4){PKW(pB1,0),PKW(pB1,2),PKW(pB1,4),PKW(pB1,6)};pw3=(u32x4){PKW(pB1,8),PKW(pB1,10),PKW(pB1,12),PKW(pB1,14)};
    SBAR(); pv(o,vb0+sl_cur,PAF(0),PAF(1),PAF(2),PAF(3)); }
  #undef PKW
  #undef PAF
  #undef VFR
  #undef PIN
  #undef MX3
  #undef GAPA
  #undef GAPB
  #undef EX
  #undef VRD
  #undef KRD
  #undef STEP
  #undef ENDW
  {auto rr=__builtin_amdgcn_permlane32_swap(__float_as_uint(l_reg),__float_as_uint(l_reg),false,false);l_reg=__uint_as_float(rr[0])+__uint_as_float(rr[1]);}
  if(hi==0)wsf[32+r32]=l_reg;asm volatile("s_waitcnt lgkmcnt(0)":::"memory");
  float rli[16];
  #pragma unroll
  for(int r=0;r<16;++r)rli[r]=__builtin_amdgcn_rcpf(wsf[32+crow(r,hi)]);
  { unsigned short*os=(unsigned short*)(shm+LDS_OS)+wid*4096+(pass&1)*2048;
    if(pass<2){
      #pragma unroll
      for(int r=0;r<16;++r){const int orow=crow(r,hi);
        #pragma unroll
        for(int d0=0;d0<2;++d0)os[orow*64+d0*32+r32]=(unsigned short)(cvtpk_s(o[d0][r]*rli[r],0.f)&0xffffu);}
    } else {
      #pragma unroll
      for(int r=0;r<16;++r){const int orow=crow(r,hi);
        #pragma unroll
        for(int d0=0;d0<2;++d0){const int ix=orow*64+d0*32+r32; const float prev=__uint_as_float((unsigned)os[ix]<<16); os[ix]=(unsigned short)(cvtpk_s(prev-lam*(o[d0][r]*rli[r]),0.f)&0xffffu);}}
    }
    asm volatile("s_waitcnt lgkmcnt(0)":::"memory");
    if(pass==3){
      const unsigned short*src=(const unsigned short*)(shm+LDS_OS)+wid*4096+hi*2048+r32*64;
      u32x4 w[8]; float sq=0.f;
      #pragma unroll
      for(int i=0;i<8;++i){w[i]=*(const u32x4*)(src+i*8);
        #pragma unroll
        for(int j=0;j<4;++j){const float lo=__uint_as_float(w[i][j]<<16),hh=__uint_as_float(w[i][j]&0xffff0000u);sq+=lo*lo+hh*hh;}}
      {auto rr=__builtin_amdgcn_permlane32_swap(__float_as_uint(sq),__float_as_uint(sq),false,false);sq=__uint_as_float(rr[0])+__uint_as_float(rr[1]);}
      const float rn=(1.0f-0.2f)/sqrtf(sq*(1.f/128.f)+1e-6f);
      unsigned short*Ow=(unsigned short*)O+(rowbase+q0+wid*QBLK+r32)*DM+(h>>1)*128+hi*64; const float*dg=dgain+hi*64;
      #pragma unroll
      for(int i=0;i<8;++i){u32x4 ov;
        #pragma unroll
        for(int j=0;j<4;++j){const float lo=__uint_as_float(w[i][j]<<16)*rn*dg[i*8+2*j],hh=__uint_as_float(w[i][j]&0xffff0000u)*rn*dg[i*8+2*j+1];ov[j]=cvtpk_s(lo,hh);}
        *(u32x4*)(Ow+i*8)=ov;}
    } }
  asm volatile("s_waitcnt lgkmcnt(0)\n\ts_barrier":::"memory");
  #undef DMA_K
  #undef DMA_V
  #undef CMASK
  #undef START
  #undef RESC
  #undef ROT
}
constexpr int ATTN_LDS_BYTES=LDS_BYTES;
struct AttnTensors { const bf16* Q; const bf16* K; const bf16* V; bf16* O; };

template<int THRL=8> __device__ __forceinline__ void attn_phase(char*lds,const AttnTensors&T,int vcu,int ncu,float lam,const float*dgain){
  for(int v=vcu;v<BATCH*8*2;v+=ncu){ const int bh=v>>1,half=v&1,b=bh>>3,h8=bh&7;
    for(int i=0;i<8;++i){ const int s=half*4+(i>>1),qb=(i&1)?15-s:s;
      for(int pass=0;pass<4;++pass) attn_unit<THRL>(b,2*h8+(pass>>1),2*h8+(pass&1),qb,pass,lam,dgain,T.Q,T.K,T.V,T.O,lds); } }
}
#undef SBAR
#undef WAIT_BAR
}
namespace mls {
typedef short bf16x8 __attribute__((ext_vector_type(8)));
typedef short s16x4 __attribute__((ext_vector_type(4)));
typedef float f32x16 __attribute__((ext_vector_type(16)));
typedef float f32x4 __attribute__((ext_vector_type(4)));
typedef unsigned u32x4 __attribute__((ext_vector_type(4)));
typedef unsigned u32x2 __attribute__((ext_vector_type(2)));
typedef short v4i16_t __attribute__((ext_vector_type(4)));
typedef float f32x2_t __attribute__((ext_vector_type(2))); typedef __bf16 bf16x2_t __attribute__((ext_vector_type(2)));
#define MLS_LAS __attribute__((address_space(3)))
#define MLS_MFMA(a, b, c) __builtin_amdgcn_mfma_f32_32x32x16_bf16((a), (b), (c), 0, 0, 0)
__device__ __forceinline__ int crow(int r, int hi) { return (r & 3) + 8 * (r >> 2) + 4 * hi; }
__device__ __forceinline__ unsigned off_b(unsigned row, unsigned ch) { return 256u * row + 16u * (ch ^ (((row & 3) << 2) | ((row >> 2) & 3))); }
__device__ __forceinline__ unsigned cvtpk(float lo, float hi) { f32x2_t v = {lo, hi}; bf16x2_t b = __builtin_convertvector(v, bf16x2_t); return __builtin_bit_cast(unsigned, b); }
__device__ __forceinline__ float bflo(unsigned w) { return __uint_as_float(w << 16); }
__device__ __forceinline__ float bfhi(unsigned w) { return __uint_as_float(w & 0xffff0000u); }
__device__ __forceinline__ bf16x8 row_frag(MLS_LAS const unsigned char* tile, int lane, int s) { return *(MLS_LAS const bf16x8*)(tile + off_b(lane & 31, 2 * s + (lane >> 5))); }
__device__ __forceinline__ bf16x8 tr_frag(MLS_LAS const unsigned char* tile, int lane, int c, int ks) {
    const unsigned h = lane >> 5, blk = (lane >> 4) & 1, q = (lane & 15) >> 2, p = lane & 3;
    const unsigned a0 = off_b(16 * ks + 8 * h + q, 4 * c + 2 * blk + (p >> 1)) + 8 * (p & 1), a1 = off_b(16 * ks + 8 * h + 4 + q, 4 * c + 2 * blk + (p >> 1)) + 8 * (p & 1);
    const s16x4 lo = __builtin_bit_cast(s16x4, __builtin_amdgcn_ds_read_tr16_b64_v4i16((MLS_LAS v4i16_t*)(tile + a0)));
    const s16x4 hi = __builtin_bit_cast(s16x4, __builtin_amdgcn_ds_read_tr16_b64_v4i16((MLS_LAS v4i16_t*)(tile + a1)));
    return (bf16x8){lo[0], lo[1], lo[2], lo[3], hi[0], hi[1], hi[2], hi[3]};
}
constexpr int L_QS = 0, L_KS = 16384, L_KW = 32768, L_VS = 49152, L_SP = 81920, L_HS = 90112, L_SM = 155648;
constexpr int G_A = 0, G_MM = 64, G_WI = 128, G_WK = 192, G_EI = 256, G_DEC = 320, G_STRIDE = 328, S_R0 = 656, S_R1 = 720, S_NQ = 784, S_NV = 848;
constexpr float LOG2E_ = 1.4426950408889634f;

__device__ __forceinline__ void gate_scan(MLS_LAS float* sm, const float* IF, size_t tok0, int h, int lane, int gb, float& m) {
    const float lf = IF[(tok0 + lane) * 8 + 4 + h], ig = IF[(tok0 + lane) * 8 + h];
    float b = lf;
#pragma unroll
    for (int o = 1; o < 64; o <<= 1) { const float v = __shfl_up(b, o); if (lane >= o) b += v; }
    const float a = ig - b; float am = a;
#pragma unroll
    for (int o = 1; o < 64; o <<= 1) { const float v = __shfl_up(am, o); if (lane >= o) am = fmaxf(am, v); }
    const float mm = fmaxf(m, am), mt = b + mm;
    const float blast = __shfl(b, 63), amall = __shfl(am, 63);
    const float mnew = blast + fmaxf(m, amall);
    MLS_LAS float* g = sm + gb * G_STRIDE;
    g[G_A + lane] = a; g[G_MM + lane] = mm; g[G_WI + lane] = expf(m - mm); g[G_WK + lane] = expf(blast + a - mnew); g[G_EI + lane] = expf(-mt);
    if (lane == 0) g[G_DEC] = expf(blast + m - mnew);
    m = mnew;
}

__device__ __forceinline__ void mlstm_unit(const unsigned short* QKM, unsigned short* VM, const float* IF, const float* convw, const float* mgain, MLS_LAS unsigned char* lds, int b, int h) {
    int tid_ = threadIdx.x; asm volatile("" : "+v"(tid_));
    const int tid0 = tid_, w = __builtin_amdgcn_readfirstlane(tid0 >> 6);
    MLS_LAS float* sm = (MLS_LAS float*)(lds + L_SM);
    MLS_LAS float* hs = (MLS_LAS float*)(lds + L_HS);
    f32x16 CT[4];
#pragma unroll
    for (int j = 0; j < 4; ++j)
#pragma unroll
        for (int i = 0; i < 16; ++i) CT[j][i] = 0.f;
    if (tid0 < 128) sm[S_NV + tid0] = 0.f;
    float mrun = 0.f;
    if (w == 3) gate_scan(sm, IF, (size_t)b * SEQ, h, tid0 & 63, 0, mrun);
    __syncthreads();
    for (int ch = 0; ch < SEQ / 64; ++ch) {
        const size_t tok0 = (size_t)b * SEQ + ch * 64; const int gb = ch & 1;
        MLS_LAS const float* g = sm + gb * G_STRIDE;
#define MLS_FRESH() int tid = tid0; asm volatile("" : "+v"(tid)); const int lane = tid & 63, hi = lane >> 5, r32 = lane & 31; (void)hi; (void)r32
        { MLS_FRESH(); const int cg = tid & 15, which = (tid >> 4) & 1, rb = tid >> 5; const int chn0 = which * 512 + h * 128 + cg * 8;
          float cwv[4][8];
#pragma unroll
          for (int j = 0; j < 4; ++j) { const f32x4 c0 = *(const f32x4*)(convw + j * 1024 + chn0), c1 = *(const f32x4*)(convw + j * 1024 + chn0 + 4);
              cwv[j][0] = c0[0]; cwv[j][1] = c0[1]; cwv[j][2] = c0[2]; cwv[j][3] = c0[3]; cwv[j][4] = c1[0]; cwv[j][5] = c1[1]; cwv[j][6] = c1[2]; cwv[j][7] = c1[3]; }
          float xr[7][8];
#pragma unroll
          for (int rr = 0; rr < 7; ++rr) { const int t = ch * 64 + rb * 4 + rr - 3;
              u32x4 wv = (u32x4){0u, 0u, 0u, 0u}; if (t >= 0) wv = *(const u32x4*)(QKM + ((size_t)b * SEQ + t) * 1024 + chn0);
              xr[rr][0] = bflo(wv[0]); xr[rr][1] = bfhi(wv[0]); xr[rr][2] = bflo(wv[1]); xr[rr][3] = bfhi(wv[1]); xr[rr][4] = bflo(wv[2]); xr[rr][5] = bfhi(wv[2]); xr[rr][6] = bflo(wv[3]); xr[rr][7] = bfhi(wv[3]); }
#pragma unroll
          for (int r = 0; r < 4; ++r) { const int t = rb * 4 + r; float o[8];
#pragma unroll
              for (int e = 0; e < 8; ++e) { const float cv = cwv[0][e] * xr[r][e] + cwv[1][e] * xr[r + 1][e] + cwv[2][e] * xr[r + 2][e] + cwv[3][e] * xr[r + 3][e];
                  o[e] = cv * __builtin_amdgcn_rcpf(1.0f + __builtin_amdgcn_exp2f(-LOG2E_ * cv)); }
              const unsigned ob = (unsigned)(t >> 5) * 8192u + off_b(t & 31, cg);
              if (which == 0) { const float sc = 0.08838834764831845f;
                  *(MLS_LAS u32x4*)(lds + L_QS + ob) = (u32x4){cvtpk(o[0] * sc, o[1] * sc), cvtpk(o[2] * sc, o[3] * sc), cvtpk(o[4] * sc, o[5] * sc), cvtpk(o[6] * sc, o[7] * sc)};
              } else { const float wkv = g[G_WK + t];
                  *(MLS_LAS u32x4*)(lds + L_KS + ob) = (u32x4){cvtpk(o[0], o[1]), cvtpk(o[2], o[3]), cvtpk(o[4], o[5]), cvtpk(o[6], o[7])};
                  *(MLS_LAS u32x4*)(lds + L_KW + ob) = (u32x4){cvtpk(o[0] * wkv, o[1] * wkv), cvtpk(o[2] * wkv, o[3] * wkv), cvtpk(o[4] * wkv, o[5] * wkv), cvtpk(o[6] * wkv, o[7] * wkv)}; } }
#pragma unroll
          for (int i = 0; i < 4; ++i) { const int idx = tid + 512 * i, s = idx >> 5, c8 = idx & 31;
              const u32x4 vv = *(const u32x4*)(VM + (tok0 + s) * 1024 + h * 256 + c8 * 8);
              *(MLS_LAS u32x4*)(lds + L_VS + (unsigned)((s >> 5) * 2 + (c8 >> 4)) * 8192u + off_b(s & 31, c8 & 15)) = vv; } }
        __syncthreads();
        { MLS_FRESH();
        if (w < 3) { const int sb = (w == 2) ? 1 : 0, tb = (w == 0) ? 0 : 1;
            f32x16 acc;
#pragma unroll
            for (int i = 0; i < 16; ++i) acc[i] = 0.f;
#pragma unroll
            for (int kk = 0; kk < 8; ++kk) acc = MLS_MFMA(row_frag(lds + L_KS + sb * 8192, lane, kk), row_frag(lds + L_QS + tb * 8192, lane, kk), acc);
            const int t = 32 * tb + r32; const float mmv = g[G_MM + t]; float rsum = 0.f;
#pragma unroll
            for (int gq = 0; gq < 4; ++gq) { float v4[4];
#pragma unroll
                for (int e = 0; e < 4; ++e) { const int s = 32 * sb + 8 * gq + 4 * hi + e; const float dv = __builtin_amdgcn_exp2f((g[G_A + s] - mmv) * LOG2E_);
                    v4[e] = (s <= t) ? acc[4 * gq + e] * dv : 0.f; rsum += v4[e]; }
                *(MLS_LAS u32x2*)(lds + L_SP + t * 128 + (((4 * sb + gq) ^ (t & 7)) << 4) + 8 * hi) = (u32x2){cvtpk(v4[0], v4[1]), cvtpk(v4[2], v4[3])}; }
            { auto rr = __builtin_amdgcn_permlane32_swap(__float_as_uint(rsum), __float_as_uint(rsum), false, false); rsum = __uint_as_float(rr[0]) + __uint_as_float(rr[1]); }
            if (hi == 0) sm[(sb ? S_R1 : S_R0) + t] = rsum;
        } else if (w == 3) {
            if (lane < 32) sm[S_R1 + lane] = 0.f;
            if (ch + 1 < SEQ / 64) gate_scan(sm, IF, tok0 + 64, h, lane, gb ^ 1, mrun);
        } else { const int u = tid - 256, t = u >> 2, p = u & 3; float acc = 0.f;
#pragma unroll
            for (int j = 0; j < 4; ++j) { const u32x4 qw = *(MLS_LAS const u32x4*)(lds + L_QS + (t >> 5) * 8192 + off_b(t & 31, 4 * p + j)); MLS_LAS const float* nv = sm + S_NV + 32 * p + 8 * j;
                acc += (bflo(qw[0]) * nv[0] + bfhi(qw[0]) * nv[1]) + (bflo(qw[1]) * nv[2] + bfhi(qw[1]) * nv[3]) + (bflo(qw[2]) * nv[4] + bfhi(qw[2]) * nv[5]) + (bflo(qw[3]) * nv[6] + bfhi(qw[3]) * nv[7]); }
            acc += __shfl_xor(acc, 1); acc += __shfl_xor(acc, 2);
            if (p == 0) sm[S_NQ + t] = acc; } }
        __syncthreads();
        { MLS_FRESH(); f32x16 H0, H1;
#pragma unroll
          for (int i = 0; i < 16; ++i) { H0[i] = 0.f; H1[i] = 0.f; }
#pragma unroll
          for (int jb = 0; jb < 4; ++jb)
#pragma unroll
              for (int u = 0; u < 2; ++u) {
                  const bf16x8 Bf = __builtin_bit_cast(bf16x8, (u32x4){cvtpk(CT[jb][8 * u], CT[jb][8 * u + 1]), cvtpk(CT[jb][8 * u + 2], CT[jb][8 * u + 3]), cvtpk(CT[jb][8 * u + 4], CT[jb][8 * u + 5]), cvtpk(CT[jb][8 * u + 6], CT[jb][8 * u + 7])});
                  const unsigned a0 = off_b(r32, 4 * jb + 2 * u) + 8 * hi, a1 = off_b(r32, 4 * jb + 2 * u + 1) + 8 * hi;
                  const u32x2 p00 = *(MLS_LAS const u32x2*)(lds + L_QS + a0), p01 = *(MLS_LAS const u32x2*)(lds + L_QS + a1), p10 = *(MLS_LAS const u32x2*)(lds + L_QS + 8192 + a0), p11 = *(MLS_LAS const u32x2*)(lds + L_QS + 8192 + a1);
                  H0 = MLS_MFMA(__builtin_bit_cast(bf16x8, (u32x4){p00[0], p00[1], p01[0], p01[1]}), Bf, H0);
                  H1 = MLS_MFMA(__builtin_bit_cast(bf16x8, (u32x4){p10[0], p10[1], p11[0], p11[1]}), Bf, H1); }
#pragma unroll
          for (int i = 0; i < 16; ++i) { H0[i] *= g[G_WI + crow(i, hi)]; H1[i] *= g[G_WI + 32 + crow(i, hi)]; }
          bf16x8 Vf[2][2];
#pragma unroll
          for (int sh = 0; sh < 2; ++sh)
#pragma unroll
              for (int ks = 0; ks < 2; ++ks) Vf[sh][ks] = tr_frag(lds + L_VS + (sh * 2 + (w >> 2)) * 8192, lane, w & 3, ks);
#pragma unroll
          for (int u = 0; u < 2; ++u) {
              const bf16x8 s00 = *(MLS_LAS const bf16x8*)(lds + L_SP + r32 * 128 + (((2 * u + hi) ^ (r32 & 7)) << 4));
              const bf16x8 s10 = *(MLS_LAS const bf16x8*)(lds + L_SP + (32 + r32) * 128 + (((2 * u + hi) ^ (r32 & 7)) << 4));
              const bf16x8 s11 = *(MLS_LAS const bf16x8*)(lds + L_SP + (32 + r32) * 128 + (((4 + 2 * u + hi) ^ (r32 & 7)) << 4));
              H0 = MLS_MFMA(s00, Vf[0][u], H0); H1 = MLS_MFMA(s10, Vf[0][u], H1); H1 = MLS_MFMA(s11, Vf[1][u], H1); }
#pragma unroll
          for (int i = 0; i < 16; ++i) { hs[crow(i, hi) * 256 + 32 * w + r32] = H0[i]; hs[(32 + crow(i, hi)) * 256 + 32 * w + r32] = H1[i]; }
          const float decay = g[G_DEC];
#pragma unroll
          for (int jb = 0; jb < 4; ++jb) {
#pragma unroll
              for (int i = 0; i < 16; ++i) CT[jb][i] *= decay;
#pragma unroll
              for (int sh = 0; sh < 2; ++sh)
#pragma unroll
                  for (int ks = 0; ks < 2; ++ks) CT[jb] = MLS_MFMA(tr_frag(lds + L_KW + sh * 8192, lane, jb, ks), Vf[sh][ks], CT[jb]); }
          { const int dk = tid >> 2, p = tid & 3; float acc = 0.f;
#pragma unroll
            for (int e = 0; e < 16; ++e) { const int s = 16 * p + e; acc += __uint_as_float((unsigned)*(MLS_LAS const unsigned short*)(lds + L_KW + (s >> 5) * 8192 + off_b(s & 31, dk >> 3) + (dk & 7) * 2) << 16); }
            acc += __shfl_xor(acc, 1); acc += __shfl_xor(acc, 2);
            if (p == 0) sm[S_NV + dk] = decay * sm[S_NV + dk] + acc; } }
        __syncthreads();
        { MLS_FRESH(); const int t = tid >> 3, seg = tid & 7;
          const float den = fmaxf(fabsf(sm[S_R0 + t] + sm[S_R1 + t] + g[G_WI + t] * sm[S_NQ + t]), g[G_EI + t]); const float inv = 1.0f / den;
          f32x4 v[8]; float sq = 0.f;
#pragma unroll
          for (int j = 0; j < 8; ++j) { v[j] = *(MLS_LAS const f32x4*)(hs + t * 256 + seg * 32 + j * 4) * inv; sq += (v[j][0] * v[j][0] + v[j][1] * v[j][1]) + (v[j][2] * v[j][2] + v[j][3] * v[j][3]); }
          sq += __shfl_xor(sq, 1); sq += __shfl_xor(sq, 2); sq += __shfl_xor(sq, 4);
          const float rn = 1.0f / sqrtf(sq * (1.f / 256.f) + 1e-6f);
          const float* gp = mgain + h * 256 + seg * 32; unsigned short* op = VM + (tok0 + t) * 1024 + h * 256 + seg * 32;
#pragma unroll
          for (int j = 0; j < 4; ++j) { const f32x4 g0 = *(const f32x4*)(gp + 8 * j), g1 = *(const f32x4*)(gp + 8 * j + 4); const f32x4 a0 = v[2 * j] * rn * g0, a1 = v[2 * j + 1] * rn * g1;
              *(u32x4*)(op + 8 * j) = (u32x4){cvtpk(a0[0], a0[1]), cvtpk(a0[2], a0[3]), cvtpk(a1[0], a1[1]), cvtpk(a1[2], a1[3])}; } }
    }
    __syncthreads();
}
}
__device__ __forceinline__ void transpose_item(const float* W, int ldw, int k0, int n0, bf16* WT, int ldt, int drow0, const float* gain, LAS float* scr, int lane) {
#pragma unroll 8
    for (int i = 0; i < 32; ++i) { const int kk = 2 * i + (lane >> 5); float v = W[(size_t)(k0 + kk) * ldw + n0 + (lane & 31)]; if (gain) v *= gain[k0 + kk]; scr[kk * 33 + (lane & 31)] = v; }
    LDS_WAIT(); asm volatile("" ::: "memory");
    const int c = lane & 7;
#pragma unroll
    for (int j = 0; j < 4; ++j) { const int n = (lane >> 3) + 8 * j; const LAS float* s = scr + (8 * c) * 33 + n;
        v4u o; o.x = pk2(s[0 * 33], s[1 * 33]); o.y = pk2(s[2 * 33], s[3 * 33]); o.z = pk2(s[4 * 33], s[5 * 33]); o.w = pk2(s[6 * 33], s[7 * 33]);
        *(v4u*)(WT + (size_t)(drow0 + n) * ldt + k0 + 8 * c) = o; }
    LDS_WAIT(); asm volatile("" ::: "memory");
}
__device__ __forceinline__ int win_src_col(int drow0) {
    return drow0 < 2048 ? drow0 : drow0 < 3072 ? 3080 + (drow0 - 2048) : drow0 < 4096 ? 4104 + (drow0 - 3072) : drow0 < 5120 ? 5128 + (drow0 - 4096) : drow0 < 6144 ? 2048 + (drow0 - 5120) : 6152 + (drow0 - 6144);
}
__device__ __forceinline__ float log_sigmoid_(float x) { return x < 0.f ? x - log1pf(expf(x)) : -log1pf(expf(-x)); }

__device__ __forceinline__ void phase_p0(const Args& a, LAS unsigned char* lds, int tid, int lane, int wave, int vcu, int G) {
    unsigned char* ws = a.ws;
    const int gw = vcu * NWAVES + wave, NGW = G * NWAVES;
    LAS float* scr = (LAS float*)(lds + wave * 16384);
    constexpr int I_IN = 16 * 256, I_SQ = 16 * 32, I_KV = 16 * 64, I_GU = 32 * 16 * 64, I_DN = 32 * 16 * 32;
    constexpr int NITEMS = I_IN + 4 * I_SQ + I_KV + I_GU + I_DN;
    for (int it = gw; it < NITEMS; it += NGW) {
        int r = it;
        if (r < I_IN) { const int kb = r >> 8, nb = r & 255; transpose_item(a.in[I_W_IN], 8200, 64 * kb, win_src_col(32 * nb), (bf16*)(ws + WS_WIN), 1024, 32 * nb, a.in[I_NORM_MIX], scr, lane); continue; } r -= I_IN;
        if (r < I_SQ) { transpose_item(a.in[I_W_BM], 1024, 64 * (r >> 5), 32 * (r & 31), (bf16*)(ws + WS_WBM), 1024, 32 * (r & 31), nullptr, scr, lane); continue; } r -= I_SQ;
        if (r < I_SQ) { transpose_item(a.in[I_W_BD], 1024, 64 * (r >> 5), 32 * (r & 31), (bf16*)(ws + WS_WBD), 1024, 32 * (r & 31), nullptr, scr, lane); continue; } r -= I_SQ;
        if (r < I_SQ) { transpose_item(a.in[I_W_OUT], 1024, 64 * (r >> 5), 32 * (r & 31), (bf16*)(ws + WS_WOUT), 1024, 32 * (r & 31), nullptr, scr, lane); continue; } r -= I_SQ;
        if (r < I_SQ) { transpose_item(a.in[I_WO], 1024, 64 * (r >> 5), 32 * (r & 31), (bf16*)(ws + WS_WO), 1024, 32 * (r & 31), nullptr, scr, lane); continue; } r -= I_SQ;
        if (r < I_KV) { transpose_item(a.in[I_WKV], 2048, 64 * (r >> 6), 32 * (r & 63), (bf16*)(ws + WS_WKV), 1024, 32 * (r & 63), nullptr, scr, lane); continue; } r -= I_KV;
        if (r < I_GU) { const int e = r >> 10, q = r & 1023, kb = q >> 6, nb = q & 63, n0 = 32 * nb;
            const int drow0 = n0 < 1024 ? (n0 >> 7) * 256 + (n0 & 127) : ((n0 - 1024) >> 7) * 256 + 128 + ((n0 - 1024) & 127);
            transpose_item(a.in[I_W_GU] + (size_t)e * 1024 * 2048, 2048, 64 * kb, n0, (bf16*)(ws + WS_WGU) + (size_t)e * 2048 * 1024, 1024, drow0, a.in[I_NORM_FFN], scr, lane); continue; } r -= I_GU;
        { const int e = r >> 9, q = r & 511; transpose_item(a.in[I_W_DN] + (size_t)e * 1024 * 1024, 1024, 64 * (q >> 5), 32 * (q & 31), (bf16*)(ws + WS_WDN) + (size_t)e * 1024 * 1024, 1024, 32 * (q & 31), nullptr, scr, lane); }
    }
    for (int idx = (vcu * 512 + tid); idx < 1024 * 1024 / 4; idx += G * 512) { const int row = idx >> 8; const float g = a.in[I_NORM_XATTN][row];
        const f32x4 v = *(const f32x4*)(a.in[I_WQ] + (size_t)idx * 4); v2u o; o.x = pk2(v[0] * g, v[1] * g); o.y = pk2(v[2] * g, v[3] * g); *(v2u*)((bf16*)(ws + WS_WQG) + (size_t)idx * 4) = o; }
    for (int idx = (vcu * 512 + tid); idx < 32 * 1024; idx += G * 512) { const int e = idx >> 10, k = idx & 1023; ((float*)(ws + WS_WGT))[idx] = a.in[I_NORM_FFN][k] * a.in[I_W_R][k * 32 + e]; }
    __syncthreads();
    LAS float* wif = (LAS float*)lds;
    for (int idx = tid; idx < 8192; idx += 512) { const int j = idx & 7, k = idx >> 3; wif[j * 1024 + k] = a.in[I_NORM_MIX][k] * a.in[I_W_IN][(size_t)k * 8200 + 3072 + j]; }
    __syncthreads();
    for (int m = gw; m < T; m += NGW) {
        const f32x4* xr = (const f32x4*)(a.in[I_X] + (size_t)m * D) + lane;
        f32x4 v[4]; float s = 0.f;
#pragma unroll
        for (int j = 0; j < 4; ++j) { v[j] = xr[64 * j]; s += (v[j][0] * v[j][0] + v[j][1] * v[j][1]) + (v[j][2] * v[j][2] + v[j][3] * v[j][3]); }
        const float rs = 1.0f / sqrtf(wave_sum(s) * (1.f / D) + EPS);
        unsigned long long* o8 = (unsigned long long*)((bf16*)(ws + WS_B0) + (size_t)m * D) + lane;
#pragma unroll
        for (int j = 0; j < 4; ++j) o8[64 * j] = (unsigned long long)pk2(v[j][0], v[j][1]) | ((unsigned long long)pk2(v[j][2], v[j][3]) << 32);
        float gv[8];
#pragma unroll
        for (int g = 0; g < 8; ++g) { float p = 0.f;
#pragma unroll
            for (int j = 0; j < 4; ++j) { const f32x4 w = *(const LAS f32x4*)(wif + g * 1024 + 4 * lane + 256 * j); p += (v[j][0] * w[0] + v[j][1] * w[1]) + (v[j][2] * w[2] + v[j][3] * w[3]); }
            gv[g] = wave_sum(p) * rs + a.in[I_B_IF][g]; }
        if (lane == 0) { ((float*)(ws + WS_RS0))[m] = rs; float* o = (float*)(ws + WS_IF) + (size_t)m * 8;
#pragma unroll
            for (int g = 0; g < 4; ++g) { o[g] = gv[g]; o[4 + g] = log_sigmoid_(gv[4 + g]); } }
    }
    for (int m = gw; m < NB * NMEM; m += NGW) {
        const f32x4* xr = (const f32x4*)(a.in[I_MEM] + (size_t)m * D) + lane; const f32x4* gr = (const f32x4*)a.in[I_NORM_MEM] + lane;
        f32x4 v[4]; float s = 0.f;
#pragma unroll
        for (int j = 0; j < 4; ++j) { v[j] = xr[64 * j]; s += (v[j][0] * v[j][0] + v[j][1] * v[j][1]) + (v[j][2] * v[j][2] + v[j][3] * v[j][3]); }
        const float rs = 1.0f / sqrtf(wave_sum(s) * (1.f / D) + EPS);
        unsigned long long* o8 = (unsigned long long*)((bf16*)(ws + WS_MEMN) + (size_t)m * D) + lane;
#pragma unroll
        for (int j = 0; j < 4; ++j) { const f32x4 g = gr[64 * j]; o8[64 * j] = (unsigned long long)pk2(v[j][0] * rs * g[0], v[j][1] * rs * g[1]) | ((unsigned long long)pk2(v[j][2] * rs * g[2], v[j][3] * rs * g[3]) << 32); }
    }
}

__device__ __forceinline__ void att_naive_unit(const Args& a, LAS unsigned char* lds, int tid, int b, int h, int qblk, float lam) {
    const bf16* QD = (const bf16*)(a.ws + WS_B3); const bf16* KD = (const bf16*)(a.ws + WS_B4); const bf16* VD = (const bf16*)(a.ws + WS_B5); bf16* HD = (bf16*)(a.ws + WS_B3);
    const int row = tid >> 2, c = (tid >> 1) & 1, vh = tid & 1;
    const int qpos = qblk * 128 + row; const size_t tok = (size_t)b * SEQ + qpos;
    float q[64];
    { const v4u* qp = (const v4u*)(QD + tok * 1024 + h * 128 + c * 64);
#pragma unroll
      for (int i = 0; i < 8; ++i) { const v4u w = qp[i]; q[8 * i + 0] = pg8::bf_lo(w.x); q[8 * i + 1] = pg8::bf_hi(w.x); q[8 * i + 2] = pg8::bf_lo(w.y); q[8 * i + 3] = pg8::bf_hi(w.y);
          q[8 * i + 4] = pg8::bf_lo(w.z); q[8 * i + 5] = pg8::bf_hi(w.z); q[8 * i + 6] = pg8::bf_lo(w.w); q[8 * i + 7] = pg8::bf_hi(w.w); } }
    const int kmax = ((qpos >> 6) + 1) << 6, ukmax = qblk * 128 + 128;
    float o[64];
#pragma unroll
    for (int i = 0; i < 64; ++i) o[i] = 0.f;
    float mrun = -INFINITY, l = 0.f;
    LAS float* Ks = (LAS float*)lds; LAS float* Vs = (LAS float*)(lds + 8192);
    for (int kt = 0; kt < ukmax; kt += 16) {
        __syncthreads();
        { const int kr = tid >> 5, cc = (tid & 31) * 4; const size_t ko = ((size_t)b * SEQ + kt + kr) * 1024 + h * 128 + cc;
          const v2u kw = *(const v2u*)(KD + ko), vw = *(const v2u*)(VD + ko);
          *(LAS f32x4*)(Ks + kr * 128 + cc) = (f32x4){pg8::bf_lo(kw.x), pg8::bf_hi(kw.x), pg8::bf_lo(kw.y), pg8::bf_hi(kw.y)};
          *(LAS f32x4*)(Vs + kr * 128 + cc) = (f32x4){pg8::bf_lo(vw.x), pg8::bf_hi(vw.x), pg8::bf_lo(vw.y), pg8::bf_hi(vw.y)}; }
        __syncthreads();
#pragma unroll 1
        for (int j = 0; j < 16; ++j) {
            if (kt + j >= kmax) continue;
            float d = 0.f; const LAS f32x4* kp = (const LAS f32x4*)(Ks + j * 128 + c * 64);
#pragma unroll
            for (int i = 0; i < 16; ++i) { const f32x4 kk = kp[i]; d += (q[4 * i] * kk[0] + q[4 * i + 1] * kk[1]) + (q[4 * i + 2] * kk[2] + q[4 * i + 3] * kk[3]); }
            const float mnew = fmaxf(mrun, d); const float alpha = __builtin_amdgcn_exp2f(mrun - mnew), p = __builtin_amdgcn_exp2f(d - mnew);
            l = l * alpha + p; mrun = mnew;
            const LAS f32x4* vp = (const LAS f32x4*)(Vs + j * 128 + vh * 64);
#pragma unroll
            for (int i = 0; i < 16; ++i) { const f32x4 vv = vp[i]; o[4 * i] = o[4 * i] * alpha + p * vv[0]; o[4 * i + 1] = o[4 * i + 1] * alpha + p * vv[1]; o[4 * i + 2] = o[4 * i + 2] * alpha + p * vv[2]; o[4 * i + 3] = o[4 * i + 3] * alpha + p * vv[3]; }
        }
    }
    const float inv = 1.0f / l; float sq = 0.f;
#pragma unroll
    for (int i = 0; i < 64; ++i) { o[i] *= inv; const float other = __shfl_xor(o[i], 2); o[i] = o[i] - lam * other; sq += o[i] * o[i]; }
    sq += __shfl_xor(sq, 1);
    const float rn = 1.0f / sqrtf(sq * (1.f / 128.f) + EPS) * (1.0f - LAM_INIT);
    if (c == 0) { const float* dg = a.in[I_DGAIN] + vh * 64; v4u* op = (v4u*)(HD + tok * 1024 + h * 128 + vh * 64);
#pragma unroll
        for (int i = 0; i < 8; ++i) { v4u w; w.x = pk2(o[8 * i] * rn * dg[8 * i], o[8 * i + 1] * rn * dg[8 * i + 1]); w.y = pk2(o[8 * i + 2] * rn * dg[8 * i + 2], o[8 * i + 3] * rn * dg[8 * i + 3]);
            w.z = pk2(o[8 * i + 4] * rn * dg[8 * i + 4], o[8 * i + 5] * rn * dg[8 * i + 5]); w.w = pk2(o[8 * i + 6] * rn * dg[8 * i + 6], o[8 * i + 7] * rn * dg[8 * i + 7]); op[i] = w; } }
}
__device__ __forceinline__ float diff_lambda(const Args& a) {
    const float* lp = a.in[I_DLAM]; float s1 = 0.f, s2 = 0.f;
    for (int i = 0; i < 64; ++i) { s1 += lp[i] * lp[64 + i]; s2 += lp[128 + i] * lp[192 + i]; }
    return expf(s1) - expf(s2) + LAM_INIT;
}
__device__ __forceinline__ void phase_att_naive(const Args& a, LAS unsigned char* lds, int tid, int vcu, int G) {
    const float lam = diff_lambda(a);
    for (int i = 0;; ++i) { const int u = i * G + vcu; if (u >= NB * 8 * 32) break;
        const int bh = u >> 5, r = (u & 31), rot = (r + 2 * (i >> 1)) & 31, qblk = (i & 1) ? 31 - rot : rot;
        att_naive_unit(a, lds, tid, bh >> 3, bh & 7, qblk, lam);
        __syncthreads(); }
}

__device__ __forceinline__ float bfdot8(const v4u w, const float* c) {
    return (c[0] * pg8::bf_lo(w.x) + c[1] * pg8::bf_hi(w.x)) + (c[2] * pg8::bf_lo(w.y) + c[3] * pg8::bf_hi(w.y)) + (c[4] * pg8::bf_lo(w.z) + c[5] * pg8::bf_hi(w.z)) + (c[6] * pg8::bf_lo(w.w) + c[7] * pg8::bf_hi(w.w));
}
__device__ __forceinline__ void mlstm_naive_unit(const Args& a, LAS unsigned char* lds, int tid, int lane, int wave, int b, int h) {
    const bf16* QKM = (const bf16*)(a.ws + WS_B1); bf16* VM = (bf16*)(a.ws + WS_B2); const float* IF = (const float*)(a.ws + WS_IF);
    LAS bf16* qs = (LAS bf16*)lds;
    LAS bf16* ks = (LAS bf16*)(lds + 16384);
    LAS bf16* vs = (LAS bf16*)(lds + 32768);
    LAS float* Sm = (LAS float*)(lds + 65536);
    LAS float* hs = (LAS float*)(lds + 81920);
    LAS float* sm = (LAS float*)(lds + 147456);
    LAS float* ig = sm, *lf = sm + 64, *bcum = sm + 128, *aarr = sm + 192, *mt = sm + 256, *wint = sm + 320, *wk = sm + 384, *den = sm + 448, *nvec = sm + 512, *scal = sm + 640, *hsqw = sm + 704;
    const int dv = tid >> 1, half = tid & 1;
    float Creg[64];
#pragma unroll
    for (int j = 0; j < 64; ++j) Creg[j] = 0.f;
    if (tid < 128) nvec[tid] = 0.f;
    if (tid == 0) scal[0] = 0.f;
    const float* cw = a.in[I_CONV_W];
    for (int ch = 0; ch < SEQ / 64; ++ch) {
        const size_t tok0 = (size_t)b * SEQ + ch * 64;
        __syncthreads();
        if (tid < 64) { ig[tid] = IF[(tok0 + tid) * 8 + h]; lf[tid] = IF[(tok0 + tid) * 8 + 4 + h]; }
        { const int col = tid & 127, which = (tid >> 7) & 1, tq = tid >> 8;
          const int chn = which * 512 + h * 128 + col; const float w0 = cw[chn], w1 = cw[1024 + chn], w2 = cw[2048 + chn], w3 = cw[3072 + chn];
          const int t0 = ch * 64 + 32 * tq; float x0, x1, x2;
          x0 = (t0 - 3 >= 0) ? bf2f(QKM[((size_t)b * SEQ + t0 - 3) * 1024 + chn]) : 0.f; x1 = (t0 - 2 >= 0) ? bf2f(QKM[((size_t)b * SEQ + t0 - 2) * 1024 + chn]) : 0.f; x2 = (t0 - 1 >= 0) ? bf2f(QKM[((size_t)b * SEQ + t0 - 1) * 1024 + chn]) : 0.f;
          LAS bf16* dst = which ? ks : qs; const float scl = which ? 1.0f : 0.08838834764831845f;
          for (int t = 0; t < 32; ++t) { const float x3 = bf2f(QKM[((size_t)b * SEQ + t0 + t) * 1024 + chn]); const float cv = w0 * x0 + w1 * x1 + w2 * x2 + w3 * x3; const float sv = cv * pg8::sigmoidf_(cv) * scl;
              dst[(32 * tq + t) * 128 + col] = (bf16)(pk2(sv, 0.f) & 0xffffu); x0 = x1; x1 = x2; x2 = x3; } }
        for (int idx = tid; idx < 64 * 32; idx += 512) { const int t = idx >> 5, c8 = (idx & 31) * 8; *(LAS v4u*)(vs + t * 256 + c8) = *(const v4u*)(VM + (tok0 + t) * 1024 + h * 256 + c8); }
        __syncthreads();
        if (tid == 0) { const float m = scal[0]; float bsum = 0.f, amax = -INFINITY;
            for (int t = 0; t < 64; ++t) { bsum += lf[t]; bcum[t] = bsum; const float av = ig[t] - bsum; aarr[t] = av; amax = fmaxf(amax, av); const float mm = fmaxf(m, amax); mt[t] = bsum + mm; wint[t] = expf(m - mm); }
            const float mm = fmaxf(m, amax), mnew = bsum + mm;
            for (int s = 0; s < 64; ++s) wk[s] = expf(bsum + aarr[s] - mnew);
            scal[1] = expf(bsum + m - mnew); scal[2] = mnew; }
        __syncthreads();
        for (int i = 0; i < 8; ++i) { const int idx = tid + 512 * i, t = idx >> 6, s = idx & 63; float val = 0.f;
            if (s <= t) { float d = 0.f;
#pragma unroll 2
                for (int k8 = 0; k8 < 16; ++k8) { const v4u qw = *(const LAS v4u*)(qs + t * 128 + k8 * 8), kw = *(const LAS v4u*)(ks + s * 128 + k8 * 8);
                    d += (pg8::bf_lo(qw.x) * pg8::bf_lo(kw.x) + pg8::bf_hi(qw.x) * pg8::bf_hi(kw.x)) + (pg8::bf_lo(qw.y) * pg8::bf_lo(kw.y) + pg8::bf_hi(qw.y) * pg8::bf_hi(kw.y))
                       + (pg8::bf_lo(qw.z) * pg8::bf_lo(kw.z) + pg8::bf_hi(qw.z) * pg8::bf_hi(kw.z)) + (pg8::bf_lo(qw.w) * pg8::bf_lo(kw.w) + pg8::bf_hi(qw.w) * pg8::bf_hi(kw.w)); }
                val = d * expf(bcum[t] + aarr[s] - mt[t]); }
            Sm[idx] = val; }
        __syncthreads();
        if (tid < 64) { float rsum = 0.f; for (int s = 0; s < 64; ++s) rsum += Sm[tid * 64 + s];
            float nq = 0.f; for (int k = 0; k < 128; ++k) nq += nvec[k] * bf2f(qs[tid * 128 + k]);
            den[tid] = fmaxf(fabsf(rsum + wint[tid] * nq), expf(-mt[tid])); }
        __syncthreads();
#pragma unroll 1
        for (int t = 0; t < 64; ++t) {
            float part = 0.f;
#pragma unroll
            for (int k8 = 0; k8 < 8; ++k8) part += bfdot8(*(const LAS v4u*)(qs + t * 128 + half * 64 + k8 * 8), &Creg[k8 * 8]);
            float ip = 0.f;
#pragma unroll 4
            for (int s = half * 32; s < half * 32 + 32; ++s) ip += Sm[t * 64 + s] * bf2f(vs[s * 256 + dv]);
            float tot = ip + wint[t] * part; tot += __shfl_xor(tot, 1);
            const float hv = tot / den[t];
            if (half == 0) hs[t * 256 + dv] = hv;
            const float sq = wave_sum(half == 0 ? hv * hv : 0.f);
            if (lane == 0) hsqw[wave * 64 + t] = sq;
        }
        __syncthreads();
        for (int i = 0; i < 32; ++i) { const int idx = tid + 512 * i, t = idx >> 8, dd = idx & 255; float ssum = 0.f;
#pragma unroll
            for (int w = 0; w < 8; ++w) ssum += hsqw[w * 64 + t];
            const float rn = 1.0f / sqrtf(ssum * (1.f / 256.f) + EPS);
            VM[(tok0 + t) * 1024 + h * 256 + dd] = (bf16)(pk2(hs[idx] * rn * a.in[I_MGAIN][h * 256 + dd], 0.f) & 0xffffu); }
        { const float decay = scal[1];
#pragma unroll
          for (int j = 0; j < 64; ++j) Creg[j] *= decay;
#pragma unroll 1
          for (int s = 0; s < 64; ++s) { const float wv = wk[s] * bf2f(vs[s * 256 + dv]);
#pragma unroll
              for (int k8 = 0; k8 < 8; ++k8) { const v4u kw = *(const LAS v4u*)(ks + s * 128 + half * 64 + k8 * 8);
                  Creg[k8 * 8 + 0] += wv * pg8::bf_lo(kw.x); Creg[k8 * 8 + 1] += wv * pg8::bf_hi(kw.x); Creg[k8 * 8 + 2] += wv * pg8::bf_lo(kw.y); Creg[k8 * 8 + 3] += wv * pg8::bf_hi(kw.y);
                  Creg[k8 * 8 + 4] += wv * pg8::bf_lo(kw.z); Creg[k8 * 8 + 5] += wv * pg8::bf_hi(kw.z); Creg[k8 * 8 + 6] += wv * pg8::bf_lo(kw.w); Creg[k8 * 8 + 7] += wv * pg8::bf_hi(kw.w); } }
          float nn = 0.f;
          if (tid < 128) { nn = decay * nvec[tid]; for (int s = 0; s < 64; ++s) nn += wk[s] * bf2f(ks[s * 128 + tid]); }
          __syncthreads();
          if (tid < 128) nvec[tid] = nn;
          if (tid == 0) scal[0] = scal[2]; }
    }
    __syncthreads();
}
__device__ __forceinline__ void phase_mlstm_naive(const Args& a, LAS unsigned char* lds, int tid, int lane, int wave, int vcu, int G) {
    for (int u = vcu; u < NB * 4; u += G) mlstm_naive_unit(a, lds, tid, lane, wave, u >> 2, u & 3);
}

__device__ __forceinline__ void phase_rs1(const Args& a, int tid, int vcu, int G) {
    const float* ss = (const float*)(a.ws + WS_SS1); float* rs = (float*)(a.ws + WS_RS1);
    for (int r = vcu * 512 + tid; r < T; r += G * 512) { const f32x4* p = (const f32x4*)(ss + (size_t)r * 16); const f32x4 s0 = p[0], s1 = p[1], s2 = p[2], s3 = p[3];
        const float s = ((s0[0] + s0[1]) + (s0[2] + s0[3])) + ((s1[0] + s1[1]) + (s1[2] + s1[3])) + ((s2[0] + s2[1]) + (s2[2] + s2[3])) + ((s3[0] + s3[1]) + (s3[2] + s3[3]));
        rs[r] = 1.0f / sqrtf(s * (1.f / D) + EPS); }
}
__device__ __forceinline__ void phase_pnorm(const Args& a, int lane, int wave, int vcu, int G) {
    bf16* P = (bf16*)(a.ws + WS_B3); const float* ps = (const float*)(a.ws + WS_PSUM);
    for (int r = vcu * NWAVES + wave; r < T; r += G * NWAVES) { const int hh = lane >> 4; const f32x4 s = *(const f32x4*)(ps + (size_t)r * 16 + hh * 4);
        const float inv = 1.0f / ((s[0] + s[1]) + (s[2] + s[3]));
        v4u* p = (v4u*)(P + (size_t)r * 1024 + lane * 16);
#pragma unroll
        for (int i = 0; i < 2; ++i) { const v4u w = p[i]; v4u o; o.x = pk2(pg8::bf_lo(w.x) * inv, pg8::bf_hi(w.x) * inv); o.y = pk2(pg8::bf_lo(w.y) * inv, pg8::bf_hi(w.y) * inv);
            o.z = pk2(pg8::bf_lo(w.z) * inv, pg8::bf_hi(w.z) * inv); o.w = pk2(pg8::bf_lo(w.w) * inv, pg8::bf_hi(w.w) * inv); p[i] = o; } }
}
__device__ __forceinline__ void phase_final_plain(const Args& a, const float* src, int lane, int wave, int vcu, int G) {
    for (int m = vcu * NWAVES + wave; m < T; m += G * NWAVES) {
        const f32x4* xr = (const f32x4*)(src + (size_t)m * D) + lane; const f32x4* gr = (const f32x4*)a.in[I_NORM_FINAL] + lane; f32x4* orow = (f32x4*)(a.out + (size_t)m * D) + lane;
        f32x4 v[4]; float s = 0.f;
#pragma unroll
        for (int j = 0; j < 4; ++j) { v[j] = xr[64 * j]; s += (v[j][0] * v[j][0] + v[j][1] * v[j][1]) + (v[j][2] * v[j][2] + v[j][3] * v[j][3]); }
        const float rs = 1.0f / sqrtf(wave_sum(s) * (1.f / D) + EPS);
#pragma unroll
        for (int j = 0; j < 4; ++j) orow[64 * j] = v[j] * rs * gr[64 * j];
    }
}
__device__ __forceinline__ void phase_router(const Args& a, LAS unsigned char* lds, int tid, int lane, int wave) {
    LAS float* wg = (LAS float*)lds;
    LAS int* hist = (LAS int*)(lds + 131072);
    const float* wgt = (const float*)(a.ws + WS_WGT);
    for (int idx = tid; idx < 32 * 1024 / 4; idx += 512) *(LAS f32x4*)(wg + idx * 4) = *(const f32x4*)(wgt + idx * 4);
    if (tid < 32) hist[tid] = 0;
    __syncthreads();
    const int blk = blockIdx.x;
    for (int i = 0; i < 32; ++i) { const int tk = blk * 256 + wave * 32 + i;
        const f32x4* xr = (const f32x4*)(a.out + (size_t)tk * D) + lane;
        f32x4 v[4]; float s = 0.f;
#pragma unroll
        for (int j = 0; j < 4; ++j) { v[j] = xr[64 * j]; s += (v[j][0] * v[j][0] + v[j][1] * v[j][1]) + (v[j][2] * v[j][2] + v[j][3] * v[j][3]); }
        const float rs = 1.0f / sqrtf(wave_sum(s) * (1.f / D) + EPS);
        float lg[32];
#pragma unroll
        for (int e = 0; e < 32; ++e) { float p = 0.f;
#pragma unroll
            for (int j = 0; j < 4; ++j) { const f32x4 w = *(const LAS f32x4*)(wg + e * 1024 + 4 * lane + 256 * j); p += (v[j][0] * w[0] + v[j][1] * w[1]) + (v[j][2] * w[2] + v[j][3] * w[3]); }
            lg[e] = wave_sum(p) * rs + a.in[I_B_R][e]; }
        int bi[4]; float bv[4];
#pragma unroll
        for (int k = 0; k < 4; ++k) { float best = -INFINITY; int be = 0;
#pragma unroll
            for (int e = 0; e < 32; ++e) if (lg[e] > best) { best = lg[e]; be = e; }
#pragma unroll
            for (int e = 0; e < 32; ++e) lg[e] = (e == be) ? -INFINITY : lg[e];
            bi[k] = be; bv[k] = best; }
        const float e1 = expf(bv[1] - bv[0]), e2 = expf(bv[2] - bv[0]), e3 = expf(bv[3] - bv[0]); const float inv = 1.0f / (1.0f + e1 + e2 + e3);
        if (lane == 0) { ((float*)(a.ws + WS_RS2))[tk] = rs;
            int* ti = (int*)(a.ws + WS_TOPI) + (size_t)tk * 4; float* tw = (float*)(a.ws + WS_TOPW) + (size_t)tk * 4;
            ti[0] = bi[0]; ti[1] = bi[1]; ti[2] = bi[2]; ti[3] = bi[3]; tw[0] = inv; tw[1] = e1 * inv; tw[2] = e2 * inv; tw[3] = e3 * inv;
            __hip_atomic_fetch_add(&hist[bi[0]], 1, __ATOMIC_RELAXED, __HIP_MEMORY_SCOPE_WORKGROUP); __hip_atomic_fetch_add(&hist[bi[1]], 1, __ATOMIC_RELAXED, __HIP_MEMORY_SCOPE_WORKGROUP); __hip_atomic_fetch_add(&hist[bi[2]], 1, __ATOMIC_RELAXED, __HIP_MEMORY_SCOPE_WORKGROUP); __hip_atomic_fetch_add(&hist[bi[3]], 1, __ATOMIC_RELAXED, __HIP_MEMORY_SCOPE_WORKGROUP); }
    }
    __syncthreads();
    if (tid < 32) ((int*)(a.ws + WS_MISC))[blk * 32 + tid] = hist[tid];
}
__device__ __forceinline__ void phase_slot(const Args& a, LAS unsigned char* lds, int tid) {
    LAS int* tot = (LAS int*)lds, *bef = tot + 32, *st = tot + 64, *ids = tot + 128;
    const int blk = blockIdx.x, half = blk >> 7; const int* hist = (const int*)(a.ws + WS_MISC);
    int* tile_e = (int*)(a.ws + WS_MISC) + 8192 + half * HTILES; int* ntiles = (int*)(a.ws + WS_MISC) + 8192 + 2 * HTILES;
    int* toklist = (int*)(a.ws + WS_TOKL) + (size_t)half * HSLOTS; int* slot_of = (int*)(a.ws + WS_SLOT); const int* topi = (const int*)(a.ws + WS_TOPI);
    if (tid < 32) { int t = 0, bf = 0; for (int bb = half * 128; bb < half * 128 + 128; ++bb) { const int hv = hist[bb * 32 + tid]; t += hv; if (bb < blk) bf += hv; } tot[tid] = t; bef[tid] = bf; }
    for (int i = tid; i < 1024; i += 512) ids[i] = topi[(size_t)blk * 1024 + i];
    __syncthreads();
    if (tid == 0) { int s = 0; for (int e = 0; e < 32; ++e) { st[e] = s; s += ((tot[e] + 255) >> 8) << 8; } st[32] = s; }
    __syncthreads();
    if (tid < 32) { int cnt = st[tid] + bef[tid];
        for (int i = 0; i < 1024; ++i) if (ids[i] == tid) { const int tk = blk * 256 + (i >> 2); slot_of[(size_t)tk * 4 + (i & 3)] = cnt; toklist[cnt] = tk; ++cnt; }
        if ((blk & 127) == 0) { for (int s = st[tid] + tot[tid]; s < st[tid + 1]; ++s) toklist[s] = half * (T / 2);
            for (int tl = st[tid] >> 8; tl < (st[tid + 1] >> 8); ++tl) tile_e[tl] = tid;
            if (tid == 0) ntiles[half] = st[32] >> 8; } }
}
__device__ __forceinline__ void phase_combine(const Args& a, int half, int lane, int wave, int vcu, int G) {
    const bf16* Y = (const bf16*)(a.ws + WS_Y); const int* slot_of = (const int*)(a.ws + WS_SLOT); const float* tw = (const float*)(a.ws + WS_TOPW);
    for (int m = half * (T / 2) + vcu * NWAVES + wave; m < (half + 1) * (T / 2); m += G * NWAVES) {
        f32x4* xr = (f32x4*)(a.out + (size_t)m * D) + lane; const f32x4* gr = (const f32x4*)a.in[I_NORM_FINAL] + lane;
        f32x4 v[4];
#pragma unroll
        for (int j = 0; j < 4; ++j) v[j] = xr[64 * j];
#pragma unroll
        for (int k = 0; k < 4; ++k) { const int sl = slot_of[(size_t)m * 4 + k]; const float c = tw[(size_t)m * 4 + k]; const v2u* yr = (const v2u*)(Y + (size_t)sl * 1024) + lane;
#pragma unroll
            for (int j = 0; j < 4; ++j) { const v2u w = yr[64 * j]; v[j][0] += c * pg8::bf_lo(w.x); v[j][1] += c * pg8::bf_hi(w.x); v[j][2] += c * pg8::bf_lo(w.y); v[j][3] += c * pg8::bf_hi(w.y); } }
        float s = 0.f;
#pragma unroll
        for (int j = 0; j < 4; ++j) s += (v[j][0] * v[j][0] + v[j][1] * v[j][1]) + (v[j][2] * v[j][2] + v[j][3] * v[j][3]);
        const float rs = 1.0f / sqrtf(wave_sum(s) * (1.f / D) + EPS);
#pragma unroll
        for (int j = 0; j < 4; ++j) xr[64 * j] = v[j] * rs * gr[64 * j];
    }
}
#ifndef DBG_STAGE
#define DBG_STAGE 0
#endif
enum { PH_P0 = 0, PH_Z1, PH_ATT, PH_MLSTM, PH_Z3, PH_BR1, PH_CP1, PH_BR2, PH_CP2, PH_CP3, PH_OUT, PH_RS1, PH_S, PH_PN, PH_PV, PH_ROUTER, PH_SLOT, PH_G1A, PH_G2A, PH_CA, PH_G1B, PH_G2B, PH_CB, N_PHASES };

__global__ void __launch_bounds__(NWAVES * 64, 2) fwd_kernel(Args args) {
    extern __shared__ __attribute__((aligned(16))) unsigned char lds_raw[];
    LAS unsigned char* lds = (LAS unsigned char*)lds_raw;
    volatile LAS unsigned* MISC = (volatile LAS unsigned*)(lds + MISC_OFF);
#define LAUNDER_TID() int tid = threadIdx.x; asm volatile("" : "+v"(tid)); const int lane = tid & 63, wave = __builtin_amdgcn_readfirstlane(tid >> 6)
    const int tid0 = threadIdx.x;
    const int G = gridDim.x; const int bx = blockIdx.x; const int vcu = (G % 8 == 0) ? (bx % 8) * (G / 8) + bx / 8 : bx;
    unsigned char* ws = args.ws;
    if (tid0 < 128) MISC[tid0] = 0u;
    __syncthreads();
    const int lo = args.ph_lo, hi = args.ph_hi;
    XcdBarrier bar; bar.bar = (unsigned*)(ws + WS_CTL) + CW_BAR; bar.x = 0; bar.st = nullptr;
    if (hi - lo > 1) bar = xcd_barrier_post((unsigned*)(ws + WS_CTL) + CW_BAR, MISC + 8);
#ifndef ONLY_PHASE
#define ONLY_PHASE -1
#endif
#ifndef SKIP_MASK
#define SKIP_MASK 0u
#endif
#define IN(k) ((ONLY_PHASE < 0 || ONLY_PHASE == (k)) && !((SKIP_MASK >> (k)) & 1u) && lo <= (k) && (k) < hi)
#define SEAM(k) do { if (IN(k) && IN((k) + 1)) xcd_barrier(bar); } while (0)
    using namespace pg8;
    const bf16_t* B0 = (const bf16_t*)(ws + WS_B0);

    if (IN(PH_P0)) { LAUNDER_TID(); (void)lane; (void)wave; phase_p0(args, lds, tid, lane, wave, vcu, G); } SEAM(PH_P0);
#if DBG_STAGE == 1
    if (IN(PH_Z1)) { LAUNDER_TID(); (void)lane; (void)wave; phase_final_plain(args, args.in[I_X], lane, wave, vcu, G); }
#else
    if (IN(PH_Z1)) {
        OpsPlain O{(const char*)B0, (const char*)(ws + WS_WIN), 2048u, 2048u}; StaticOrder S; S.init_tiles(T / 256, 5120 / 256, G, bx);
        EpiZ1 E{(bf16_t*)(ws + WS_B1), BUF / 2, (const float*)(ws + WS_RS0), QD_SCALE, 2};
        gemm_phase<EpiZ1, StaticOrder, OpsPlain, true>(lds + RING_OFF, O, 1024, S, E);
    } SEAM(PH_Z1);
#ifdef ATT_NAIVE
    if (IN(PH_ATT)) { LAUNDER_TID(); (void)lane; (void)wave; phase_att_naive(args, lds, tid, vcu, G); } SEAM(PH_ATT);
#else
    if (IN(PH_ATT)) { const float lam = diff_lambda(args);
        const attn_body::AttnTensors AT{(const attn_body::bf16*)(ws + WS_B3), (const attn_body::bf16*)(ws + WS_B4), (const attn_body::bf16*)(ws + WS_B5), (attn_body::bf16*)(ws + WS_B3)};
        attn_body::attn_phase<8>((char*)lds_raw, AT, vcu, G, lam, args.in[I_DGAIN]); } SEAM(PH_ATT);
#endif
#ifdef MLSTM_NAIVE
    if (IN(PH_MLSTM)) { LAUNDER_TID(); (void)lane; (void)wave; phase_mlstm_naive(args, lds, tid, lane, wave, vcu, G); } SEAM(PH_MLSTM);
#else
    if (IN(PH_MLSTM)) { for (int u = vcu; u < NB * 4; u += G) mls::mlstm_unit((const unsigned short*)(ws + WS_B1), (unsigned short*)(ws + WS_B2), (const float*)(ws + WS_IF), args.in[I_CONV_W], args.in[I_MGAIN], lds, u >> 2, u & 3); } SEAM(PH_MLSTM);
#endif
    if (IN(PH_Z3)) {
        OpsPlain O{(const char*)B0, (const char*)(ws + WS_WIN) + (size_t)5120 * 2048, 2048u, 2048u}; StaticOrder S; S.init_tiles(T / 256, 3072 / 256, G, bx);
        EpiZ3 E{(bf16_t*)(ws + WS_B2), (bf16_t*)(ws + WS_B1), (bf16_t*)(ws + WS_B4), (const float*)(ws + WS_RS0), args.in[I_B_GATE]};
        gemm_phase<EpiZ3, StaticOrder, OpsPlain, true>(lds + RING_OFF, O, 1024, S, E);
    } SEAM(PH_Z3);
    if (IN(PH_BR1)) {
        OpsPlain O{(const char*)(ws + WS_B2), (const char*)(ws + WS_WBM), 2048u, 2048u}; StaticOrder S; S.init_tiles(T / 256, 4, G, bx);
        EpiGate E{(const bf16_t*)(ws + WS_B1), nullptr, (bf16_t*)(ws + WS_B5)};
        gemm_phase<EpiGate, StaticOrder, OpsPlain, true>(lds + RING_OFF, O, 1024, S, E);
    } SEAM(PH_BR1);
    if (IN(PH_CP1)) {
        OpsPlain O{(const char*)(ws + WS_MEMN), (const char*)(ws + WS_WKV), 2048u, 2048u}; StaticOrder S; S.init_tiles(NB * NMEM / 256, 8, G, bx);
        EpiPlain E{(bf16_t*)(ws + WS_KV), 2048, 1.0f};
        gemm_phase<EpiPlain, StaticOrder, OpsPlain, true>(lds + RING_OFF, O, 1024, S, E);
    } SEAM(PH_CP1);
    if (IN(PH_BR2)) {
        OpsPlain O{(const char*)(ws + WS_B3), (const char*)(ws + WS_WBD), 2048u, 2048u}; StaticOrder S; S.init_tiles(T / 256, 4, G, bx);
        EpiGate E{(const bf16_t*)(ws + WS_B4), (const bf16_t*)(ws + WS_B5), (bf16_t*)(ws + WS_B0)};
        gemm_phase<EpiGate, StaticOrder, OpsPlain, true>(lds + RING_OFF, O, 1024, S, E);
    } SEAM(PH_BR2);
    if (IN(PH_CP2)) {
        { OpsWp O{(const char*)(ws + WS_KV), (const char*)(ws + WS_WQG), 4096u, 2048u}; StaticOrder S; S.init_tiles(NB * 4, 4, G, bx);
          EpiPlain E{(bf16_t*)(ws + WS_WPT), 1024, XS_SCALE};
          gemm_phase<EpiPlain, StaticOrder, OpsWp, true>(lds + RING_OFF, O, 256, S, E); }
    } SEAM(PH_CP2);
    if (IN(PH_CP3)) {
        { OpsVp O{(const char*)(ws + WS_WO), (const char*)(ws + WS_KV), 2048u, 4096u}; StaticOrder S; S.init_tiles(NB * 4, 4, G, bx);
          EpiPlain E{(bf16_t*)(ws + WS_VPT), 1024, 1.0f};
          gemm_phase<EpiPlain, StaticOrder, OpsVp, true>(lds + RING_OFF, O, 256, S, E); }
    } SEAM(PH_CP3);
    if (IN(PH_OUT)) {
        OpsPlain O{(const char*)B0, (const char*)(ws + WS_WOUT), 2048u, 2048u}; StaticOrder S; S.init_tiles(T / 256, 4, G, bx);
        EpiRes E{args.in[I_X], args.out, (bf16_t*)(ws + WS_B1), (float*)(ws + WS_SS1)};
        gemm_phase<EpiRes, StaticOrder, OpsPlain, true>(lds + RING_OFF, O, 1024, S, E);
    } SEAM(PH_OUT);
#if DBG_STAGE == 2
    if (IN(PH_RS1)) { LAUNDER_TID(); (void)lane; (void)wave; phase_final_plain(args, args.out, lane, wave, vcu, G); }
#else
    if (IN(PH_RS1)) { LAUNDER_TID(); (void)lane; (void)wave; phase_rs1(args, tid, vcu, G); } SEAM(PH_RS1);
    if (IN(PH_S)) {
        OpsBatchB O{(const char*)(ws + WS_B1), (const char*)(ws + WS_WPT), 2048u, 2048u, (size_t)1024 * 1024 * 2}; StaticOrder S; S.init_tiles(T / 256, 4, G, bx);
        EpiS E{(bf16_t*)(ws + WS_B3), (const float*)(ws + WS_RS1), (float*)(ws + WS_PSUM)};
        gemm_phase<EpiS, StaticOrder, OpsBatchB, true>(lds + RING_OFF, O, 1024, S, E);
    } SEAM(PH_S);
    if (IN(PH_PN)) { LAUNDER_TID(); (void)lane; (void)wave; phase_pnorm(args, lane, wave, vcu, G); } SEAM(PH_PN);
    if (IN(PH_PV)) {
        OpsBatchB O{(const char*)(ws + WS_B3), (const char*)(ws + WS_VPT), 2048u, 2048u, (size_t)1024 * 1024 * 2}; StaticOrder S; S.init_tiles(T / 256, 4, G, bx);
        EpiRes E{args.out, args.out, (bf16_t*)(ws + WS_B0), (float*)(ws + WS_SS1)};
        gemm_phase<EpiRes, StaticOrder, OpsBatchB, true>(lds + RING_OFF, O, 1024, S, E);
    } SEAM(PH_PV);
#if DBG_STAGE == 3
    if (IN(PH_ROUTER)) { LAUNDER_TID(); (void)lane; (void)wave; phase_final_plain(args, args.out, lane, wave, vcu, G); }
#else
    if (IN(PH_ROUTER)) { LAUNDER_TID(); (void)lane; (void)wave; phase_router(args, lds, tid, lane, wave); } SEAM(PH_ROUTER);
    if (IN(PH_SLOT)) { LAUNDER_TID(); (void)lane; (void)wave; phase_slot(args, lds, tid); } SEAM(PH_SLOT);
#define MOE_HALF(hf, PG1, PG2, PC) \
    if (IN(PG1)) { const int nT = ((const int*)(ws + WS_MISC))[8192 + 2 * HTILES + (hf)]; const int* tl = (const int*)(ws + WS_TOKL) + (size_t)(hf) * HSLOTS; const int* te = (const int*)(ws + WS_MISC) + 8192 + (hf) * HTILES; \
        OpsG1 O{(const char*)B0, (const char*)(ws + WS_WGU), tl, te, 2048u, 2048u}; StaticOrder S; S.init_tiles(nT, 8, G, bx); \
        EpiG1 E{(bf16_t*)(ws + WS_H), (const float*)(ws + WS_RS2), tl, te, args.in[I_B_GU]}; \
        gemm_phase<EpiG1, StaticOrder, OpsG1, true>(lds + RING_OFF, O, 1024, S, E); } SEAM(PG1); \
    if (IN(PG2)) { const int nT = ((const int*)(ws + WS_MISC))[8192 + 2 * HTILES + (hf)]; const int* te = (const int*)(ws + WS_MISC) + 8192 + (hf) * HTILES; \
        OpsG2 O{(const char*)(ws + WS_H), (const char*)(ws + WS_WDN), te, 2048u, 2048u}; StaticOrder S; S.init_tiles(nT, 4, G, bx); \
        EpiG2 E{(bf16_t*)(ws + WS_Y), te, args.in[I_B_DN]}; \
        gemm_phase<EpiG2, StaticOrder, OpsG2, true>(lds + RING_OFF, O, 1024, S, E); } SEAM(PG2); \
    if (IN(PC)) { LAUNDER_TID(); (void)lane; (void)wave; phase_combine(args, (hf), lane, wave, vcu, G); } SEAM(PC);
    MOE_HALF(0, PH_G1A, PH_G2A, PH_CA)
    MOE_HALF(1, PH_G1B, PH_G2B, PH_CB)
#endif
#endif
#endif
#undef IN
#undef SEAM
}

#ifndef MK_ONE_LAUNCH
#define MK_ONE_LAUNCH 0
#endif
extern "C" void kernel_launch(void* const* d_in, const int* in_sizes, int n_in, void* d_out, int out_size, void* d_ws, size_t ws_size, hipStream_t stream) {
    static int grid = 0;
    if (grid == 0) {
        if (n_in != N_INPUTS || out_size != T * D || ws_size < WS_END) { fprintf(stderr, "kernel_launch: unexpected shapes (n_in %d, out %d, ws %zu)\n", n_in, out_size, ws_size); grid = -1; return; }
        int dev = 0, cus = 0, per_cu = 0;
        if (hipGetDevice(&dev) != hipSuccess || hipDeviceGetAttribute(&cus, hipDeviceAttributeMultiprocessorCount, dev) != hipSuccess) { grid = -1; return; }
        if (hipFuncSetAttribute((const void*)fwd_kernel, hipFuncAttributeMaxDynamicSharedMemorySize, LDS_BYTES) != hipSuccess) { fprintf(stderr, "kernel_launch: hipFuncSetAttribute failed\n"); grid = -1; return; }
        if (hipOccupancyMaxActiveBlocksPerMultiprocessor(&per_cu, (const void*)fwd_kernel, NWAVES * 64, LDS_BYTES) != hipSuccess || per_cu < 1) fprintf(stderr, "kernel_launch: occupancy query reports %d\n", per_cu);
        (void)hipGetLastError();
        grid = cus;
    }
    if (grid < 0) return;
    (void)hipMemsetAsync((char*)d_ws + WS_CTL, 0, CTL_ZERO_BYTES, stream);
    Args a{};
    for (int i = 0; i < N_INPUTS; ++i) a.in[i] = (const float*)d_in[i];
    a.out = (float*)d_out; a.ws = (unsigned char*)d_ws;
#if MK_ONE_LAUNCH
    a.ph_lo = 0; a.ph_hi = N_PHASES;
    hipLaunchKernelGGL(fwd_kernel, dim3(grid), dim3(NWAVES * 64), LDS_BYTES, stream, a);
#else
    for (int p = 0; p < N_PHASES; ++p) { a.ph_lo = p; a.ph_hi = p + 1; hipLaunchKernelGGL(fwd_kernel, dim3(grid), dim3(NWAVES * 64), LDS_BYTES, stream, a); }
#endif
}
```

```cpp
#define MK_ONE_LAUNCH 1
#define A6_PROD_PRIO 1
#define Z1_F8_GROUPS 3
#include <hip/hip_runtime.h>
#include <cstdio>
#include <cstdint>
#include <cmath>
#include <hip/hip_bf16.h>
namespace pg8 {
#define PG8_LAS __attribute__((address_space(3)))
typedef unsigned short bf16_t;
typedef short bf16x8 __attribute__((ext_vector_type(8)));
typedef float f32x4 __attribute__((ext_vector_type(4)));
typedef float f32x2 __attribute__((ext_vector_type(2)));
typedef unsigned u32x4 __attribute__((ext_vector_type(4)));
typedef unsigned u32x2 __attribute__((ext_vector_type(2)));
typedef int i32x8 __attribute__((ext_vector_type(8)));
typedef int i32x4 __attribute__((ext_vector_type(4)));
constexpr int BM = 256, BK = 64, HALF = 128, HTB = HALF * BK * 2  , STAGE_BYTES = 8 * HTB, NXCD = 8, WGM = 8;

__host__ __device__ __forceinline__ int lds_byte(int r, int c) { const int st = (r >> 4) * 2 + (c >> 5), rr = r & 15, cc = c & 31, ob = rr * 64 + cc * 2; return st * 1024 + (ob ^ (((ob >> 9) & 1) << 5)); }
__host__ __device__ __forceinline__ void stage_rc(int b, int& R, int& C) { const int st = b / 1024, sb = b % 1024, swz = sb ^ (((sb >> 9) & 1) << 5); R = (st >> 1) * 16 + swz / 64; C = (st & 1) * 32 + (swz % 64) / 2; }
__host__ __device__ __forceinline__ int perm32(int rho) { const int n = rho >> 4, i = rho & 15; return 8 * (i >> 2) + 4 * n + (i & 3); }

struct Unit { int pm, pn; int par; };

struct StaticOrder {
    int nM, nN, nwg, G, c;
    __device__ __forceinline__ void init_tiles(int nM_, int nN_, int G_, int c_) { nM = nM_; nN = nN_; nwg = nM * nN; G = G_; c = c_; }
    __device__ __forceinline__ bool next(int i, Unit& u) const {
        const long L = (long)i * G + c; if (L >= nwg) return false;
        int wgid = (int)L; { const int q = nwg / NXCD, r = nwg % NXCD, xcd = wgid % NXCD, off = wgid / NXCD; wgid = (xcd < r ? xcd * (q + 1) : r * (q + 1) + (xcd - r) * q) + off; }
        const int nig = WGM * nN, gid = wgid / nig, fm = gid * WGM, gsz = (nM - fm) < WGM ? (nM - fm) : WGM;
        u.pm = fm + ((wgid % nig) % gsz); u.pn = (wgid % nig) / gsz; return true;
    }
    __device__ __forceinline__ void a_ready(const Unit&) const {}
    __device__ __forceinline__ void done(const Unit&) const {}
};

typedef float f32x2_c __attribute__((ext_vector_type(2))); typedef __bf16 bf16x2_c __attribute__((ext_vector_type(2)));
__device__ __forceinline__ unsigned cvt_pk_bf16(float lo, float hi) { f32x2_c v = {lo, hi}; bf16x2_c b = __builtin_convertvector(v, bf16x2_c); return __builtin_bit_cast(unsigned, b); }
__device__ __forceinline__ float bf_lo(unsigned w) { return __uint_as_float(w << 16); }
__device__ __forceinline__ float bf_hi(unsigned w) { return __uint_as_float(w & 0xffff0000u); }
__device__ __forceinline__ float sigmoidf_(float v) { return __builtin_amdgcn_rcpf(1.0f + __builtin_amdgcn_exp2f(-1.4426950408889634f * v)); }


template <class Epi, class Sched, class Ops, bool ALIGN_EPI>
__device__ __forceinline__ void gemm_phase(PG8_LAS unsigned char* lds, const Ops& O, const int K, const Sched& S, const Epi& E) {
    int tid_ = threadIdx.x; asm volatile("" : "+v"(tid_));
    const int tid = tid_, wid = __builtin_amdgcn_readfirstlane(tid >> 6), lane = tid & 63, wr = wid >> 2, wc = wid & 3, fr = lane & 15, fq = lane >> 4;
    int nt_ = K / BK; asm volatile("" : "+s"(nt_)); const int nt = nt_;
    const unsigned lda2 = O.lda2, ldb2 = O.ldb2;
    unsigned voffA[2], voffB[2], voffB1[2]; int RA[2], CA2[2];
#pragma unroll
    for (int i = 0; i < 2; ++i) { int R, C; stage_rc(tid * 16 + i * 8192, R, C); const int Rb = Epi::PERM ? ((R & ~31) + perm32(R & 31)) : R;
        RA[i] = R; CA2[i] = C * 2; voffA[i] = (unsigned)R * lda2 + (unsigned)C * 2u; voffB[i] = (unsigned)Rb * ldb2 + (unsigned)C * 2u; voffB1[i] = 0u;
        if constexpr (Epi::P64) { const unsigned cw = 64u * (unsigned)(R >> 5) + 16u * (unsigned)((R >> 2) & 3) + 4u * (unsigned)((R >> 4) & 1) + (unsigned)(R & 3);
            voffB[i] = cw * ldb2 + (unsigned)C * 2u; voffB1[i] = (cw + 8u) * ldb2 + (unsigned)C * 2u; } }
    const size_t kstep = (size_t)(BK * 2);
    const size_t hstepA = Ops::GATHER ? 0 : (size_t)HALF * lda2, hstepB = (size_t)HALF * ldb2; (void)hstepB;
    const unsigned ldsw = (unsigned)wid * 1024u;
    const int aoff = lds_byte(wr * 64 + fr, fq * 8), boff = lds_byte(wc * 32 + fr, fq * 8);
    unsigned voC[2][2], voN[2][2];
#define PG8_SA(b, h) (((b) * 2 + (h)) * HTB)
#define PG8_SB(b, h) ((4 + (b) * 2 + (h)) * HTB)
#define PG8_STAGE_B(bufoff, kptr, h) do { _Pragma("unroll") for (int _i = 0; _i < 2; ++_i) \
        __builtin_amdgcn_global_load_lds((const unsigned*)((kptr) + (Epi::P64 ? (size_t)((h) ? voffB1[_i] : voffB[_i]) : (h) * hstepB + voffB[_i])), (PG8_LAS unsigned*)(lds + (bufoff) + ldsw + _i * 8192), 16, 0, 0); } while (0)
#define PG8_STAGE_A(bufoff, kptr, h) do { _Pragma("unroll") for (int _i = 0; _i < 2; ++_i) \
        __builtin_amdgcn_global_load_lds((const unsigned*)((kptr) + (h) * hstepA + (Ops::GATHER ? voC[h][_i] : voffA[_i])), (PG8_LAS unsigned*)(lds + (bufoff) + ldsw + _i * 8192), 16, 0, 0); } while (0)
#define PG8_CAT8(x, y) __builtin_shufflevector(__builtin_bit_cast(i32x4, (x)), __builtin_bit_cast(i32x4, (y)), 0, 1, 2, 3, 4, 5, 6, 7)
#define PG8_LDA(dst, b, h) do { if constexpr (Ops::FP8) { _Pragma("unroll") for (int m = 0; m < 4; ++m) dst##8[m] = PG8_CAT8(*(const PG8_LAS bf16x8*)(lds + PG8_SA(b, h) + aoff + m * 2048), *(const PG8_LAS bf16x8*)(lds + PG8_SA(b, h) + aoff + m * 2048 + 1024)); } \
        else { _Pragma("unroll") for (int m = 0; m < 4; ++m) _Pragma("unroll") for (int k = 0; k < 2; ++k) dst[m][k] = *(const PG8_LAS bf16x8*)(lds + PG8_SA(b, h) + aoff + m * 2048 + k * 1024); } } while (0)
#define PG8_LDB(dst, b, h) do { if constexpr (Ops::FP8) { _Pragma("unroll") for (int n = 0; n < 2; ++n) dst##8[n] = PG8_CAT8(*(const PG8_LAS bf16x8*)(lds + PG8_SB(b, h) + boff + n * 2048), *(const PG8_LAS bf16x8*)(lds + PG8_SB(b, h) + boff + n * 2048 + 1024)); } \
        else { _Pragma("unroll") for (int n = 0; n < 2; ++n) _Pragma("unroll") for (int k = 0; k < 2; ++k) dst[n][k] = *(const PG8_LAS bf16x8*)(lds + PG8_SB(b, h) + boff + n * 2048 + k * 1024); } } while (0)
#define PG8_MMA(ai, bj, At, Bt) do { __builtin_amdgcn_s_setprio(1); if constexpr (Ops::FP8) { _Pragma("unroll") for (int m = 0; m < 4; ++m) _Pragma("unroll") for (int n = 0; n < 2; ++n) \
            asm volatile("v_mfma_scale_f32_16x16x128_f8f6f4 %0, %1, %2, %0, %3, %4 op_sel_hi:[0,0,0]" : "+v"(acc[ai][bj][m][n]) : "v"(Bt##8[n]), "v"(At##8[m]), "v"(sc_b), "v"(sc_a)); } \
        else { _Pragma("unroll") for (int m = 0; m < 4; ++m) _Pragma("unroll") for (int n = 0; n < 2; ++n) _Pragma("unroll") for (int k = 0; k < 2; ++k) \
            acc[ai][bj][m][n] = __builtin_amdgcn_mfma_f32_16x16x32_bf16(Bt[n][k], At[m][k], acc[ai][bj][m][n], 0, 0, 0); } __builtin_amdgcn_s_setprio(0); } while (0)
#define PG8_WAIT_V(n) asm volatile("s_waitcnt vmcnt(" #n ")" ::: "memory")
#define PG8_WAIT_L(n) asm volatile("s_waitcnt lgkmcnt(" #n ")" ::: "memory")
#define PG8_BAR __builtin_amdgcn_s_barrier()
#define PG8_SCHED __builtin_amdgcn_sched_barrier(0)
#define PG8_GLOAD(vo, u) do { if constexpr (Ops::GATHER) { _Pragma("unroll") for (int _h = 0; _h < 2; ++_h) _Pragma("unroll") for (int _i = 0; _i < 2; ++_i) vo[_h][_i] = O.grow(u, _h * HALF + RA[_i]) + (unsigned)CA2[_i]; } } while (0)
    Unit cur, nxt; int ui = 0;
    if (!S.next(0, cur)) return;
    cur.par = 0;
    f32x4 acc[2][2][4][2];
#pragma unroll
    for (int a = 0; a < 2; ++a)
#pragma unroll
        for (int b = 0; b < 2; ++b)
#pragma unroll
            for (int m = 0; m < 4; ++m)
#pragma unroll
                for (int n = 0; n < 2; ++n) acc[a][b][m][n] = (f32x4){0.f, 0.f, 0.f, 0.f};
    bf16x8 At[4][2], B0[2][2], B1[2][2]; i32x8 At8[4], B08[2], B18[2];
    int sc_a = 0x7f7f7f7f, sc_b = 0x7f7f7f7f; if constexpr (Ops::FP8) { sc_a = O.sa; sc_b = O.sb; }
    const char* cA = O.a_tile(cur); const char* cB = O.b_tile(cur);
    const char* cA2 = nullptr; const char* cB2 = nullptr; int nt1 = nt;
    if constexpr (Ops::DUAL) { cA2 = O.a_tile2(cur); cB2 = O.b_tile2(cur); nt1 = O.nt1; }
    PG8_GLOAD(voC, cur);
    S.a_ready(cur);
    if constexpr (Epi::NSTAGE > 0) { if (wid == 0) E.stage(cur, lds + STAGE_BYTES + 4096 + cur.par * 2048, lane); }
    PG8_STAGE_B(PG8_SB(0, 0), cB, 0); PG8_STAGE_B(PG8_SB(0, 1), cB, 1); PG8_STAGE_A(PG8_SA(0, 0), cA, 0); PG8_STAGE_A(PG8_SA(0, 1), cA, 1);
    if (wr == 1) PG8_BAR;
    PG8_WAIT_V(2); PG8_BAR;
    PG8_STAGE_B(PG8_SB(1, 0), cB + kstep, 0); PG8_STAGE_A(PG8_SA(1, 0), cA + kstep, 0); PG8_STAGE_B(PG8_SB(1, 1), cB + kstep, 1);
    PG8_WAIT_V(6); PG8_BAR;
    for (;;) {
        const bool has_next = S.next(ui + 1, nxt); nxt.par = (ui + 1) & 1;
        const char* nA = has_next ? O.a_tile(nxt) : cA; const char* nB = has_next ? O.b_tile(nxt) : cB;
        if constexpr (Ops::GATHER) { if (has_next) { PG8_GLOAD(voN, nxt); } else {
#pragma unroll
            for (int _h = 0; _h < 2; ++_h)
#pragma unroll
                for (int _i = 0; _i < 2; ++_i) voN[_h][_i] = voC[_h][_i]; } }
        const char* nA2 = nullptr; const char* nB2 = nullptr;
        if constexpr (Ops::DUAL) { nA2 = has_next ? O.a_tile2(nxt) : cA2; nB2 = has_next ? O.b_tile2(nxt) : cB2; }
        for (int t = 0; t < nt; t += 2) {
            const bool last = (t == nt - 2);
            const char* a1; const char* a2; const char* b2;
            if constexpr (Ops::DUAL) {
                a1 = (t < nt1 ? cA + (size_t)t * kstep : cA2 + (size_t)(t - nt1) * kstep) + kstep;
                a2 = last ? nA : (t + 2 < nt1 ? cA + (size_t)(t + 2) * kstep : cA2 + (size_t)(t + 2 - nt1) * kstep);
                b2 = last ? nB : (t + 2 < nt1 ? cB + (size_t)(t + 2) * kstep : cB2 + (size_t)(t + 2 - nt1) * kstep);
                if (t == nt1) E.mid(acc, cur, wr, wc, fr, fq);
            } else {
                a1 = cA + (size_t)(t + 1) * kstep;
                a2 = last ? nA : cA + (size_t)(t + 2) * kstep; b2 = last ? nB : cB + (size_t)(t + 2) * kstep;
            }
            const char* a3 = a2 + kstep; const char* b3 = b2 + kstep;
            if (last && has_next) S.a_ready(nxt);
            PG8_LDB(B0, 0, 0); PG8_LDB(B1, 0, 1); PG8_SCHED; PG8_LDA(At, 0, 0); PG8_STAGE_A(PG8_SA(1, 1), a1, 1);
            if constexpr (Ops::GATHER) { if (last) {
#pragma unroll
                for (int _h = 0; _h < 2; ++_h)
#pragma unroll
                    for (int _i = 0; _i < 2; ++_i) voC[_h][_i] = voN[_h][_i]; } }
            PG8_WAIT_V(8); PG8_WAIT_L(0); PG8_BAR; PG8_MMA(0, 0, At, B0); PG8_MMA(0, 1, At, B1); PG8_BAR; PG8_SCHED;
            PG8_LDA(At, 0, 1); PG8_STAGE_B(PG8_SB(0, 0), b2, 0); PG8_STAGE_B(PG8_SB(0, 1), b2, 1); PG8_STAGE_A(PG8_SA(0, 0), a2, 0);
            PG8_WAIT_V(8); PG8_WAIT_L(0); PG8_BAR; PG8_MMA(1, 0, At, B0); PG8_MMA(1, 1, At, B1); PG8_BAR; PG8_SCHED;
            PG8_LDB(B0, 1, 0); PG8_LDB(B1, 1, 1); PG8_SCHED; PG8_LDA(At, 1, 0); PG8_STAGE_A(PG8_SA(0, 1), a2, 1);
            PG8_WAIT_V(8); PG8_WAIT_L(0); PG8_BAR; PG8_MMA(0, 0, At, B0); PG8_MMA(0, 1, At, B1); PG8_BAR; PG8_SCHED;
            PG8_LDA(At, 1, 1); PG8_STAGE_B(PG8_SB(1, 0), b3, 0); PG8_STAGE_B(PG8_SB(1, 1), b3, 1); PG8_STAGE_A(PG8_SA(1, 0), a3, 0);
            PG8_WAIT_V(8); PG8_WAIT_L(0); PG8_BAR; PG8_MMA(1, 0, At, B0); PG8_MMA(1, 1, At, B1); PG8_BAR; PG8_SCHED;
        }
        if constexpr (ALIGN_EPI) { if (wr == 0) PG8_BAR; }
        { int fr_e = fr, fq_e = fq; asm volatile("" : "+v"(fr_e), "+v"(fq_e));
          E(acc, cur, wr, wc, fr_e, fq_e); } S.done(cur);
        if (!has_next) break;
#pragma unroll
        for (int a = 0; a < 2; ++a)
#pragma unroll
            for (int b = 0; b < 2; ++b)
#pragma unroll
                for (int m = 0; m < 4; ++m)
#pragma unroll
                    for (int n = 0; n < 2; ++n) acc[a][b][m][n] = (f32x4){0.f, 0.f, 0.f, 0.f};
        cur = nxt; cA = nA; cB = nB; ++ui;
        if constexpr (Epi::NSTAGE > 0) { if (wid == 0) E.stage(cur, lds + STAGE_BYTES + 4096 + cur.par * 2048, lane); }
        if constexpr (Ops::DUAL) { cA2 = nA2; cB2 = nB2; }
        if constexpr (ALIGN_EPI) { if (wr == 1) PG8_BAR; }
    }
    PG8_WAIT_V(0);
    if constexpr (!ALIGN_EPI) { if (wr == 0) PG8_BAR; }
    PG8_BAR;
#undef PG8_SA
#undef PG8_SB
#undef PG8_STAGE_A
#undef PG8_STAGE_B
#undef PG8_LDA
#undef PG8_CAT8
#undef PG8_LDB
#undef PG8_MMA
#undef PG8_WAIT_V
#undef PG8_WAIT_L
#undef PG8_BAR
#undef PG8_SCHED
#undef PG8_GLOAD
}
}
namespace pg8 {
struct OpsPlain { static constexpr bool FP8 = false, GATHER = false, DUAL = false; const char* A; const char* B; unsigned lda2, ldb2;
    __device__ __forceinline__ const char* a_tile(const Unit& u) const { return A + (size_t)u.pm * 256 * lda2; }
    __device__ __forceinline__ const char* b_tile(const Unit& u) const { return B + (size_t)u.pn * 256 * ldb2; }
    __device__ __forceinline__ unsigned grow(const Unit&, int) const { return 0u; } };
struct OpsPlainF8 { static constexpr bool FP8 = true, GATHER = false, DUAL = false; const char* A; const char* B; unsigned lda2, ldb2; int sa, sb;
    __device__ __forceinline__ const char* a_tile(const Unit& u) const { return A + (size_t)u.pm * 256 * lda2; }
    __device__ __forceinline__ const char* b_tile(const Unit& u) const { return B + (size_t)u.pn * 256 * ldb2; }
    __device__ __forceinline__ unsigned grow(const Unit&, int) const { return 0u; } };
struct OpsZ { static constexpr bool FP8 = false, GATHER = false, DUAL = false; const char* A; const char* B; unsigned lda2, ldb2; unsigned gmap;
    __device__ __forceinline__ const char* a_tile(const Unit& u) const { return A + (size_t)u.pm * 256 * lda2; }
    __device__ __forceinline__ const char* b_tile(const Unit& u) const { return B + (size_t)(((gmap >> (4 * (u.pn >> 2))) & 15u) * 1024u + (u.pn & 3) * 256u) * ldb2; }
    __device__ __forceinline__ unsigned grow(const Unit&, int) const { return 0u; } };
struct OpsZF8 { static constexpr bool FP8 = true, GATHER = false, DUAL = false; const char* A; const char* B; unsigned lda2, ldb2; unsigned gmap; int sa, sb;
    __device__ __forceinline__ const char* a_tile(const Unit& u) const { return A + (size_t)u.pm * 256 * lda2; }
    __device__ __forceinline__ const char* b_tile(const Unit& u) const { return B + (size_t)(((gmap >> (4 * (u.pn >> 2))) & 15u) * 1024u + (u.pn & 3) * 256u) * ldb2; }
    __device__ __forceinline__ unsigned grow(const Unit&, int) const { return 0u; } };
struct OpsBatchB { static constexpr bool FP8 = false, GATHER = false, DUAL = false; const char* A; const char* B; unsigned lda2, ldb2; size_t bstride;
    __device__ __forceinline__ const char* a_tile(const Unit& u) const { return A + (size_t)u.pm * 256 * lda2; }
    __device__ __forceinline__ const char* b_tile(const Unit& u) const { return B + (size_t)(u.pm >> 4) * bstride + (size_t)u.pn * 256 * ldb2; }
    __device__ __forceinline__ unsigned grow(const Unit&, int) const { return 0u; } };
struct OpsBatchBF8 { static constexpr bool FP8 = true, GATHER = false, DUAL = false; const char* A; const char* B; unsigned lda2, ldb2; size_t bstride; int sa, sb;
    __device__ __forceinline__ const char* a_tile(const Unit& u) const { return A + (size_t)u.pm * 256 * lda2; }
    __device__ __forceinline__ const char* b_tile(const Unit& u) const { return B + (size_t)(u.pm >> 4) * bstride + (size_t)u.pn * 256 * ldb2; }
    __device__ __forceinline__ unsigned grow(const Unit&, int) const { return 0u; } };
struct OpsDual { static constexpr bool FP8 = false, GATHER = false, DUAL = true; const char* A; const char* B; const char* A2; const char* B2; unsigned lda2, ldb2; int nt1;
    __device__ __forceinline__ const char* a_tile(const Unit& u) const { return A + (size_t)u.pm * 256 * lda2; }
    __device__ __forceinline__ const char* b_tile(const Unit& u) const { return B + (size_t)u.pn * 256 * ldb2; }
    __device__ __forceinline__ const char* a_tile2(const Unit& u) const { return A2 + (size_t)u.pm * 256 * lda2; }
    __device__ __forceinline__ const char* b_tile2(const Unit& u) const { return B2 + (size_t)u.pn * 256 * ldb2; }
    __device__ __forceinline__ unsigned grow(const Unit&, int) const { return 0u; } };
struct OpsWp { static constexpr bool FP8 = false, GATHER = false, DUAL = false; const char* kv; const char* wq; unsigned lda2, ldb2;
    __device__ __forceinline__ const char* a_tile(const Unit& u) const { return kv + (size_t)(u.pm >> 2) * 256 * 4096 + (size_t)(u.pm & 3) * 512; }
    __device__ __forceinline__ const char* b_tile(const Unit& u) const { return wq + (size_t)u.pn * 256 * 2048 + (size_t)(u.pm & 3) * 512; }
    __device__ __forceinline__ unsigned grow(const Unit&, int) const { return 0u; } };
struct OpsVp { static constexpr bool FP8 = false, GATHER = false, DUAL = false; const char* wo; const char* kv; unsigned lda2, ldb2;
    __device__ __forceinline__ const char* a_tile(const Unit& u) const { return wo + (size_t)(u.pm & 3) * 256 * 2048 + (size_t)u.pn * 512; }
    __device__ __forceinline__ const char* b_tile(const Unit& u) const { return kv + (size_t)(u.pm >> 2) * 256 * 4096 + 2048 + (size_t)u.pn * 512; }
    __device__ __forceinline__ unsigned grow(const Unit&, int) const { return 0u; } };
#define MOE_MP(pm) ((pm) < nT0 ? (pm) : (pm) - nT0 + MOE_HTILES)
constexpr int MOE_HTILES = 544;
struct OpsG1 { static constexpr bool FP8 = true, GATHER = true, DUAL = false; const char* A; const char* W; const int* toklist; const int* tile_e; unsigned lda2, ldb2; int sa, sb; int nT0;
    __device__ __forceinline__ const char* a_tile(const Unit&) const { return A; }
    __device__ __forceinline__ const char* b_tile(const Unit& u) const { return W + (size_t)tile_e[MOE_MP(u.pm)] * ((size_t)2048 * 1024) + (size_t)u.pn * 256 * 1024; }
    __device__ __forceinline__ unsigned grow(const Unit& u, int r) const { return (unsigned)toklist[MOE_MP(u.pm) * 256 + r] * 1024u; } };
struct OpsG2 { static constexpr bool FP8 = true, GATHER = false, DUAL = false; const char* A; const char* W; const int* tile_e; unsigned lda2, ldb2; int sa, sb; int nT0;
    __device__ __forceinline__ const char* a_tile(const Unit& u) const { return A + (size_t)MOE_MP(u.pm) * 256 * 1024; }
    __device__ __forceinline__ const char* b_tile(const Unit& u) const { return W + (size_t)tile_e[MOE_MP(u.pm)] * ((size_t)1024 * 1024) + (size_t)u.pn * 256 * 1024; }
    __device__ __forceinline__ unsigned grow(const Unit&, int) const { return 0u; } };

__device__ __forceinline__ unsigned pk4_fp8(float a, float b, float c, float d) { int w = 0; w = __builtin_amdgcn_cvt_pk_fp8_f32(a, b, w, false); w = __builtin_amdgcn_cvt_pk_fp8_f32(c, d, w, true); return (unsigned)w; }
#define EPI_ARGS const f32x4 (&acc)[2][2][4][2], const Unit& u, int wr, int wc, int fr, int fq
__device__ __forceinline__ u32x4 pack8(const f32x4 a, const f32x4 b) { u32x4 w; w.x = cvt_pk_bf16(a[0], a[1]); w.y = cvt_pk_bf16(a[2], a[3]); w.z = cvt_pk_bf16(b[0], b[1]); w.w = cvt_pk_bf16(b[2], b[3]); return w; }
__device__ __forceinline__ void unpack8(const u32x4 w, f32x4& a, f32x4& b) { a = (f32x4){bf_lo(w.x), bf_hi(w.x), bf_lo(w.y), bf_hi(w.y)}; b = (f32x4){bf_lo(w.z), bf_hi(w.z), bf_lo(w.w), bf_hi(w.w)}; }

struct EpiZ1 { static constexpr bool PERM = true; static constexpr int NSTAGE = 0; static constexpr bool P64 = false; bf16_t* O; size_t tstride; const float* rs; float qscale; int qtile; unsigned gmap;
    __device__ __forceinline__ void operator()(EPI_ARGS) const {
        const int t = (int)((gmap >> (4 * (u.pn >> 2))) & 15u); bf16_t* base = O + (size_t)t * tstride; const float sc = (t == qtile) ? qscale : 1.f;
        const int col0 = (u.pn & 3) * 256 + wc * 32 + 8 * fq; const int r0 = u.pm * 256 + wr * 64 + fr;
#ifdef KV_ROWMAJOR
        const int W = 10;
#else
        const int W = (t == 3) ? 6 : (t == 4) ? 7 : 10;
#endif
        size_t cpart[2];
#pragma unroll
        for (int bj = 0; bj < 2; ++bj) { const int col = col0 + bj * 128; cpart[bj] = ((size_t)(col >> W) << (12 + W)) + (size_t)(col & ((1 << W) - 1)); }
#pragma unroll
        for (int ai = 0; ai < 2; ++ai)
#pragma unroll
            for (int m = 0; m < 4; ++m) { const float s = sc; const int row = r0 + ai * 128 + m * 16; bf16_t* rowp = base + ((size_t)(row >> 12) << 22) + ((size_t)(row & 4095) << W);
#pragma unroll
                for (int bj = 0; bj < 2; ++bj) *(u32x4*)(rowp + cpart[bj]) = pack8(acc[ai][bj][m][0] * s, acc[ai][bj][m][1] * s); }
    } };
struct EpiZ3 { static constexpr bool PERM = true; static constexpr int NSTAGE = 1; static constexpr bool P64 = false; const bf16_t* HM; bf16_t* HO; bf16_t* GM; bf16_t* GD; const float* rs; const float* bgate; bool dry; unsigned gmap; PG8_LAS unsigned char* elds;
    __device__ __forceinline__ void stage(const Unit& u, PG8_LAS unsigned char* dst, int lane) const {
        const int t = (int)((gmap >> (4 * (u.pn >> 2))) & 15u) - 5;
        if (t >= 1) __builtin_amdgcn_global_load_lds((const unsigned*)(bgate + (t - 1) * 1024 + (u.pn & 3) * 256 + lane * 4), (PG8_LAS unsigned*)dst, 16, 0, 0); }
    __device__ __forceinline__ void operator()(EPI_ARGS) const {
        const int t = (int)((gmap >> (4 * (u.pn >> 2))) & 15u) - 5; const int col0 = (u.pn & 3) * 256 + wc * 32 + 8 * fq; const int r0 = u.pm * 256 + wr * 64 + fr;
#ifdef Z3_FULLDRY
        if (dry) return;
#endif
        float sv[2][4];
#pragma unroll
        for (int ai = 0; ai < 2; ++ai)
#pragma unroll
            for (int m = 0; m < 4; ++m) sv[ai][m] = 1.0f;
        if (t == 0) {
#pragma unroll
            for (int ai = 0; ai < 2; ++ai) { u32x4 hv[4][2];
#pragma unroll
                for (int m = 0; m < 4; ++m)
#pragma unroll
                    for (int bj = 0; bj < 2; ++bj) hv[m][bj] = *(const u32x4*)(HM + (size_t)(r0 + ai * 128 + m * 16) * 1024 + col0 + bj * 128);
#pragma unroll
                for (int m = 0; m < 4; ++m) { const float s = sv[ai][m]; bf16_t* rowp = HO + (size_t)(r0 + ai * 128 + m * 16) * 1024 + col0;
#pragma unroll
                    for (int bj = 0; bj < 2; ++bj) { f32x4 h0, h1; unpack8(hv[m][bj], h0, h1); f32x4 o0, o1;
#pragma unroll
                        for (int i = 0; i < 4; ++i) { o0[i] = sigmoidf_(acc[ai][bj][m][0][i] * s) * h0[i]; o1[i] = sigmoidf_(acc[ai][bj][m][1][i] * s) * h1[i]; }
                        if (!dry) *(u32x4*)(rowp + bj * 128) = pack8(o0, o1); } } }
        } else {
            bf16_t* dst = (t == 1) ? GM : GD; const PG8_LAS float* bb = (const PG8_LAS float*)(elds + u.par * 2048) + wc * 32 + 8 * fq;
            f32x4 bv[2][2];
#pragma unroll
            for (int bj = 0; bj < 2; ++bj)
#pragma unroll
                for (int n = 0; n < 2; ++n) bv[bj][n] = *(const PG8_LAS f32x4*)(bb + bj * 128 + 4 * n);
#pragma unroll
            for (int ai = 0; ai < 2; ++ai)
#pragma unroll
                for (int m = 0; m < 4; ++m) { const float s = sv[ai][m]; bf16_t* rowp = dst + (size_t)(r0 + ai * 128 + m * 16) * 1024 + col0;
#pragma unroll
                    for (int bj = 0; bj < 2; ++bj) { f32x4 o0, o1;
#pragma unroll
                        for (int i = 0; i < 4; ++i) { o0[i] = sigmoidf_(acc[ai][bj][m][0][i] * s + bv[bj][0][i]); o1[i] = sigmoidf_(acc[ai][bj][m][1][i] * s + bv[bj][1][i]); }
                        *(u32x4*)(rowp + bj * 128) = pack8(o0, o1); } }
        }
    } };
struct EpiGate { static constexpr bool PERM = true; static constexpr int NSTAGE = 0; static constexpr bool P64 = false; const bf16_t* Gt; const bf16_t* ADD; bf16_t* Out; bool dry;
    __device__ __forceinline__ void operator()(EPI_ARGS) const {
        if (dry) return;
        const int col0 = u.pn * 256 + wc * 32 + 8 * fq;
#pragma unroll
        for (int ai = 0; ai < 2; ++ai) { u32x4 gv[4][2], av[4][2];
#pragma unroll
            for (int m = 0; m < 4; ++m)
#pragma unroll
                for (int bj = 0; bj < 2; ++bj) { const size_t ro = (size_t)(u.pm * 256 + ai * 128 + wr * 64 + m * 16 + fr) * 1024 + col0 + bj * 128; gv[m][bj] = *(const u32x4*)(Gt + ro); av[m][bj] = ADD ? *(const u32x4*)(ADD + ro) : (u32x4){0u, 0u, 0u, 0u}; }
#pragma unroll
            for (int m = 0; m < 4; ++m)
#pragma unroll
                for (int bj = 0; bj < 2; ++bj) { const size_t ro = (size_t)(u.pm * 256 + ai * 128 + wr * 64 + m * 16 + fr) * 1024 + col0 + bj * 128; f32x4 g0, g1, a0, a1; unpack8(gv[m][bj], g0, g1); unpack8(av[m][bj], a0, a1);
                    *(u32x4*)(Out + ro) = pack8(a0 + g0 * acc[ai][bj][m][0], a1 + g1 * acc[ai][bj][m][1]); } }
    } };
#ifndef BRF_MG
#define BRF_MG 4
#endif
struct EpiBRF { static constexpr bool PERM = true; static constexpr int NSTAGE = 0; static constexpr bool P64 = false; const bf16_t* GM; const bf16_t* GD; bf16_t* Out;
    __device__ __forceinline__ void mid(f32x4 (&acc)[2][2][4][2], const Unit& u, int wr, int wc, int fr, int fq) const {
        const int col0 = u.pn * 256 + wc * 32 + 8 * fq;
#pragma unroll
        for (int ai = 0; ai < 2; ++ai) { u32x4 gm[BRF_MG][2], gd[BRF_MG][2];
#pragma unroll
            for (int mb = 0; mb < 4; mb += BRF_MG) {
#pragma unroll
                for (int mi = 0; mi < BRF_MG; ++mi) { const size_t ro = (size_t)(u.pm * 256 + ai * 128 + wr * 64 + (mb + mi) * 16 + fr) * 1024 + col0;
#pragma unroll
                    for (int bj = 0; bj < 2; ++bj) { gm[mi][bj] = *(const u32x4*)(GM + ro + bj * 128); gd[mi][bj] = *(const u32x4*)(GD + ro + bj * 128); } }
#pragma unroll
                for (int mi = 0; mi < BRF_MG; ++mi) { const int m = mb + mi;
#pragma unroll
                    for (int bj = 0; bj < 2; ++bj) { f32x4 m0, m1, d0, d1; unpack8(gm[mi][bj], m0, m1); unpack8(gd[mi][bj], d0, d1);
#pragma unroll
                        for (int i = 0; i < 4; ++i) { acc[ai][bj][m][0][i] *= m0[i] * __builtin_amdgcn_rcpf(d0[i]); acc[ai][bj][m][1][i] *= m1[i] * __builtin_amdgcn_rcpf(d1[i]); } } }
                asm volatile("" ::: "memory"); } }
    }
    __device__ __forceinline__ void operator()(EPI_ARGS) const {
        const int col0 = u.pn * 256 + wc * 32 + 8 * fq;
#pragma unroll
        for (int ai = 0; ai < 2; ++ai) { u32x4 gd[4][2];
#pragma unroll
            for (int m = 0; m < 4; ++m)
#pragma unroll
                for (int bj = 0; bj < 2; ++bj) gd[m][bj] = *(const u32x4*)(GD + (size_t)(u.pm * 256 + ai * 128 + wr * 64 + m * 16 + fr) * 1024 + col0 + bj * 128);
#pragma unroll
            for (int m = 0; m < 4; ++m)
#pragma unroll
                for (int bj = 0; bj < 2; ++bj) { f32x4 d0, d1; unpack8(gd[m][bj], d0, d1);
                    *(u32x4*)(Out + (size_t)(u.pm * 256 + ai * 128 + wr * 64 + m * 16 + fr) * 1024 + col0 + bj * 128) = pack8(acc[ai][bj][m][0] * d0, acc[ai][bj][m][1] * d1); } }
    } };
template <bool BASE_BF16> struct EpiResB { static constexpr bool PERM = true; static constexpr int NSTAGE = 0; static constexpr bool P64 = true; const void* base; bf16_t* xb; float* ss; unsigned char* xq;
    __device__ __forceinline__ void operator()(EPI_ARGS) const {
        const int col0 = u.pn * 256 + wc * 64 + 16 * fq;
#pragma unroll
        for (int ai = 0; ai < 2; ++ai) { f32x4 bvv[4][2][2];
#pragma unroll
            for (int m = 0; m < 4; ++m)
#pragma unroll
                for (int bj = 0; bj < 2; ++bj) { const size_t off = (size_t)(u.pm * 256 + ai * 128 + wr * 64 + m * 16 + fr) * 1024 + col0 + bj * 8;
                    if constexpr (BASE_BF16) { const u32x4 w = *(const u32x4*)((const bf16_t*)base + off); unpack8(w, bvv[m][bj][0], bvv[m][bj][1]); }
                    else { bvv[m][bj][0] = *(const f32x4*)((const float*)base + off); bvv[m][bj][1] = *(const f32x4*)((const float*)base + off + 4); } }
#pragma unroll
            for (int m = 0; m < 4; ++m) { const int r = u.pm * 256 + ai * 128 + wr * 64 + m * 16 + fr; const size_t ro = (size_t)r * 1024 + col0; float sq = 0.f; u32x4 q8;
#pragma unroll
                for (int bj = 0; bj < 2; ++bj) { const f32x4 o0 = bvv[m][bj][0] + acc[ai][bj][m][0], o1 = bvv[m][bj][1] + acc[ai][bj][m][1];
                    const u32x4 w = pack8(o0, o1); *(u32x4*)(xb + ro + bj * 8) = w;
                    f32x4 q0, q1; unpack8(w, q0, q1);
                    sq += ((q0[0] * q0[0] + q0[1] * q0[1]) + (q0[2] * q0[2] + q0[3] * q0[3])) + ((q1[0] * q1[0] + q1[1] * q1[1]) + (q1[2] * q1[2] + q1[3] * q1[3]));
                    q8[2 * bj] = pk4_fp8(q0[0], q0[1], q0[2], q0[3]); q8[2 * bj + 1] = pk4_fp8(q1[0], q1[1], q1[2], q1[3]); }
                if (xq) *(u32x4*)(xq + ro) = q8;
                if (ss) { sq += __shfl_xor(sq, 16); sq += __shfl_xor(sq, 32);
                    if (fq == 0) ss[(size_t)r * 16 + u.pn * 4 + wc] = sq; } } }
    } };
struct EpiS { static constexpr bool PERM = true; static constexpr int NSTAGE = 0; static constexpr bool P64 = true; unsigned char* P; const float* ss; PG8_LAS float* xl;
    __device__ __forceinline__ void operator()(EPI_ARGS) const {
        const int col0 = u.pn * 256 + wc * 64 + 16 * fq;
        float rsv[2][4];
#pragma unroll
        for (int ai = 0; ai < 2; ++ai)
#pragma unroll
            for (int m = 0; m < 4; ++m) { const int r = u.pm * 256 + ai * 128 + wr * 64 + m * 16 + fr; const f32x4 s0 = *((const f32x4*)(ss + (size_t)r * 16) + fq);
                float sq = (s0[0] + s0[1]) + (s0[2] + s0[3]); sq += __shfl_xor(sq, 16); sq += __shfl_xor(sq, 32);
                const float s = 1.0f / sqrtf(sq * (1.0f / 1024.0f) + 1e-6f); rsv[ai][m] = s; float sum = 0.f;
#pragma unroll
                for (int bj = 0; bj < 2; ++bj)
#pragma unroll
                    for (int n = 0; n < 2; ++n)
#pragma unroll
                        for (int i = 0; i < 4; ++i) sum += __builtin_amdgcn_exp2f(acc[ai][bj][m][n][i] * s);
                sum += __shfl_xor(sum, 16); sum += __shfl_xor(sum, 32);
                if (fq == 0) xl[(ai * 128 + wr * 64 + m * 16 + fr) * 4 + wc] = sum; }
        asm volatile("s_waitcnt lgkmcnt(0)" ::: "memory"); __builtin_amdgcn_s_barrier(); asm volatile("" ::: "memory");
#pragma unroll
        for (int ai = 0; ai < 2; ++ai)
#pragma unroll
            for (int m = 0; m < 4; ++m) { const int rl = ai * 128 + wr * 64 + m * 16 + fr; const f32x4 t4 = *(const PG8_LAS f32x4*)(xl + rl * 4); const float inv = 256.0f / ((t4[0] + t4[1]) + (t4[2] + t4[3])); const float s = rsv[ai][m];
                u32x4 pk;
#pragma unroll
                for (int bj = 0; bj < 2; ++bj) { f32x4 e0, e1;
#pragma unroll
                    for (int i = 0; i < 4; ++i) { e0[i] = __builtin_amdgcn_exp2f(acc[ai][bj][m][0][i] * s) * inv; e1[i] = __builtin_amdgcn_exp2f(acc[ai][bj][m][1][i] * s) * inv; }
                    pk[2 * bj] = pk4_fp8(e0[0], e0[1], e0[2], e0[3]); pk[2 * bj + 1] = pk4_fp8(e1[0], e1[1], e1[2], e1[3]); }
                *(u32x4*)(P + (size_t)(u.pm * 256 + rl) * 1024 + col0) = pk; }
    } };
struct EpiPlain { static constexpr bool PERM = true; static constexpr int NSTAGE = 0; static constexpr bool P64 = false; bf16_t* O; int ldc; float scale;
    __device__ __forceinline__ void operator()(EPI_ARGS) const {
        const int col0 = u.pn * 256 + wc * 32 + 8 * fq;
#pragma unroll
        for (int ai = 0; ai < 2; ++ai)
#pragma unroll
            for (int m = 0; m < 4; ++m) { bf16_t* rowp = O + (size_t)(u.pm * 256 + ai * 128 + wr * 64 + m * 16 + fr) * ldc + col0;
#pragma unroll
                for (int bj = 0; bj < 2; ++bj) *(u32x4*)(rowp + bj * 128) = pack8(acc[ai][bj][m][0] * scale, acc[ai][bj][m][1] * scale); }
    } };
struct EpiPlainF8 { static constexpr bool PERM = true; static constexpr int NSTAGE = 0; static constexpr bool P64 = false; unsigned char* O; int ldc; float scale;
    __device__ __forceinline__ void operator()(EPI_ARGS) const {
        const int col0 = u.pn * 256 + wc * 32 + 8 * fq;
#pragma unroll
        for (int ai = 0; ai < 2; ++ai)
#pragma unroll
            for (int m = 0; m < 4; ++m) { unsigned char* rowp = O + (size_t)(u.pm * 256 + ai * 128 + wr * 64 + m * 16 + fr) * ldc + col0;
#pragma unroll
                for (int bj = 0; bj < 2; ++bj) { const f32x4 v0 = acc[ai][bj][m][0] * scale, v1 = acc[ai][bj][m][1] * scale;
                    *(u32x2*)(rowp + bj * 128) = (u32x2){pk4_fp8(v0[0], v0[1], v0[2], v0[3]), pk4_fp8(v1[0], v1[1], v1[2], v1[3])}; } }
    } };
struct EpiG1 { static constexpr bool PERM = true; static constexpr int NSTAGE = 2; static constexpr bool P64 = false; unsigned char* H; const float* rs; const int* toklist; const int* tile_e; const float* bgu; bool dry; int nT0; PG8_LAS unsigned char* elds;
    __device__ __forceinline__ void stage(const Unit& u, PG8_LAS unsigned char* dst, int lane) const {
        const int mp = MOE_MP(u.pm); const float* bsrc = bgu + (size_t)tile_e[mp] * 2048 + u.pn * 128 + (lane & 31) * 4 + (lane >> 5) * 1024;
        __builtin_amdgcn_global_load_lds((const unsigned*)bsrc, (PG8_LAS unsigned*)dst, 16, 0, 0);
        __builtin_amdgcn_global_load_lds((const unsigned*)(rs + (size_t)mp * 256 + lane * 4), (PG8_LAS unsigned*)(dst + 1024), 16, 0, 0); }
    __device__ __forceinline__ void operator()(EPI_ARGS) const {
#ifdef PROBE_EPI_DRY
        if (dry) return;
#endif
        const int mp = MOE_MP(u.pm); const int colh = u.pn * 128 + wc * 32 + 8 * fq; const PG8_LAS float* el = (const PG8_LAS float*)(elds + u.par * 2048);
        f32x4 bgv[2], buv[2];
#pragma unroll
        for (int n = 0; n < 2; ++n) { bgv[n] = *(const PG8_LAS f32x4*)(el + wc * 32 + 8 * fq + 4 * n); buv[n] = *(const PG8_LAS f32x4*)(el + 128 + wc * 32 + 8 * fq + 4 * n); }
        float sv[2][4];
#pragma unroll
        for (int ai = 0; ai < 2; ++ai)
#pragma unroll
            for (int m = 0; m < 4; ++m) sv[ai][m] = el[256 + ai * 128 + wr * 64 + m * 16 + fr];
#pragma unroll
        for (int n = 0; n < 2; ++n) buv[n] += 1.0f;
#pragma unroll
        for (int ai = 0; ai < 2; ++ai)
#pragma unroll
            for (int m = 0; m < 4; ++m) { const int slot = mp * 256 + ai * 128 + wr * 64 + m * 16 + fr; const float s = sv[ai][m]; f32x4 o[2];
#pragma unroll
                for (int n = 0; n < 2; ++n)
#pragma unroll
                    for (int i = 0; i < 4; ++i) { const float g = fminf(acc[ai][0][m][n][i] * s + bgv[n][i], 7.0f); const float up1 = fminf(fmaxf(acc[ai][1][m][n][i] * s + buv[n][i], -6.0f), 8.0f);
                        o[n][i] = up1 * (g * sigmoidf_(1.702f * g)); }
                *(u32x2*)(H + (size_t)slot * 1024 + colh) = (u32x2){pk4_fp8(o[0][0], o[0][1], o[0][2], o[0][3]), pk4_fp8(o[1][0], o[1][1], o[1][2], o[1][3])}; }
    } };
struct EpiG2 { static constexpr bool PERM = true; static constexpr int NSTAGE = 1; static constexpr bool P64 = true; unsigned char* Y; const int* tile_e; const float* bdn; bool dry; int nT0; PG8_LAS unsigned char* elds;
    __device__ __forceinline__ void stage(const Unit& u, PG8_LAS unsigned char* dst, int lane) const {
        const int mp = MOE_MP(u.pm); const float* src = bdn + (size_t)tile_e[mp] * 1024 + u.pn * 256 + lane * 4;
        __builtin_amdgcn_global_load_lds((const unsigned*)src, (PG8_LAS unsigned*)dst, 16, 0, 0); }
    __device__ __forceinline__ void operator()(EPI_ARGS) const {
        const int mp = MOE_MP(u.pm); const int col0 = u.pn * 256 + wc * 64 + 16 * fq; const PG8_LAS float* bb = (const PG8_LAS float*)(elds + u.par * 2048) + wc * 64 + 16 * fq;
        f32x4 bv[2][2];
#pragma unroll
        for (int bj = 0; bj < 2; ++bj)
#pragma unroll
            for (int n = 0; n < 2; ++n) bv[bj][n] = *(const PG8_LAS f32x4*)(bb + bj * 8 + 4 * n);
#pragma unroll
        for (int ai = 0; ai < 2; ++ai)
#pragma unroll
            for (int m = 0; m < 4; ++m) { unsigned char* rowp = Y + (size_t)(mp * 256 + ai * 128 + wr * 64 + m * 16 + fr) * 1024 + col0; u32x4 pk;
#pragma unroll
                for (int bj = 0; bj < 2; ++bj) { const f32x4 v0 = acc[ai][bj][m][0] + bv[bj][0], v1 = acc[ai][bj][m][1] + bv[bj][1];
                    pk[2 * bj] = pk4_fp8(v0[0], v0[1], v0[2], v0[3]); pk[2 * bj + 1] = pk4_fp8(v1[0], v1[1], v1[2], v1[3]); }
                *(u32x4*)rowp = pk; }
    } };
#undef EPI_ARGS
#undef MOE_MP
}
constexpr int NWAVES = 8;
constexpr int NB = 16, SEQ = 4096, D = 1024, T = NB * SEQ;
constexpr int NMEM = 256, NE = 32, TOPK = 4;
constexpr float EPS = 1e-6f;
constexpr float LOG2E = 1.4426950408889634f;
constexpr float QD_SCALE = 0.125f * LOG2E;
constexpr float XS_SCALE = 0.0625f * LOG2E;
constexpr float LAM_INIT = 0.2f;

constexpr size_t MiB = 1u << 20;
constexpr size_t WS_CTL = 0, CTL_ZERO_BYTES = 1 * MiB;
constexpr size_t WS_RS0 = 1 * MiB;
constexpr size_t WS_RS1 = 1 * MiB + 256 * 1024;
constexpr size_t WS_RS2 = 1 * MiB + 512 * 1024;
constexpr size_t WS_MISC = 1 * MiB + 768 * 1024;
constexpr size_t WS_IF = 2 * MiB;
constexpr size_t WS_SS1 = 4 * MiB;
constexpr size_t WS_PSUM = 12 * MiB;
constexpr size_t WS_TOPI = 16 * MiB, WS_TOPW = 17 * MiB, WS_SLOT = 18 * MiB;
constexpr size_t WS_TOKL = 19 * MiB;
constexpr size_t WS_RSS = 20 * MiB + 512 * 1024;
constexpr int HSLOTS = 139264, HTILES = 544;
constexpr size_t WS_WGT = 22 * MiB;
constexpr size_t WS_WIN = 24 * MiB;
constexpr size_t WS_WBM = 40 * MiB, WS_WBD = 42 * MiB, WS_WOUT = 44 * MiB, WS_WQG = 46 * MiB, WS_WKV = 48 * MiB, WS_WO = 52 * MiB;
constexpr size_t WS_MEMN = 54 * MiB;
constexpr size_t WS_B0 = 64 * MiB, BUF = 128 * MiB;
constexpr size_t WS_B1 = WS_B0 + BUF, WS_B2 = WS_B0 + 2 * BUF, WS_B3 = WS_B0 + 3 * BUF, WS_B4 = WS_B0 + 4 * BUF, WS_B5 = WS_B0 + 5 * BUF;
constexpr size_t WS_KV = WS_B5, WS_WPT = WS_B5 + 16 * MiB, WS_VPT = WS_B5 + 48 * MiB;
constexpr size_t WS_H = WS_B1;
constexpr size_t WS_X2Q = 896 * MiB;
constexpr size_t WS_XQ = 896 * MiB;
constexpr size_t WS_WIN8 = 992 * MiB;
constexpr int SC_P = 0x77777777, SC_V = 0x7a7a7a7a;
constexpr size_t WS_X1Q = WS_B4;
constexpr int SC_ONE = 0x7f7f7f7f, SC_W = 0x78787878;
constexpr size_t WS_Y = WS_B1 + 272 * MiB;
constexpr size_t WS_WGU = 832 * MiB, WS_WDN = 960 * MiB, WS_END = 1024 * MiB;
static_assert(WS_Y + 272 * MiB <= WS_WGU, "map"); static_assert(HTILES == 544, "MOE_HTILES");

constexpr int CW_TMO = 0, CW_CODE = 1, CW_BAR = 4096, CW_Q = 8192;

constexpr int RING_OFF = 0, RING_BYTES = 131072;
constexpr int LDS_BYTES = 163840;
constexpr int MISC_OFF = LDS_BYTES - 512;

#define GAS __attribute__((address_space(1)))
#define LAS __attribute__((address_space(3)))
typedef unsigned short bf16;
typedef unsigned v4u __attribute__((ext_vector_type(4)));
typedef unsigned v2u __attribute__((ext_vector_type(2)));
typedef float f32x4 __attribute__((ext_vector_type(4)));
typedef GAS unsigned gu32;
#define RLX_AGENT __ATOMIC_RELAXED, __HIP_MEMORY_SCOPE_AGENT
#define LDS_WAIT() asm volatile("s_waitcnt lgkmcnt(0)" ::: "memory")
#define VM_WAIT() asm volatile("s_waitcnt vmcnt(0)" ::: "memory")
__device__ __forceinline__ unsigned pk2(float lo, float hi) { return pg8::cvt_pk_bf16(lo, hi); }
__device__ __forceinline__ float bf2f(bf16 v) { return __uint_as_float((unsigned)v << 16); }

#define XB_TMO      128
#define XB_XCNT(j)  (256  + 64 * (j))
#define XB_XSUB(j)  (1280 + 64 * (j))
#define XB_XGEN(j)  (2304 + 64 * (j))
#define XB_TOP      3328
#define XB_TOPGEN   3392
#define XCD_BAR_WORDS 3456
#define XB_SPIN_CAP (1u << 22)
__device__ __forceinline__ unsigned xb_ld(unsigned* p)              { return __hip_atomic_load(p, __ATOMIC_RELAXED, __HIP_MEMORY_SCOPE_AGENT); }
__device__ __forceinline__ unsigned xb_add(unsigned* p, unsigned v) { return __hip_atomic_fetch_add(p, v, __ATOMIC_RELAXED, __HIP_MEMORY_SCOPE_AGENT); }
__device__ __forceinline__ unsigned xb_xcc_id() { return (unsigned)__builtin_amdgcn_s_getreg((3 << 11) | 20) & 0xFu; }
#define XB_SPIN(cond, bar) do { unsigned _sp = 0; while (cond) { __builtin_amdgcn_s_sleep(1); \
    if ((++_sp & 255u) == 0u) { if (xb_ld(&(bar)[XB_TMO])) break; if (_sp > XB_SPIN_CAP) { atomicAdd(&(bar)[XB_TMO], 1u); break; } } } } while (0)
struct XcdBarrier { unsigned* bar; unsigned x; volatile LAS unsigned* st; };
__device__ __forceinline__ XcdBarrier xcd_barrier_post(unsigned* bar, volatile LAS unsigned* st) {
    XcdBarrier b; b.bar = bar; b.x = xb_xcc_id(); b.st = st;
    if (threadIdx.x == 0) (void)xb_add(&bar[XB_XCNT(b.x)], 1u);
    return b;
}
__device__ __forceinline__ void xcd_barrier_complete(unsigned* bar, unsigned x, unsigned& nloc, unsigned& nx) {
    const unsigned G = gridDim.x * gridDim.y * gridDim.z;
    unsigned sum, cnt, mine, sp = 0u;
    for (;;) {
        sum = 0u; cnt = 0u; mine = 0u;
#pragma unroll
        for (unsigned j = 0; j < 16; ++j) { const unsigned c = xb_ld(&bar[XB_XCNT(j)]); sum += c; cnt += (c > 0u) ? 1u : 0u; mine = (j == x) ? c : mine; }
        if (sum == G) break;
        __builtin_amdgcn_s_sleep(1);
        if ((++sp & 255u) == 0u) { if (xb_ld(&bar[XB_TMO])) break; if (sp > XB_SPIN_CAP) { atomicAdd(&bar[XB_TMO], 1u); break; } }
    }
    nloc = mine > 0u ? mine : 1u; nx = cnt > 0u ? cnt : 1u;
}
#ifdef SIMPLE_BARRIER
__device__ __forceinline__ void xcd_barrier(const XcdBarrier& b) {
    asm volatile("s_waitcnt vmcnt(0)" ::: "memory");
    __syncthreads();
    if (threadIdx.x == 0) {
        unsigned* bar = b.bar;
        const unsigned n = ++b.st[2];
        __builtin_amdgcn_fence(__ATOMIC_RELEASE, "agent");
        asm volatile("s_waitcnt vmcnt(0)" ::: "memory");
        xb_add(&bar[XB_TOP], 1u);
        const unsigned want = n * (gridDim.x);
        unsigned sp = 0; while (xb_ld(&bar[XB_TOP]) < want) { __builtin_amdgcn_s_sleep(2); if (++sp > (1u << 24)) break; }
        __builtin_amdgcn_fence(__ATOMIC_ACQUIRE, "agent");
        asm volatile("s_waitcnt vmcnt(0)" ::: "memory");
    }
    __syncthreads();
}
#else
__device__ __forceinline__ void xcd_barrier(const XcdBarrier& b) {
    asm volatile("s_waitcnt vmcnt(0)" ::: "memory");
    __syncthreads();
    if (threadIdx.x == 0) {
        unsigned* bar = b.bar;
        __builtin_amdgcn_s_waitcnt(0);
        unsigned nloc = b.st[0], nx = b.st[1];
        if (nloc == 0u) { xcd_barrier_complete(bar, b.x, nloc, nx); b.st[0] = nloc; b.st[1] = nx; }
        const unsigned old = xb_add(&bar[XB_XSUB(b.x)], 1u);
        const unsigned gen = old / nloc;
        if (old + 1u == (gen + 1u) * nloc) {
            __builtin_amdgcn_fence(__ATOMIC_RELEASE, "agent");
            asm volatile("s_waitcnt vmcnt(0)" ::: "memory");
            const unsigned og = xb_add(&bar[XB_TOP], 1u);
            const unsigned tg = og / nx;
            if (og + 1u == (tg + 1u) * nx) xb_add(&bar[XB_TOPGEN], 1u);
            else XB_SPIN(xb_ld(&bar[XB_TOPGEN]) == tg, bar);
            __builtin_amdgcn_fence(__ATOMIC_ACQUIRE, "agent");
            xb_add(&bar[XB_XGEN(b.x)], 1u);
            asm volatile("s_waitcnt vmcnt(0)" ::: "memory");
        } else {
            XB_SPIN(xb_ld(&bar[XB_XGEN(b.x)]) == gen, bar);
            __builtin_amdgcn_fence(__ATOMIC_ACQUIRE, "agent");
            asm volatile("s_waitcnt vmcnt(0)" ::: "memory");
        }
    }
    __syncthreads();
}
#endif

enum { I_X = 0, I_MEM, I_NORM_MIX, I_W_IN, I_CONV_W, I_B_IF, I_MGAIN, I_DLAM, I_DGAIN, I_W_BM, I_W_BD, I_B_GATE, I_W_OUT, I_NORM_XATTN, I_NORM_MEM, I_WQ, I_WKV, I_WO,
       I_NORM_FFN, I_W_R, I_B_R, I_W_GU, I_B_GU, I_W_DN, I_B_DN, I_NORM_FINAL, N_INPUTS };
struct Args { const float* in[N_INPUTS]; float* out; unsigned char* ws; int ph_lo, ph_hi; };

__device__ __forceinline__ float wave_sum(float v) {
#pragma unroll
    for (int o = 1; o < 64; o <<= 1) v += __shfl_xor(v, o);
    return v;
}
#ifndef EXPERT_SLICES
#define EXPERT_SLICES 4
#endif
namespace att6 {
using bf16x8=__attribute__((ext_vector_type(8)))short;
using s16x4=__attribute__((ext_vector_type(4)))short;
using f32x16=__attribute__((ext_vector_type(16)))float;
using u32x4=__attribute__((ext_vector_type(4)))unsigned;
typedef short v4i16_t __attribute__((ext_vector_type(4)));
typedef float f32x2_t __attribute__((ext_vector_type(2))); typedef __bf16 bf16x2_t __attribute__((ext_vector_type(2)));
#define A6_LAS __attribute__((address_space(3)))
typedef A6_LAS const char* lds_cptr;
typedef A6_LAS char* lds_ptr;
constexpr int SEQ=4096,DM=1024,QB=256,KVBLK=64;
constexpr int KSLOT=8192,VSLOT=16384,PSLOT=32768;
constexpr int L_K=0,L_V=3*KSLOT,L_P=L_V+3*VSLOT,L_F=L_P+2*PSLOT,L_FL=L_F+2*1024,L_L=L_FL+64,L_BYTES=L_L+1024;
__device__ __forceinline__ int crow(int r,int hi){return (r&3)+8*(r>>2)+4*hi;}
__device__ __forceinline__ unsigned cvtpk(float lo,float hi){f32x2_t v={lo,hi};bf16x2_t b=__builtin_convertvector(v,bf16x2_t);return __builtin_bit_cast(unsigned,b);}
__device__ __forceinline__ void glds16(const void*gsrc,unsigned lds_dst){unsigned keep;
  asm volatile("s_mov_b32 %0, m0\n\ts_mov_b32 m0, %2\n\ts_nop 0\n\tglobal_load_lds_dwordx4 %1, off\n\ts_mov_b32 m0, %0":"=&s"(keep):"v"(gsrc),"s"(lds_dst):"memory");}
__device__ __forceinline__ s16x4 vtr(lds_cptr p){ return __builtin_bit_cast(s16x4,__builtin_amdgcn_ds_read_tr16_b64_v4i16((A6_LAS v4i16_t*)p)); }
#define A6_WAIT_BAR(N) asm volatile("s_waitcnt vmcnt(" #N ") lgkmcnt(0)\n\ts_barrier":::"memory")
#define A6_MFMA(a,b,c) __builtin_amdgcn_mfma_f32_32x32x16_bf16((a),(b),(c),0,0,0)

template<int THRL> __device__ __forceinline__ void prod_tile(const bf16x8(&kf)[8],const bf16x8(&qr)[4],f32x16&negm,float&mhat,float&l_reg,const bool first,const int hi,const int r32,const int lane,
                                                             lds_ptr pdst,A6_LAS float*fdst,A6_LAS unsigned*flg){
  f32x16 C0=A6_MFMA(kf[0],qr[0],negm),C1=A6_MFMA(kf[1],qr[0],negm);
  C0=A6_MFMA(kf[2],qr[1],C0);C1=A6_MFMA(kf[3],qr[1],C1);C0=A6_MFMA(kf[4],qr[2],C0);C1=A6_MFMA(kf[5],qr[2],C1);C0=A6_MFMA(kf[6],qr[3],C0);C1=A6_MFMA(kf[7],qr[3],C1);
  float ma=__builtin_fmaxf(__builtin_fmaxf(C0[0],C0[1]),C1[0]),mb=__builtin_fmaxf(__builtin_fmaxf(C0[2],C0[3]),C1[1]); ma=__builtin_fmaxf(__builtin_fmaxf(ma,C1[2]),C1[3]);
  #pragma unroll
  for(int r=4;r<16;r+=4){ma=__builtin_fmaxf(__builtin_fmaxf(ma,C0[r]),C0[r+1]);mb=__builtin_fmaxf(__builtin_fmaxf(mb,C0[r+2]),C0[r+3]);ma=__builtin_fmaxf(__builtin_fmaxf(ma,C1[r]),C1[r+1]);mb=__builtin_fmaxf(__builtin_fmaxf(mb,C1[r+2]),C1[r+3]);}
  float rm=__builtin_fmaxf(ma,mb);
  { auto rr=__builtin_amdgcn_permlane32_swap(__float_as_uint(rm),__float_as_uint(rm),false,false); rm=__builtin_fmaxf(__uint_as_float(rr[0]),__uint_as_float(rr[1])); }
  unsigned flag=0u;
  if(first||__any(rm>(float)THRL)){ const float dl=first?rm:__builtin_fmaxf(rm,0.f); mhat+=dl;
    #pragma unroll
    for(int r=0;r<16;++r){C0[r]-=dl;C1[r]-=dl;}
    #pragma unroll
    for(int r=0;r<16;++r)negm[r]=-mhat;
    if(!first){ const float f=__builtin_amdgcn_exp2f(-dl); l_reg*=f; if(hi==0)fdst[r32]=f; flag=1u; } }
  #pragma unroll
  for(int r=0;r<16;++r){C0[r]=__builtin_amdgcn_exp2f(C0[r]);C1[r]=__builtin_amdgcn_exp2f(C1[r]);}
  { float sa=C0[0]+C1[0],sb=C0[1]+C1[1];
    #pragma unroll
    for(int r=2;r<16;r+=2){sa+=C0[r];sb+=C0[r+1];asm volatile("":"+v"(sa),"+v"(sb));sa+=C1[r];sb+=C1[r+1];asm volatile("":"+v"(sa),"+v"(sb));}
    l_reg+=sa+sb; }
  *(A6_LAS u32x4*)(pdst)     =(u32x4){cvtpk(C0[0],C0[1]),cvtpk(C0[2],C0[3]),cvtpk(C0[4],C0[5]),cvtpk(C0[6],C0[7])};
  *(A6_LAS u32x4*)(pdst+1024)=(u32x4){cvtpk(C0[8],C0[9]),cvtpk(C0[10],C0[11]),cvtpk(C0[12],C0[13]),cvtpk(C0[14],C0[15])};
  *(A6_LAS u32x4*)(pdst+2048)=(u32x4){cvtpk(C1[0],C1[1]),cvtpk(C1[2],C1[3]),cvtpk(C1[4],C1[5]),cvtpk(C1[6],C1[7])};
  *(A6_LAS u32x4*)(pdst+3072)=(u32x4){cvtpk(C1[8],C1[9]),cvtpk(C1[10],C1[11]),cvtpk(C1[12],C1[13]),cvtpk(C1[14],C1[15])};
  if(lane==0)*flg=flag;
}
__device__ __forceinline__ void cons_epi(const f32x16(&o)[4],const int c,const float lam,const float*dgain,const int hi,const int r32,const int lane,A6_LAS const float*lb,A6_LAS unsigned short*os,
                                         unsigned char*pk,unsigned short*Orow,const bool dry){
  if(c==0){
    #pragma unroll
    for(int i=0;i<8;++i){ u32x4 w; const int r=2*i; const float r0=__builtin_amdgcn_rcpf(lb[crow(r,hi)]),r1=__builtin_amdgcn_rcpf(lb[crow(r+1,hi)]);
      #pragma unroll
      for(int j=0;j<4;++j) w[j]=cvtpk(o[j][r]*r0,o[j][r+1]*r1);
      *(u32x4*)(pk+i*1024+lane*16)=w; }
  } else {
    #pragma unroll
    for(int ih=0;ih<2;++ih){ u32x4 w[4];
      #pragma unroll
      for(int i=0;i<4;++i)w[i]=*(const u32x4*)(pk+(ih*4+i)*1024+lane*16);
      #pragma unroll
      for(int i=0;i<4;++i){ const int r=2*(ih*4+i); const float r0=lam*__builtin_amdgcn_rcpf(lb[crow(r,hi)]),r1=lam*__builtin_amdgcn_rcpf(lb[crow(r+1,hi)]);
        #pragma unroll
        for(int j=0;j<4;++j){
          const float p0=__uint_as_float(w[i][j]<<16),p1=__uint_as_float(w[i][j]&0xffff0000u);
          os[crow(r,hi)*128+j*32+r32]  =(unsigned short)(cvtpk(p0-o[j][r]*r0,0.f)&0xffffu);
          os[crow(r+1,hi)*128+j*32+r32]=(unsigned short)(cvtpk(p1-o[j][r+1]*r1,0.f)&0xffffu); } }
      asm volatile("":::"memory"); }
    asm volatile("s_waitcnt lgkmcnt(0)":::"memory");
    if(!dry){
      A6_LAS const unsigned short*src=os+r32*128+hi*64;
      u32x4 v[8]; float sq=0.f;
      #pragma unroll
      for(int i=0;i<8;++i){v[i]=*(A6_LAS const u32x4*)(src+i*8);
        #pragma unroll
        for(int j=0;j<4;++j){const float lo=__uint_as_float(v[i][j]<<16),hh=__uint_as_float(v[i][j]&0xffff0000u);sq+=lo*lo+hh*hh;}}
      {auto rr=__builtin_amdgcn_permlane32_swap(__float_as_uint(sq),__float_as_uint(sq),false,false);sq=__uint_as_float(rr[0])+__uint_as_float(rr[1]);}
      const float rn=1.0f/sqrtf(sq*(1.f/128.f)+1e-6f);
      unsigned short*Ow=Orow+(long)r32*DM+hi*64;
      #pragma unroll
      for(int i=0;i<8;++i){u32x4 ov;
        #pragma unroll
        for(int j=0;j<4;++j){const float lo=__uint_as_float(v[i][j]<<16)*rn,hh=__uint_as_float(v[i][j]&0xffff0000u)*rn;ov[j]=cvtpk(lo,hh);}
        *(u32x4*)(Ow+i*8)=ov;}
    }
  }
}

template<int THRL> __device__ __forceinline__ void unit(int b,int h8,int c,int qb,float lam,const float*dgain,const unsigned short*Q,const unsigned short*K,const unsigned short*V,unsigned short*O,char*shm,unsigned char*park,bool dry){
  int tid_=threadIdx.x; asm volatile("":"+v"(tid_));
  const int tid=tid_,lane=tid&63,r32=lane&31,hi=lane>>5; const int wid=__builtin_amdgcn_readfirstlane(tid>>6);
  const int pr=wid&3;
  const long rowbase=(long)b*SEQ; const int q0=qb*QB;
  const unsigned short*Kh=K+((long)(b*16+2*h8+c)*SEQ)*64,*Vh=V+((long)(b*8+h8)*SEQ)*128;
  const unsigned lds0=(unsigned)(uintptr_t)shm;
  const unsigned short*ksrc=Kh+(long)lane*64+wid*8;
  const unsigned short*vsrc=Vh+(long)(16*(wid&3)+(lane>>2))*128+(wid>>2)*32+(lane&3)*8;
  const unsigned kdst=lds0+L_K+wid*1024, vdst=lds0+L_V+wid*1024;
  #define A6_DMA_K(t,slot) glds16(ksrc+(long)(t)*tstr,(unsigned)__builtin_amdgcn_readfirstlane(kdst+(slot)*KSLOT))
  #define A6_DMA_V(t,slot) do{ const unsigned vs_=(unsigned)__builtin_amdgcn_readfirstlane(vdst+(slot)*VSLOT); glds16(vsrc+(long)(t)*2*tstr,vs_); glds16(vsrc+(long)(t)*2*tstr+64,vs_+8192u); }while(0)
  #define A6_STEP_WAIT(t) do{ if((t)+1<NT){A6_WAIT_BAR(3);}else if((t)+1==NT){A6_WAIT_BAR(2);}else{A6_WAIT_BAR(0);} }while(0)
  #define A6_STEP_DMA(t) do{ if((t)+2<NT)A6_DMA_K((t)+2,s2); if((t)+1<NT)A6_DMA_V((t)+1,s1); }while(0)
#ifdef PROBE_DMA_TILE0
  const long tstr=dry?0:(long)KVBLK*64;
#else
  const long tstr=(long)KVBLK*64;
#endif
  const lds_cptr shm3=(lds_cptr)shm;
  const int NT=(q0+QB)/KVBLK;
  A6_DMA_K(0,0); A6_DMA_K(1,1); A6_DMA_V(0,0);
  int s0=0,s1=1,s2=2;
  if(wid<4){
#ifdef A6_PROD_PRIO
    __builtin_amdgcn_s_setprio(A6_PROD_PRIO);
#endif
    const unsigned short*Qw=Q+(rowbase+q0+pr*64)*DM+(2*h8+c)*64;
    bf16x8 qa[4],qc[4];
    #pragma unroll
    for(int d0=0;d0<4;++d0){qa[d0]=*reinterpret_cast<const bf16x8*>(&Qw[(long)r32*DM+d0*16+hi*8]);qc[d0]=*reinterpret_cast<const bf16x8*>(&Qw[(long)(32+r32)*DM+d0*16+hi*8]);}
    float mh0=0.f,mh1=0.f,l0=0.f,l1=0.f; f32x16 ng0,ng1;
    #pragma unroll
    for(int r=0;r<16;++r){ng0[r]=0.f;ng1[r]=0.f;}
    const lds_cptr kp0=shm3+L_K+hi*1024+r32*16;
    const lds_ptr pd0=(lds_ptr)shm3+L_P+(2*pr)*4096+lane*16;
    A6_LAS float*const fd0=(A6_LAS float*)((lds_ptr)shm3+L_F)+(2*pr)*32;
    A6_LAS unsigned*const fl0=(A6_LAS unsigned*)((lds_ptr)shm3+L_FL)+2*pr;
    for(int t=0;t<=NT;++t){
      A6_STEP_WAIT(t);
      A6_STEP_DMA(t);
      if(t<NT){
        if(t-(NT-4)<=pr){
          const int ps=t&1; const lds_cptr kp=kp0+s0*KSLOT; bf16x8 kf[8];
          #pragma unroll
          for(int j=0;j<4;++j){kf[2*j]=*(A6_LAS const bf16x8*)(kp+j*2048);kf[2*j+1]=*(A6_LAS const bf16x8*)(kp+j*2048+512);}
          prod_tile<THRL>(kf,qa,ng0,mh0,l0,t==0,hi,r32,lane,pd0+ps*PSLOT,fd0+ps*256,fl0+ps*8);
          prod_tile<THRL>(kf,qc,ng1,mh1,l1,t==0,hi,r32,lane,pd0+ps*PSLOT+4096,fd0+ps*256+32,fl0+ps*8+1);
        }
        if(t==NT-1){
          {auto rr=__builtin_amdgcn_permlane32_swap(__float_as_uint(l0),__float_as_uint(l0),false,false);l0=__uint_as_float(rr[0])+__uint_as_float(rr[1]);}
          {auto rr=__builtin_amdgcn_permlane32_swap(__float_as_uint(l1),__float_as_uint(l1),false,false);l1=__uint_as_float(rr[0])+__uint_as_float(rr[1]);}
          A6_LAS float*lb=(A6_LAS float*)((lds_ptr)shm3+L_L)+(2*pr)*32;
          if(hi==0){lb[r32]=l0;lb[32+r32]=l1;} }
      }
      { const int x=s0; s0=s1; s1=s2; s2=x; }
    }
  } else {
#ifdef A6_CONS_PRIO
    __builtin_amdgcn_s_setprio(A6_CONS_PRIO);
#endif
    f32x16 oa[4],ob[4];
    #pragma unroll
    for(int d=0;d<4;++d)
      #pragma unroll
      for(int r=0;r<16;++r){oa[d][r]=0.f;ob[d][r]=0.f;}
    const lds_cptr vp0=shm3+L_V+((lane>>4)&1)*32+(lane&3)*8+(4*hi+((lane&15)>>2))*64;
    const lds_cptr ps0=shm3+L_P+(2*pr)*4096+lane*16;
    A6_LAS const float*const fs0=(A6_LAS const float*)(shm3+L_F)+(2*pr)*32;
    A6_LAS const unsigned*const fl0=(A6_LAS const unsigned*)(shm3+L_FL)+2*pr;
    int sp=0;
    for(int t=0;t<=NT;++t){
      A6_STEP_WAIT(t);
      A6_STEP_DMA(t);
      if(t>=1){
        const int tt=t-1;
        if(tt-(NT-4)<=pr){
          const int ps=tt&1;
          const unsigned f0=(unsigned)__builtin_amdgcn_readfirstlane((int)fl0[ps*8]),f1=(unsigned)__builtin_amdgcn_readfirstlane((int)fl0[ps*8+1]);
          if(f0){
            #pragma unroll
            for(int r=0;r<16;++r){const float f=fs0[ps*256+crow(r,hi)];
              #pragma unroll
              for(int d=0;d<4;++d)oa[d][r]*=f;} }
          if(f1){
            #pragma unroll
            for(int r=0;r<16;++r){const float f=fs0[ps*256+32+crow(r,hi)];
              #pragma unroll
              for(int d=0;d<4;++d)ob[d][r]*=f;} }
          bf16x8 pa[4],pb[4];
          #pragma unroll
          for(int i=0;i<4;++i){pa[i]=*(A6_LAS const bf16x8*)(ps0+ps*PSLOT+i*1024);pb[i]=*(A6_LAS const bf16x8*)(ps0+ps*PSLOT+4096+i*1024);}
          const lds_cptr vp=vp0+sp*VSLOT;
          s16x4 vlo[4],vhi[4];
          #define A6_VRD(i) do{ vlo[(i)&3]=vtr(vp+(((i)&3)*4+((i)>>2))*1024); vhi[(i)&3]=vtr(vp+(((i)&3)*4+((i)>>2))*1024+512); }while(0)
          A6_VRD(0);A6_VRD(1);A6_VRD(2);A6_VRD(3); __builtin_amdgcn_sched_barrier(0);
          #pragma unroll
          for(int i=0;i<16;++i){ const int d=i&3,ks=i>>2;
            const bf16x8 vf=(bf16x8){vlo[d][0],vlo[d][1],vlo[d][2],vlo[d][3],vhi[d][0],vhi[d][1],vhi[d][2],vhi[d][3]};
            oa[d]=A6_MFMA(pa[ks],vf,oa[d]); ob[d]=A6_MFMA(pb[ks],vf,ob[d]);
            if(i+4<16)A6_VRD(i+4);
            __builtin_amdgcn_sched_barrier(0); }
          #undef A6_VRD
        }
        sp=(sp==2)?0:sp+1;
      }
      { const int x=s0; s0=s1; s1=s2; s2=x; }
    }
    { A6_LAS const float*lb=(A6_LAS const float*)(shm3+L_L)+(2*pr)*32;
      unsigned char*pk=park+(size_t)(blockIdx.x*8+2*pr)*8192;
      unsigned short*Or=O+(rowbase+q0+pr*64)*DM+h8*128;
      cons_epi(oa,c,lam,dgain,hi,r32,lane,lb,   (A6_LAS unsigned short*)((lds_ptr)shm3+L_P+pr*8192),      pk,     Or,             dry);
      cons_epi(ob,c,lam,dgain,hi,r32,lane,lb+32,(A6_LAS unsigned short*)((lds_ptr)shm3+L_P+PSLOT+pr*8192),pk+8192,Or+(long)32*DM,dry); }
  }
#if defined(A6_PROD_PRIO) || defined(A6_CONS_PRIO)
  __builtin_amdgcn_s_setprio(0);
#endif
  asm volatile("s_waitcnt lgkmcnt(0)\n\ts_barrier":::"memory");
  #undef A6_DMA_K
  #undef A6_DMA_V
  #undef A6_STEP_WAIT
  #undef A6_STEP_DMA
}
template<int THRL=8,class Between> __device__ __forceinline__ void phase(char*lds,const unsigned short*Q,const unsigned short*K,const unsigned short*V,unsigned short*O,unsigned*qhead,volatile __attribute__((address_space(3))) unsigned*qslot,float lam,const float*dgain,unsigned char*park,bool dry,const Between&between){
  const int x=blockIdx.x&7; unsigned*const qh=qhead+x*64; int nun=0;
  for(;;){
    if(threadIdx.x==0)*qslot=__hip_atomic_fetch_add(qh,1u,__ATOMIC_RELAXED,__HIP_MEMORY_SCOPE_AGENT);
    __syncthreads();
    const unsigned idx=*qslot;
    if(idx>=256u)break;
    between(nun++);
#ifndef A6_QG
#define A6_QG 2
#endif
    const int g4=(int)(idx>>(4+A6_QG)),j=(int)(idx&((16u<<A6_QG)-1u)),qb=15-(j>>A6_QG),b=(g4<<A6_QG)+(j&((1<<A6_QG)-1)),h8=x;
    for(int c=0;c<2;++c) unit<THRL>(b,h8,c,qb,lam,dgain,Q,K,V,O,lds,park,dry);
  }
  for(;nun<EXPERT_SLICES;)between(nun++);
}
#undef A6_WAIT_BAR
#undef A6_MFMA
#undef A6_LAS
}
namespace mls {
typedef short bf16x8 __attribute__((ext_vector_type(8)));
typedef short s16x4 __attribute__((ext_vector_type(4)));
typedef float f32x16 __attribute__((ext_vector_type(16)));
typedef float f32x4 __attribute__((ext_vector_type(4)));
typedef unsigned u32x4 __attribute__((ext_vector_type(4)));
typedef unsigned u32x2 __attribute__((ext_vector_type(2)));
typedef short v4i16_t __attribute__((ext_vector_type(4)));
typedef float f32x2_t __attribute__((ext_vector_type(2))); typedef __bf16 bf16x2_t __attribute__((ext_vector_type(2)));
#define MLS_LAS __attribute__((address_space(3)))
#define MLS_BAR() asm volatile("s_waitcnt lgkmcnt(0)\n\ts_barrier" ::: "memory")
#define MLS_MFMA(a, b, c) __builtin_amdgcn_mfma_f32_32x32x16_bf16((a), (b), (c), 0, 0, 0)
__device__ __forceinline__ int crow(int r, int hi) { return (r & 3) + 8 * (r >> 2) + 4 * hi; }
__device__ __forceinline__ unsigned off_b(unsigned row, unsigned ch) { return 256u * row + 16u * (ch ^ (((row & 3) << 2) | ((row >> 2) & 3))); }
__device__ __forceinline__ unsigned cvtpk(float lo, float hi) { f32x2_t v = {lo, hi}; bf16x2_t b = __builtin_convertvector(v, bf16x2_t); return __builtin_bit_cast(unsigned, b); }
__device__ __forceinline__ float bflo(unsigned w) { return __uint_as_float(w << 16); }
__device__ __forceinline__ float bfhi(unsigned w) { return __uint_as_float(w & 0xffff0000u); }
__device__ __forceinline__ bf16x8 row_frag(MLS_LAS const unsigned char* tile, int lane, int s) { return *(MLS_LAS const bf16x8*)(tile + off_b(lane & 31, 2 * s + (lane >> 5))); }
__device__ __forceinline__ bf16x8 tr_frag(MLS_LAS const unsigned char* tile, int lane, int c, int ks) {
    const unsigned h = lane >> 5, blk = (lane >> 4) & 1, q = (lane & 15) >> 2, p = lane & 3;
    const unsigned a0 = off_b(16 * ks + 8 * h + q, 4 * c + 2 * blk + (p >> 1)) + 8 * (p & 1), a1 = off_b(16 * ks + 8 * h + 4 + q, 4 * c + 2 * blk + (p >> 1)) + 8 * (p & 1);
    const s16x4 lo = __builtin_bit_cast(s16x4, __builtin_amdgcn_ds_read_tr16_b64_v4i16((MLS_LAS v4i16_t*)(tile + a0)));
    const s16x4 hi = __builtin_bit_cast(s16x4, __builtin_amdgcn_ds_read_tr16_b64_v4i16((MLS_LAS v4i16_t*)(tile + a1)));
    return (bf16x8){lo[0], lo[1], lo[2], lo[3], hi[0], hi[1], hi[2], hi[3]};
}
constexpr int L_QS = 0, L_KS = 16384, L_KW = 32768, L_VS = 49152, L_SP = 81920, L_HS = 90112, L_SM = 155648;
constexpr int G_A = 0, G_MM = 64, G_WI = 128, G_WK = 192, G_EI = 256, G_DEC = 320, G_STRIDE = 328, S_R0 = 656, S_R1 = 720, S_NQ = 784, S_NV = 848;
constexpr float LOG2E_ = 1.4426950408889634f;

__device__ __forceinline__ void gate_scan(MLS_LAS float* sm, const float lf, const float ig, int lane, int gb, float& m) {
    float b = lf;
#pragma unroll
    for (int o = 1; o < 64; o <<= 1) { const float v = __shfl_up(b, o); if (lane >= o) b += v; }
    const float a = ig - b; float am = a;
#pragma unroll
    for (int o = 1; o < 64; o <<= 1) { const float v = __shfl_up(am, o); if (lane >= o) am = fmaxf(am, v); }
    const float mm = fmaxf(m, am), mt = b + mm;
    const float blast = __shfl(b, 63), amall = __shfl(am, 63);
    const float mnew = blast + fmaxf(m, amall);
    MLS_LAS float* g = sm + gb * G_STRIDE;
    g[G_A + lane] = a; g[G_MM + lane] = mm; g[G_WI + lane] = expf(m - mm); g[G_WK + lane] = expf(blast + a - mnew); g[G_EI + lane] = expf(-mt);
    if (lane == 0) g[G_DEC] = expf(blast + m - mnew);
    m = mnew;
}

__device__ __forceinline__ void mlstm_unit(const unsigned short* QKM, unsigned short* VM, const float* IF, const float* convw, const float* mgain, MLS_LAS unsigned char* lds, int b, int h, bool dry = false) {
    int tid_ = threadIdx.x; asm volatile("" : "+v"(tid_));
    const int tid0 = tid_, w = __builtin_amdgcn_readfirstlane(tid0 >> 6);
    MLS_LAS float* sm = (MLS_LAS float*)(lds + L_SM);
    MLS_LAS float* hs = (MLS_LAS float*)(lds + L_HS);
    f32x16 CT[4];
#pragma unroll
    for (int j = 0; j < 4; ++j)
#pragma unroll
        for (int i = 0; i < 16; ++i) CT[j][i] = 0.f;
    if (tid0 < 128) sm[S_NV + tid0] = 0.f;
    float mrun = 0.f;
    float nlf = 0.f, nig = 0.f;
    if (w == 3) { const size_t tk = (size_t)b * SEQ + (tid0 & 63); gate_scan(sm, IF[tk * 8 + 4 + h], IF[tk * 8 + h], tid0 & 63, 0, mrun); nlf = IF[(tk + 64) * 8 + 4 + h]; nig = IF[(tk + 64) * 8 + h]; }
    __syncthreads();
    u32x4 pq[7], pv[4];
#define MLS_PREFETCH(CH) do { int tidp = tid0; asm volatile("" : "+v"(tidp)); const int cgp = tidp & 15, whp = (tidp >> 4) & 1, rbp = tidp >> 5; const int chnp = whp * 512 + h * 128 + cgp * 8; \
        _Pragma("unroll") for (int rr = 0; rr < 7; ++rr) { const int t = (CH) * 64 + rbp * 4 + rr - 3; pq[rr] = (u32x4){0u, 0u, 0u, 0u}; if (t >= 0) pq[rr] = *(const u32x4*)(QKM + ((size_t)b * SEQ + t) * 1024 + chnp); } \
        _Pragma("unroll") for (int i = 0; i < 4; ++i) { const int idx = tidp + 512 * i, s = idx >> 5, c8 = idx & 31; pv[i] = *(const u32x4*)(VM + ((size_t)b * SEQ + (CH) * 64 + s) * 1024 + h * 256 + c8 * 8); } } while (0)
    MLS_PREFETCH(0);
    for (int ch = 0; ch < SEQ / 64; ++ch) {
        const size_t tok0 = (size_t)b * SEQ + ch * 64; const int gb = ch & 1;
        MLS_LAS const float* g = sm + gb * G_STRIDE;
#define MLS_FRESH() int tid = tid0; asm volatile("" : "+v"(tid)); const int lane = tid & 63, hi = lane >> 5, r32 = lane & 31; (void)hi; (void)r32
        { MLS_FRESH(); const int cg = tid & 15, which = (tid >> 4) & 1, rb = tid >> 5; const int chn0 = which * 512 + h * 128 + cg * 8;
          float cwv[4][8];
#pragma unroll
          for (int j = 0; j < 4; ++j) { const f32x4 c0 = *(const f32x4*)(convw + j * 1024 + chn0), c1 = *(const f32x4*)(convw + j * 1024 + chn0 + 4);
              cwv[j][0] = c0[0]; cwv[j][1] = c0[1]; cwv[j][2] = c0[2]; cwv[j][3] = c0[3]; cwv[j][4] = c1[0]; cwv[j][5] = c1[1]; cwv[j][6] = c1[2]; cwv[j][7] = c1[3]; }
          float xr[7][8];
#pragma unroll
          for (int rr = 0; rr < 7; ++rr) { const u32x4 wv = pq[rr];
              xr[rr][0] = bflo(wv[0]); xr[rr][1] = bfhi(wv[0]); xr[rr][2] = bflo(wv[1]); xr[rr][3] = bfhi(wv[1]); xr[rr][4] = bflo(wv[2]); xr[rr][5] = bfhi(wv[2]); xr[rr][6] = bflo(wv[3]); xr[rr][7] = bfhi(wv[3]); }
#pragma unroll
          for (int r = 0; r < 4; ++r) { const int t = rb * 4 + r; float o[8];
#pragma unroll
              for (int e = 0; e < 8; ++e) { const float cv = cwv[0][e] * xr[r][e] + cwv[1][e] * xr[r + 1][e] + cwv[2][e] * xr[r + 2][e] + cwv[3][e] * xr[r + 3][e];
                  o[e] = cv * __builtin_amdgcn_rcpf(1.0f + __builtin_amdgcn_exp2f(-LOG2E_ * cv)); }
              const unsigned ob = (unsigned)(t >> 5) * 8192u + off_b(t & 31, cg);
              if (which == 0) { const float sc = 0.08838834764831845f;
                  *(MLS_LAS u32x4*)(lds + L_QS + ob) = (u32x4){cvtpk(o[0] * sc, o[1] * sc), cvtpk(o[2] * sc, o[3] * sc), cvtpk(o[4] * sc, o[5] * sc), cvtpk(o[6] * sc, o[7] * sc)};
              } else { const float wkv = g[G_WK + t];
                  *(MLS_LAS u32x4*)(lds + L_KS + ob) = (u32x4){cvtpk(o[0], o[1]), cvtpk(o[2], o[3]), cvtpk(o[4], o[5]), cvtpk(o[6], o[7])};
                  *(MLS_LAS u32x4*)(lds + L_KW + ob) = (u32x4){cvtpk(o[0] * wkv, o[1] * wkv), cvtpk(o[2] * wkv, o[3] * wkv), cvtpk(o[4] * wkv, o[5] * wkv), cvtpk(o[6] * wkv, o[7] * wkv)}; } }
#pragma unroll
          for (int i = 0; i < 4; ++i) { const int idx = tid + 512 * i, s = idx >> 5, c8 = idx & 31;
              const u32x4 vv = pv[i];
              *(MLS_LAS u32x4*)(lds + L_VS + (unsigned)((s >> 5) * 2 + (c8 >> 4)) * 8192u + off_b(s & 31, c8 & 15)) = vv; } }
        MLS_BAR();
        { MLS_FRESH();
        if (w < 3) { const int sb = (w == 2) ? 1 : 0, tb = (w == 0) ? 0 : 1;
            f32x16 acc;
#pragma unroll
            for (int i = 0; i < 16; ++i) acc[i] = 0.f;
#pragma unroll
            for (int kk = 0; kk < 8; ++kk) acc = MLS_MFMA(row_frag(lds + L_KS + sb * 8192, lane, kk), row_frag(lds + L_QS + tb * 8192, lane, kk), acc);
            const int t = 32 * tb + r32; const float mmv = g[G_MM + t]; float rsum = 0.f;
#pragma unroll
            for (int gq = 0; gq < 4; ++gq) { float v4[4];
#pragma unroll
                for (int e = 0; e < 4; ++e) { const int s = 32 * sb + 8 * gq + 4 * hi + e; const float dv = __builtin_amdgcn_exp2f((g[G_A + s] - mmv) * LOG2E_);
                    v4[e] = (s <= t) ? acc[4 * gq + e] * dv : 0.f; rsum += v4[e]; }
                *(MLS_LAS u32x2*)(lds + L_SP + t * 128 + (((4 * sb + gq) ^ (t & 7)) << 4) + 8 * hi) = (u32x2){cvtpk(v4[0], v4[1]), cvtpk(v4[2], v4[3])}; }
            { auto rr = __builtin_amdgcn_permlane32_swap(__float_as_uint(rsum), __float_as_uint(rsum), false, false); rsum = __uint_as_float(rr[0]) + __uint_as_float(rr[1]); }
            if (hi == 0) sm[(sb ? S_R1 : S_R0) + t] = rsum;
        } else if (w == 3) {
            if (lane < 32) sm[S_R1 + lane] = 0.f;
            if (ch + 1 < SEQ / 64) { gate_scan(sm, nlf, nig, lane, gb ^ 1, mrun);
                if (ch + 2 < SEQ / 64) { nlf = IF[(tok0 + 128 + lane) * 8 + 4 + h]; nig = IF[(tok0 + 128 + lane) * 8 + h]; } }
        } else { const int u = tid - 256, t = u >> 2, p = u & 3; float acc = 0.f;
#pragma unroll
            for (int j = 0; j < 4; ++j) { const u32x4 qw = *(MLS_LAS const u32x4*)(lds + L_QS + (t >> 5) * 8192 + off_b(t & 31, 4 * p + j)); MLS_LAS const float* nv = sm + S_NV + 32 * p + 8 * j;
                acc += (bflo(qw[0]) * nv[0] + bfhi(qw[0]) * nv[1]) + (bflo(qw[1]) * nv[2] + bfhi(qw[1]) * nv[3]) + (bflo(qw[2]) * nv[4] + bfhi(qw[2]) * nv[5]) + (bflo(qw[3]) * nv[6] + bfhi(qw[3]) * nv[7]); }
            acc += __shfl_xor(acc, 1); acc += __shfl_xor(acc, 2);
            if (p == 0) sm[S_NQ + t] = acc; } }
        MLS_BAR();
        if (ch + 1 < SEQ / 64) MLS_PREFETCH(ch + 1);
        { MLS_FRESH(); f32x16 H0, H1;
#pragma unroll
          for (int i = 0; i < 16; ++i) { H0[i] = 0.f; H1[i] = 0.f; }
#pragma unroll
          for (int jb = 0; jb < 4; ++jb)
#pragma unroll
              for (int u = 0; u < 2; ++u) {
                  const bf16x8 Bf = __builtin_bit_cast(bf16x8, (u32x4){cvtpk(CT[jb][8 * u], CT[jb][8 * u + 1]), cvtpk(CT[jb][8 * u + 2], CT[jb][8 * u + 3]), cvtpk(CT[jb][8 * u + 4], CT[jb][8 * u + 5]), cvtpk(CT[jb][8 * u + 6], CT[jb][8 * u + 7])});
                  const unsigned a0 = off_b(r32, 4 * jb + 2 * u) + 8 * hi, a1 = off_b(r32, 4 * jb + 2 * u + 1) + 8 * hi;
                  const u32x2 p00 = *(MLS_LAS const u32x2*)(lds + L_QS + a0), p01 = *(MLS_LAS const u32x2*)(lds + L_QS + a1), p10 = *(MLS_LAS const u32x2*)(lds + L_QS + 8192 + a0), p11 = *(MLS_LAS const u32x2*)(lds + L_QS + 8192 + a1);
                  H0 = MLS_MFMA(__builtin_bit_cast(bf16x8, (u32x4){p00[0], p00[1], p01[0], p01[1]}), Bf, H0);
                  H1 = MLS_MFMA(__builtin_bit_cast(bf16x8, (u32x4){p10[0], p10[1], p11[0], p11[1]}), Bf, H1); }
#pragma unroll
          for (int i = 0; i < 16; ++i) { H0[i] *= g[G_WI + crow(i, hi)]; H1[i] *= g[G_WI + 32 + crow(i, hi)]; }
          bf16x8 Vf[2][2];
#pragma unroll
          for (int sh = 0; sh < 2; ++sh)
#pragma unroll
              for (int ks = 0; ks < 2; ++ks) Vf[sh][ks] = tr_frag(lds + L_VS + (sh * 2 + (w >> 2)) * 8192, lane, w & 3, ks);
#pragma unroll
          for (int u = 0; u < 2; ++u) {
              const bf16x8 s00 = *(MLS_LAS const bf16x8*)(lds + L_SP + r32 * 128 + (((2 * u + hi) ^ (r32 & 7)) << 4));
              const bf16x8 s10 = *(MLS_LAS const bf16x8*)(lds + L_SP + (32 + r32) * 128 + (((2 * u + hi) ^ (r32 & 7)) << 4));
              const bf16x8 s11 = *(MLS_LAS const bf16x8*)(lds + L_SP + (32 + r32) * 128 + (((4 + 2 * u + hi) ^ (r32 & 7)) << 4));
              H0 = MLS_MFMA(s00, Vf[0][u], H0); H1 = MLS_MFMA(s10, Vf[0][u], H1); H1 = MLS_MFMA(s11, Vf[1][u], H1); }
#pragma unroll
          for (int i = 0; i < 16; ++i) { hs[crow(i, hi) * 256 + 32 * w + r32] = H0[i]; hs[(32 + crow(i, hi)) * 256 + 32 * w + r32] = H1[i]; }
          const float decay = g[G_DEC];
#pragma unroll
          for (int jb = 0; jb < 4; ++jb) {
#pragma unroll
              for (int i = 0; i < 16; ++i) CT[jb][i] *= decay;
#pragma unroll
              for (int sh = 0; sh < 2; ++sh)
#pragma unroll
                  for (int ks = 0; ks < 2; ++ks) CT[jb] = MLS_MFMA(tr_frag(lds + L_KW + sh * 8192, lane, jb, ks), Vf[sh][ks], CT[jb]); }
          { const int dk = tid >> 2, p = tid & 3; float acc = 0.f;
#pragma unroll
            for (int e = 0; e < 16; ++e) { const int s = 16 * p + e; acc += __uint_as_float((unsigned)*(MLS_LAS const unsigned short*)(lds + L_KW + (s >> 5) * 8192 + off_b(s & 31, dk >> 3) + (dk & 7) * 2) << 16); }
            acc += __shfl_xor(acc, 1); acc += __shfl_xor(acc, 2);
            if (p == 0) sm[S_NV + dk] = decay * sm[S_NV + dk] + acc; } }
        MLS_BAR();
        { MLS_FRESH(); const int t = tid >> 3, seg = tid & 7;
          const float den = fmaxf(fabsf(sm[S_R0 + t] + sm[S_R1 + t] + g[G_WI + t] * sm[S_NQ + t]), g[G_EI + t]); const float inv = 1.0f / den;
          f32x4 v[8]; float sq = 0.f;
#pragma unroll
          for (int j = 0; j < 8; ++j) { v[j] = *(MLS_LAS const f32x4*)(hs + t * 256 + seg * 32 + j * 4) * inv; sq += (v[j][0] * v[j][0] + v[j][1] * v[j][1]) + (v[j][2] * v[j][2] + v[j][3] * v[j][3]); }
          sq += __shfl_xor(sq, 1); sq += __shfl_xor(sq, 2); sq += __shfl_xor(sq, 4);
          const float rn = 1.0f / sqrtf(sq * (1.f / 256.f) + 1e-6f);
          unsigned short* op = VM + (tok0 + t) * 1024 + h * 256 + seg * 32;
#pragma unroll
          for (int j = 0; j < 4; ++j) { const f32x4 a0 = v[2 * j] * rn, a1 = v[2 * j + 1] * rn;
              if (!dry) *(u32x4*)(op + 8 * j) = (u32x4){cvtpk(a0[0], a0[1]), cvtpk(a0[2], a0[3]), cvtpk(a1[0], a1[1]), cvtpk(a1[2], a1[3])}; } }
    }
    __syncthreads();
}
}
__device__ __forceinline__ void transpose_item(const float* W, int ldw, int k0, int n0, bf16* WT, int ldt, int drow0, const float* gain, LAS float* scr, int lane, int gmask = 0x7fffffff, float gscale = 1.0f) {
    const int rg = lane >> 3, c4 = lane & 7;
    f32x4 v[8];
#pragma unroll
    for (int i = 0; i < 8; ++i) v[i] = *(const f32x4*)(W + (size_t)(k0 + 8 * i + rg) * ldw + n0 + 4 * c4);
#pragma unroll
    for (int i = 0; i < 8; ++i) { const int kk = 8 * i + rg; const float g = gain ? gain[(k0 + kk) & gmask] * gscale : 1.0f; LAS float* d = scr + kk * 33 + 4 * c4; d[0] = v[i][0] * g; d[1] = v[i][1] * g; d[2] = v[i][2] * g; d[3] = v[i][3] * g; }
    LDS_WAIT(); asm volatile("" ::: "memory");
    const int c = lane & 7;
#pragma unroll
    for (int j = 0; j < 4; ++j) { const int n = (lane >> 3) + 8 * j; const LAS float* s = scr + (8 * c) * 33 + n;
        v4u o; o.x = pk2(s[0 * 33], s[1 * 33]); o.y = pk2(s[2 * 33], s[3 * 33]); o.z = pk2(s[4 * 33], s[5 * 33]); o.w = pk2(s[6 * 33], s[7 * 33]);
        *(v4u*)(WT + (size_t)(drow0 + n) * ldt + k0 + 8 * c) = o; }
    LDS_WAIT(); asm volatile("" ::: "memory");
}
__device__ __forceinline__ void transpose_item_f8(const float* W, int ldw, int k0, int n0, unsigned char* WT, int ldt, int drow0, const float* gain, LAS float* scr, int lane) {
    const int rg = lane >> 3, c4 = lane & 7;
    f32x4 v[8];
#pragma unroll
    for (int i = 0; i < 8; ++i) v[i] = *(const f32x4*)(W + (size_t)(k0 + 8 * i + rg) * ldw + n0 + 4 * c4);
#pragma unroll
    for (int i = 0; i < 8; ++i) { const int kk = 8 * i + rg; const float g = (gain ? gain[k0 + kk] : 1.0f) * 128.0f; LAS float* d = scr + kk * 33 + 4 * c4; d[0] = v[i][0] * g; d[1] = v[i][1] * g; d[2] = v[i][2] * g; d[3] = v[i][3] * g; }
    LDS_WAIT(); asm volatile("" ::: "memory");
    const int c = lane & 7;
#pragma unroll
    for (int j = 0; j < 4; ++j) { const int n = (lane >> 3) + 8 * j; const LAS float* s = scr + (8 * c) * 33 + n;
        v2u o; o.x = pg8::pk4_fp8(s[0 * 33], s[1 * 33], s[2 * 33], s[3 * 33]); o.y = pg8::pk4_fp8(s[4 * 33], s[5 * 33], s[6 * 33], s[7 * 33]);
        *(v2u*)(WT + (size_t)(drow0 + n) * ldt + k0 + 8 * c) = o; }
    LDS_WAIT(); asm volatile("" ::: "memory");
}
__device__ __forceinline__ int win_src_col(int drow0) {
    return drow0 < 2048 ? drow0 : drow0 < 3072 ? 3080 + (drow0 - 2048) : drow0 < 4096 ? 4104 + (drow0 - 3072) : drow0 < 5120 ? 5128 + (drow0 - 4096) : drow0 < 6144 ? 2048 + (drow0 - 5120) : 6152 + (drow0 - 6144);
}
__device__ __forceinline__ float log_sigmoid_(float x) { return x < 0.f ? x - log1pf(expf(x)) : -log1pf(expf(-x)); }

__device__ __forceinline__ void p0_expert_items(const Args& a, LAS unsigned char* lds, int lane, int wave, int part, int nparts) {
    unsigned char* ws = a.ws;
    LAS float* scr = (LAS float*)(lds + wave * 16384);
    constexpr int I_GU = 32 * 16 * 64, I_DN = 32 * 16 * 32;
    for (int it = part * NWAVES + wave; it < I_GU + I_DN; it += nparts * NWAVES) {
        int r = it;
        if (r < I_GU) { const int e = r >> 10, q = r & 1023, kb = q >> 6, nb = q & 63, n0 = 32 * nb;
            const int drow0 = n0 < 1024 ? (n0 >> 7) * 256 + (n0 & 127) : ((n0 - 1024) >> 7) * 256 + 128 + ((n0 - 1024) & 127);
            transpose_item_f8(a.in[I_W_GU] + (size_t)e * 1024 * 2048, 2048, 64 * kb, n0, (unsigned char*)(ws + WS_WGU) + (size_t)e * 2048 * 1024, 1024, drow0, a.in[I_NORM_FFN], scr, lane); continue; } r -= I_GU;
        { const int e = r >> 9, q = r & 511; transpose_item_f8(a.in[I_W_DN] + (size_t)e * 1024 * 1024, 1024, 64 * (q >> 5), 32 * (q & 31), (unsigned char*)(ws + WS_WDN) + (size_t)e * 1024 * 1024, 1024, 32 * (q & 31), nullptr, scr, lane); }
    }
}
__device__ __forceinline__ void phase_p0(const Args& a, LAS unsigned char* lds, int tid, int lane, int wave, int vcu, int G) {
    unsigned char* ws = a.ws;
    const int gw = vcu * NWAVES + wave, NGW = G * NWAVES;
    LAS float* scr = (LAS float*)(lds + wave * 16384);
    constexpr int I_IN = 16 * 256, I_SQ = 16 * 32, I_KV = 16 * 64, I_GU = 32 * 16 * 64, I_DN = 32 * 16 * 32;
#ifdef EXPERT_CONV_IN_ATT
    constexpr int NITEMS = I_IN + 4 * I_SQ + I_KV;
#else
    constexpr int NITEMS = I_IN + 4 * I_SQ + I_KV + I_GU + I_DN;
#endif
    for (int it = gw; it < NITEMS; it += NGW) {
        int r = it;
        if (r < I_IN) { const int kb = r >> 8, nb = r & 255; transpose_item(a.in[I_W_IN], 8200, 64 * kb, win_src_col(32 * nb), (bf16*)(ws + WS_WIN), 1024, 32 * nb, a.in[I_NORM_MIX], scr, lane);
            transpose_item_f8(a.in[I_W_IN], 8200, 64 * kb, win_src_col(32 * nb), (unsigned char*)(ws + WS_WIN8), 1024, 32 * nb, a.in[I_NORM_MIX], scr, lane); continue; } r -= I_IN;
        if (r < I_SQ) { transpose_item(a.in[I_W_BM], 1024, 64 * (r >> 5), 32 * (r & 31), (bf16*)(ws + WS_WBM), 1024, 32 * (r & 31), a.in[I_MGAIN], scr, lane); continue; }     r -= I_SQ;
        if (r < I_SQ) { transpose_item(a.in[I_W_BD], 1024, 64 * (r >> 5), 32 * (r & 31), (bf16*)(ws + WS_WBD), 1024, 32 * (r & 31), a.in[I_DGAIN], scr, lane, 127, 1.0f - LAM_INIT); continue; }     r -= I_SQ;
        if (r < I_SQ) { transpose_item(a.in[I_W_OUT], 1024, 64 * (r >> 5), 32 * (r & 31), (bf16*)(ws + WS_WOUT), 1024, 32 * (r & 31), nullptr, scr, lane); continue; } r -= I_SQ;
        if (r < I_SQ) { transpose_item(a.in[I_WO], 1024, 64 * (r >> 5), 32 * (r & 31), (bf16*)(ws + WS_WO), 1024, 32 * (r & 31), nullptr, scr, lane); continue; } r -= I_SQ;
        if (r < I_KV) { transpose_item(a.in[I_WKV], 2048, 64 * (r >> 6), 32 * (r & 63), (bf16*)(ws + WS_WKV), 1024, 32 * (r & 63), nullptr, scr, lane); continue; } r -= I_KV;
        if (r < I_GU) { const int e = r >> 10, q = r & 1023, kb = q >> 6, nb = q & 63, n0 = 32 * nb;
            const int drow0 = n0 < 1024 ? (n0 >> 7) * 256 + (n0 & 127) : ((n0 - 1024) >> 7) * 256 + 128 + ((n0 - 1024) & 127);
            transpose_item_f8(a.in[I_W_GU] + (size_t)e * 1024 * 2048, 2048, 64 * kb, n0, (unsigned char*)(ws + WS_WGU) + (size_t)e * 2048 * 1024, 1024, drow0, a.in[I_NORM_FFN], scr, lane); continue; } r -= I_GU;
        { const int e = r >> 9, q = r & 511; transpose_item_f8(a.in[I_W_DN] + (size_t)e * 1024 * 1024, 1024, 64 * (q >> 5), 32 * (q & 31), (unsigned char*)(ws + WS_WDN) + (size_t)e * 1024 * 1024, 1024, 32 * (q & 31), nullptr, scr, lane); }
    }
    for (int idx = (vcu * 512 + tid); idx < 1024 * 1024 / 4; idx += G * 512) { const int row = idx >> 8; const float g = a.in[I_NORM_XATTN][row];
        const f32x4 v = *(const f32x4*)(a.in[I_WQ] + (size_t)idx * 4); v2u o; o.x = pk2(v[0] * g, v[1] * g); o.y = pk2(v[2] * g, v[3] * g); *(v2u*)((bf16*)(ws + WS_WQG) + (size_t)idx * 4) = o; }
    for (int idx = (vcu * 512 + tid); idx < 32 * 1024; idx += G * 512) { const int e = idx >> 10, k = idx & 1023; ((float*)(ws + WS_WGT))[idx] = a.in[I_NORM_FFN][k] * a.in[I_W_R][k * 32 + e]; }
    __syncthreads();
    LAS float* wif = (LAS float*)lds;
    for (int idx = tid; idx < 8192; idx += 512) { const int j = idx & 7, k = idx >> 3; wif[j * 1024 + k] = a.in[I_NORM_MIX][k] * a.in[I_W_IN][(size_t)k * 8200 + 3072 + j]; }
    __syncthreads();
    for (int m0 = 2 * gw; m0 < T; m0 += 2 * NGW) {
        f32x4 v[2][4]; float s[2] = {0.f, 0.f}; float p[2][8];
#pragma unroll
        for (int q = 0; q < 2; ++q) { const f32x4* xr = (const f32x4*)(a.in[I_X] + (size_t)(m0 + q) * D) + 2 * lane;
#pragma unroll
            for (int j = 0; j < 4; ++j) v[q][j] = xr[128 * (j >> 1) + (j & 1)]; }
#pragma unroll
        for (int q = 0; q < 2; ++q) {
#pragma unroll
            for (int j = 0; j < 4; ++j) s[q] += (v[q][j][0] * v[q][j][0] + v[q][j][1] * v[q][j][1]) + (v[q][j][2] * v[q][j][2] + v[q][j][3] * v[q][j][3]);
#pragma unroll
            for (int g = 0; g < 8; ++g) { float pp = 0.f;
#pragma unroll
                for (int j = 0; j < 4; ++j) { const f32x4 w = *(const LAS f32x4*)(wif + g * 1024 + 8 * lane + 512 * (j >> 1) + 4 * (j & 1)); pp += (v[q][j][0] * w[0] + v[q][j][1] * w[1]) + (v[q][j][2] * w[2] + v[q][j][3] * w[3]); }
                p[q][g] = pp; } }
        float rs[2], gval[2];
#pragma unroll
        for (int q = 0; q < 2; ++q) { rs[q] = 1.0f / sqrtf(wave_sum(s[q]) * (1.f / D) + EPS);
            { v4u* o16 = (v4u*)((bf16*)(ws + WS_B0) + (size_t)(m0 + q) * D) + lane; const float r_ = rs[q];
#pragma unroll
              for (int jj = 0; jj < 2; ++jj) o16[64 * jj] = (v4u){pk2(v[q][2 * jj][0] * r_, v[q][2 * jj][1] * r_), pk2(v[q][2 * jj][2] * r_, v[q][2 * jj][3] * r_), pk2(v[q][2 * jj + 1][0] * r_, v[q][2 * jj + 1][1] * r_), pk2(v[q][2 * jj + 1][2] * r_, v[q][2 * jj + 1][3] * r_)};
              v2u* o8 = (v2u*)((unsigned char*)(ws + WS_XQ) + (size_t)(m0 + q) * D) + lane;
#pragma unroll
              for (int jj = 0; jj < 2; ++jj) o8[64 * jj] = (v2u){pg8::pk4_fp8(v[q][2 * jj][0] * r_, v[q][2 * jj][1] * r_, v[q][2 * jj][2] * r_, v[q][2 * jj][3] * r_), pg8::pk4_fp8(v[q][2 * jj + 1][0] * r_, v[q][2 * jj + 1][1] * r_, v[q][2 * jj + 1][2] * r_, v[q][2 * jj + 1][3] * r_)}; }
            float r4[4], r2[2], r1;
#pragma unroll
            for (int g = 0; g < 4; ++g) { const bool up = (lane & 32) != 0; const float send = up ? p[q][g] : p[q][g + 4], keep = up ? p[q][g + 4] : p[q][g]; r4[g] = keep + __shfl_xor(send, 32); }
#pragma unroll
            for (int g = 0; g < 2; ++g) { const bool up = (lane & 16) != 0; const float send = up ? r4[g] : r4[g + 2], keep = up ? r4[g + 2] : r4[g]; r2[g] = keep + __shfl_xor(send, 16); }
            { const bool up = (lane & 8) != 0; const float send = up ? r2[0] : r2[1], keep = up ? r2[1] : r2[0]; r1 = keep + __shfl_xor(send, 8); }
            r1 += __shfl_xor(r1, 4); r1 += __shfl_xor(r1, 2); r1 += __shfl_xor(r1, 1);
            gval[q] = r1; }
#pragma unroll
        for (int q = 0; q < 2; ++q) { const int g = ((lane >> 5) & 1) * 4 + ((lane >> 4) & 1) * 2 + ((lane >> 3) & 1);
            if ((lane & 7) == 0) { const float val = gval[q] * rs[q] + a.in[I_B_IF][g]; ((float*)(ws + WS_IF))[(size_t)(m0 + q) * 8 + g] = g < 4 ? val : log_sigmoid_(val); }
            if (lane == 0) ((float*)(ws + WS_RS0))[m0 + q] = rs[q]; }
    }
    for (int m = gw; m < NB * NMEM; m += NGW) {
        const f32x4* xr = (const f32x4*)(a.in[I_MEM] + (size_t)m * D) + lane; const f32x4* gr = (const f32x4*)a.in[I_NORM_MEM] + lane;
        f32x4 v[4]; float s = 0.f;
#pragma unroll
        for (int j = 0; j < 4; ++j) { v[j] = xr[64 * j]; s += (v[j][0] * v[j][0] + v[j][1] * v[j][1]) + (v[j][2] * v[j][2] + v[j][3] * v[j][3]); }
        const float rs = 1.0f / sqrtf(wave_sum(s) * (1.f / D) + EPS);
        unsigned long long* o8 = (unsigned long long*)((bf16*)(ws + WS_MEMN) + (size_t)m * D) + lane;
#pragma unroll
        for (int j = 0; j < 4; ++j) { const f32x4 g = gr[64 * j]; o8[64 * j] = (unsigned long long)pk2(v[j][0] * rs * g[0], v[j][1] * rs * g[1]) | ((unsigned long long)pk2(v[j][2] * rs * g[2], v[j][3] * rs * g[3]) << 32); }
    }
}

__device__ __forceinline__ void att_naive_unit(const Args& a, LAS unsigned char* lds, int tid, int b, int h, int qblk, float lam) {
    const bf16* QD = (const bf16*)(a.ws + WS_B3); const bf16* KD = (const bf16*)(a.ws + WS_B4); const bf16* VD = (const bf16*)(a.ws + WS_B5); bf16* HD = (bf16*)(a.ws + WS_B3);
    const int row = tid >> 2, c = (tid >> 1) & 1, vh = tid & 1;
    const int qpos = qblk * 128 + row; const size_t tok = (size_t)b * SEQ + qpos;
    float q[64];
    { const v4u* qp = (const v4u*)(QD + tok * 1024 + h * 128 + c * 64);
#pragma unroll
      for (int i = 0; i < 8; ++i) { const v4u w = qp[i]; q[8 * i + 0] = pg8::bf_lo(w.x); q[8 * i + 1] = pg8::bf_hi(w.x); q[8 * i + 2] = pg8::bf_lo(w.y); q[8 * i + 3] = pg8::bf_hi(w.y);
          q[8 * i + 4] = pg8::bf_lo(w.z); q[8 * i + 5] = pg8::bf_hi(w.z); q[8 * i + 6] = pg8::bf_lo(w.w); q[8 * i + 7] = pg8::bf_hi(w.w); } }
    const int kmax = ((qpos >> 6) + 1) << 6, ukmax = qblk * 128 + 128;
    float o[64];
#pragma unroll
    for (int i = 0; i < 64; ++i) o[i] = 0.f;
    float mrun = -INFINITY, l = 0.f;
    LAS float* Ks = (LAS float*)lds; LAS float* Vs = (LAS float*)(lds + 8192);
    for (int kt = 0; kt < ukmax; kt += 16) {
        __syncthreads();
        { const int kr = tid >> 5, cc = (tid & 31) * 4; const size_t ko = ((size_t)b * SEQ + kt + kr) * 1024 + h * 128 + cc;
          const v2u kw = *(const v2u*)(KD + ko), vw = *(const v2u*)(VD + ko);
          *(LAS f32x4*)(Ks + kr * 128 + cc) = (f32x4){pg8::bf_lo(kw.x), pg8::bf_hi(kw.x), pg8::bf_lo(kw.y), pg8::bf_hi(kw.y)};
          *(LAS f32x4*)(Vs + kr * 128 + cc) = (f32x4){pg8::bf_lo(vw.x), pg8::bf_hi(vw.x), pg8::bf_lo(vw.y), pg8::bf_hi(vw.y)}; }
        __syncthreads();
#pragma unroll 1
        for (int j = 0; j < 16; ++j) {
            if (kt + j >= kmax) continue;
            float d = 0.f; const LAS f32x4* kp = (const LAS f32x4*)(Ks + j * 128 + c * 64);
#pragma unroll
            for (int i = 0; i < 16; ++i) { const f32x4 kk = kp[i]; d += (q[4 * i] * kk[0] + q[4 * i + 1] * kk[1]) + (q[4 * i + 2] * kk[2] + q[4 * i + 3] * kk[3]); }
            const float mnew = fmaxf(mrun, d); const float alpha = __builtin_amdgcn_exp2f(mrun - mnew), p = __builtin_amdgcn_exp2f(d - mnew);
            l = l * alpha + p; mrun = mnew;
            const LAS f32x4* vp = (const LAS f32x4*)(Vs + j * 128 + vh * 64);
#pragma unroll
            for (int i = 0; i < 16; ++i) { const f32x4 vv = vp[i]; o[4 * i] = o[4 * i] * alpha + p * vv[0]; o[4 * i + 1] = o[4 * i + 1] * alpha + p * vv[1]; o[4 * i + 2] = o[4 * i + 2] * alpha + p * vv[2]; o[4 * i + 3] = o[4 * i + 3] * alpha + p * vv[3]; }
        }
    }
    const float inv = 1.0f / l; float sq = 0.f;
#pragma unroll
    for (int i = 0; i < 64; ++i) { o[i] *= inv; const float other = __shfl_xor(o[i], 2); o[i] = o[i] - lam * other; sq += o[i] * o[i]; }
    sq += __shfl_xor(sq, 1);
    const float rn = 1.0f / sqrtf(sq * (1.f / 128.f) + EPS) * (1.0f - LAM_INIT);
    if (c == 0) { const float* dg = a.in[I_DGAIN] + vh * 64; v4u* op = (v4u*)(HD + tok * 1024 + h * 128 + vh * 64);
#pragma unroll
        for (int i = 0; i < 8; ++i) { v4u w; w.x = pk2(o[8 * i] * rn * dg[8 * i], o[8 * i + 1] * rn * dg[8 * i + 1]); w.y = pk2(o[8 * i + 2] * rn * dg[8 * i + 2], o[8 * i + 3] * rn * dg[8 * i + 3]);
            w.z = pk2(o[8 * i + 4] * rn * dg[8 * i + 4], o[8 * i + 5] * rn * dg[8 * i + 5]); w.w = pk2(o[8 * i + 6] * rn * dg[8 * i + 6], o[8 * i + 7] * rn * dg[8 * i + 7]); op[i] = w; } }
}
__device__ __forceinline__ float diff_lambda(const Args& a) {
    const float* lp = a.in[I_DLAM]; float s1 = 0.f, s2 = 0.f;
    for (int i = 0; i < 64; ++i) { s1 += lp[i] * lp[64 + i]; s2 += lp[128 + i] * lp[192 + i]; }
    return expf(s1) - expf(s2) + LAM_INIT;
}
__device__ __forceinline__ void phase_att_naive(const Args& a, LAS unsigned char* lds, int tid, int vcu, int G) {
    const float lam = diff_lambda(a);
    for (int i = 0;; ++i) { const int u = i * G + vcu; if (u >= NB * 8 * 32) break;
        const int bh = u >> 5, r = (u & 31), rot = (r + 2 * (i >> 1)) & 31, qblk = (i & 1) ? 31 - rot : rot;
        att_naive_unit(a, lds, tid, bh >> 3, bh & 7, qblk, lam);
        __syncthreads(); }
}

__device__ __forceinline__ float bfdot8(const v4u w, const float* c) {
    return (c[0] * pg8::bf_lo(w.x) + c[1] * pg8::bf_hi(w.x)) + (c[2] * pg8::bf_lo(w.y) + c[3] * pg8::bf_hi(w.y)) + (c[4] * pg8::bf_lo(w.z) + c[5] * pg8::bf_hi(w.z)) + (c[6] * pg8::bf_lo(w.w) + c[7] * pg8::bf_hi(w.w));
}
__device__ __forceinline__ void mlstm_naive_unit(const Args& a, LAS unsigned char* lds, int tid, int lane, int wave, int b, int h) {
    const bf16* QKM = (const bf16*)(a.ws + WS_B1); bf16* VM = (bf16*)(a.ws + WS_B2); const float* IF = (const float*)(a.ws + WS_IF);
    LAS bf16* qs = (LAS bf16*)lds;
    LAS bf16* ks = (LAS bf16*)(lds + 16384);
    LAS bf16* vs = (LAS bf16*)(lds + 32768);
    LAS float* Sm = (LAS float*)(lds + 65536);
    LAS float* hs = (LAS float*)(lds + 81920);
    LAS float* sm = (LAS float*)(lds + 147456);
    LAS float* ig = sm, *lf = sm + 64, *bcum = sm + 128, *aarr = sm + 192, *mt = sm + 256, *wint = sm + 320, *wk = sm + 384, *den = sm + 448, *nvec = sm + 512, *scal = sm + 640, *hsqw = sm + 704;
    const int dv = tid >> 1, half = tid & 1;
    float Creg[64];
#pragma unroll
    for (int j = 0; j < 64; ++j) Creg[j] = 0.f;
    if (tid < 128) nvec[tid] = 0.f;
    if (tid == 0) scal[0] = 0.f;
    const float* cw = a.in[I_CONV_W];
    for (int ch = 0; ch < SEQ / 64; ++ch) {
        const size_t tok0 = (size_t)b * SEQ + ch * 64;
        __syncthreads();
        if (tid < 64) { ig[tid] = IF[(tok0 + tid) * 8 + h]; lf[tid] = IF[(tok0 + tid) * 8 + 4 + h]; }
        { const int col = tid & 127, which = (tid >> 7) & 1, tq = tid >> 8;
          const int chn = which * 512 + h * 128 + col; const float w0 = cw[chn], w1 = cw[1024 + chn], w2 = cw[2048 + chn], w3 = cw[3072 + chn];
          const int t0 = ch * 64 + 32 * tq; float x0, x1, x2;
          x0 = (t0 - 3 >= 0) ? bf2f(QKM[((size_t)b * SEQ + t0 - 3) * 1024 + chn]) : 0.f; x1 = (t0 - 2 >= 0) ? bf2f(QKM[((size_t)b * SEQ + t0 - 2) * 1024 + chn]) : 0.f; x2 = (t0 - 1 >= 0) ? bf2f(QKM[((size_t)b * SEQ + t0 - 1) * 1024 + chn]) : 0.f;
          LAS bf16* dst = which ? ks : qs; const float scl = which ? 1.0f : 0.08838834764831845f;
          for (int t = 0; t < 32; ++t) { const float x3 = bf2f(QKM[((size_t)b * SEQ + t0 + t) * 1024 + chn]); const float cv = w0 * x0 + w1 * x1 + w2 * x2 + w3 * x3; const float sv = cv * pg8::sigmoidf_(cv) * scl;
              dst[(32 * tq + t) * 128 + col] = (bf16)(pk2(sv, 0.f) & 0xffffu); x0 = x1; x1 = x2; x2 = x3; } }
        for (int idx = tid; idx < 64 * 32; idx += 512) { const int t = idx >> 5, c8 = (idx & 31) * 8; *(LAS v4u*)(vs + t * 256 + c8) = *(const v4u*)(VM + (tok0 + t) * 1024 + h * 256 + c8); }
        __syncthreads();
        if (tid == 0) { const float m = scal[0]; float bsum = 0.f, amax = -INFINITY;
            for (int t = 0; t < 64; ++t) { bsum += lf[t]; bcum[t] = bsum; const float av = ig[t] - bsum; aarr[t] = av; amax = fmaxf(amax, av); const float mm = fmaxf(m, amax); mt[t] = bsum + mm; wint[t] = expf(m - mm); }
            const float mm = fmaxf(m, amax), mnew = bsum + mm;
            for (int s = 0; s < 64; ++s) wk[s] = expf(bsum + aarr[s] - mnew);
            scal[1] = expf(bsum + m - mnew); scal[2] = mnew; }
        __syncthreads();
        for (int i = 0; i < 8; ++i) { const int idx = tid + 512 * i, t = idx >> 6, s = idx & 63; float val = 0.f;
            if (s <= t) { float d = 0.f;
#pragma unroll 2
                for (int k8 = 0; k8 < 16; ++k8) { const v4u qw = *(const LAS v4u*)(qs + t * 128 + k8 * 8), kw = *(const LAS v4u*)(ks + s * 128 + k8 * 8);
                    d += (pg8::bf_lo(qw.x) * pg8::bf_lo(kw.x) + pg8::bf_hi(qw.x) * pg8::bf_hi(kw.x)) + (pg8::bf_lo(qw.y) * pg8::bf_lo(kw.y) + pg8::bf_hi(qw.y) * pg8::bf_hi(kw.y))
                       + (pg8::bf_lo(qw.z) * pg8::bf_lo(kw.z) + pg8::bf_hi(qw.z) * pg8::bf_hi(kw.z)) + (pg8::bf_lo(qw.w) * pg8::bf_lo(kw.w) + pg8::bf_hi(qw.w) * pg8::bf_hi(kw.w)); }
                val = d * expf(bcum[t] + aarr[s] - mt[t]); }
            Sm[idx] = val; }
        __syncthreads();
        if (tid < 64) { float rsum = 0.f; for (int s = 0; s < 64; ++s) rsum += Sm[tid * 64 + s];
            float nq = 0.f; for (int k = 0; k < 128; ++k) nq += nvec[k] * bf2f(qs[tid * 128 + k]);
            den[tid] = fmaxf(fabsf(rsum + wint[tid] * nq), expf(-mt[tid])); }
        __syncthreads();
#pragma unroll 1
        for (int t = 0; t < 64; ++t) {
            float part = 0.f;
#pragma unroll
            for (int k8 = 0; k8 < 8; ++k8) part += bfdot8(*(const LAS v4u*)(qs + t * 128 + half * 64 + k8 * 8), &Creg[k8 * 8]);
            float ip = 0.f;
#pragma unroll 4
            for (int s = half * 32; s < half * 32 + 32; ++s) ip += Sm[t * 64 + s] * bf2f(vs[s * 256 + dv]);
            float tot = ip + wint[t] * part; tot += __shfl_xor(tot, 1);
            const float hv = tot / den[t];
            if (half == 0) hs[t * 256 + dv] = hv;
            const float sq = wave_sum(half == 0 ? hv * hv : 0.f);
            if (lane == 0) hsqw[wave * 64 + t] = sq;
        }
        __syncthreads();
        for (int i = 0; i < 32; ++i) { const int idx = tid + 512 * i, t = idx >> 8, dd = idx & 255; float ssum = 0.f;
#pragma unroll
            for (int w = 0; w < 8; ++w) ssum += hsqw[w * 64 + t];
            const float rn = 1.0f / sqrtf(ssum * (1.f / 256.f) + EPS);
            VM[(tok0 + t) * 1024 + h * 256 + dd] = (bf16)(pk2(hs[idx] * rn * a.in[I_MGAIN][h * 256 + dd], 0.f) & 0xffffu); }
        { const float decay = scal[1];
#pragma unroll
          for (int j = 0; j < 64; ++j) Creg[j] *= decay;
#pragma unroll 1
          for (int s = 0; s < 64; ++s) { const float wv = wk[s] * bf2f(vs[s * 256 + dv]);
#pragma unroll
              for (int k8 = 0; k8 < 8; ++k8) { const v4u kw = *(const LAS v4u*)(ks + s * 128 + half * 64 + k8 * 8);
                  Creg[k8 * 8 + 0] += wv * pg8::bf_lo(kw.x); Creg[k8 * 8 + 1] += wv * pg8::bf_hi(kw.x); Creg[k8 * 8 + 2] += wv * pg8::bf_lo(kw.y); Creg[k8 * 8 + 3] += wv * pg8::bf_hi(kw.y);
                  Creg[k8 * 8 + 4] += wv * pg8::bf_lo(kw.z); Creg[k8 * 8 + 5] += wv * pg8::bf_hi(kw.z); Creg[k8 * 8 + 6] += wv * pg8::bf_lo(kw.w); Creg[k8 * 8 + 7] += wv * pg8::bf_hi(kw.w); } }
          float nn = 0.f;
          if (tid < 128) { nn = decay * nvec[tid]; for (int s = 0; s < 64; ++s) nn += wk[s] * bf2f(ks[s * 128 + tid]); }
          __syncthreads();
          if (tid < 128) nvec[tid] = nn;
          if (tid == 0) scal[0] = scal[2]; }
    }
    __syncthreads();
}
__device__ __forceinline__ void phase_mlstm_naive(const Args& a, LAS unsigned char* lds, int tid, int lane, int wave, int vcu, int G) {
    for (int u = vcu; u < NB * 4; u += G) mlstm_naive_unit(a, lds, tid, lane, wave, u >> 2, u & 3);
}

__device__ __forceinline__ void phase_rs1(const Args& a, int tid, int vcu, int G) {
    const float* ss = (const float*)(a.ws + WS_SS1); float* rs = (float*)(a.ws + WS_RS1);
    for (int r = vcu * 512 + tid; r < T; r += G * 512) { const f32x4* p = (const f32x4*)(ss + (size_t)r * 16); const f32x4 s0 = p[0], s1 = p[1], s2 = p[2], s3 = p[3];
        const float s = ((s0[0] + s0[1]) + (s0[2] + s0[3])) + ((s1[0] + s1[1]) + (s1[2] + s1[3])) + ((s2[0] + s2[1]) + (s2[2] + s2[3])) + ((s3[0] + s3[1]) + (s3[2] + s3[3]));
        rs[r] = 1.0f / sqrtf(s * (1.f / D) + EPS); }
}
__device__ __forceinline__ void phase_pnorm(const Args& a, int lane, int wave, int vcu, int G, bool dry = false) {
    bf16* P = (bf16*)(a.ws + WS_B3); const float* ps = (const float*)(a.ws + WS_PSUM);
    for (int r = vcu * NWAVES + wave; r < T; r += G * NWAVES) { const int hh = lane >> 4; const f32x4 s = *(const f32x4*)(ps + (size_t)r * 16 + hh * 4);
        const float inv = 1.0f / ((s[0] + s[1]) + (s[2] + s[3]));
        v4u* p = (v4u*)(P + (size_t)r * 1024 + lane * 16);
#pragma unroll
        for (int i = 0; i < 2; ++i) { const v4u w = p[i]; v4u o; o.x = pk2(pg8::bf_lo(w.x) * inv, pg8::bf_hi(w.x) * inv); o.y = pk2(pg8::bf_lo(w.y) * inv, pg8::bf_hi(w.y) * inv);
            o.z = pk2(pg8::bf_lo(w.z) * inv, pg8::bf_hi(w.z) * inv); o.w = pk2(pg8::bf_lo(w.w) * inv, pg8::bf_hi(w.w) * inv); if (!dry) p[i] = o; } }
}
__device__ __forceinline__ void phase_final_plain(const Args& a, const float* src, int lane, int wave, int vcu, int G) {
    for (int m = vcu * NWAVES + wave; m < T; m += G * NWAVES) {
        const f32x4* xr = (const f32x4*)(src + (size_t)m * D) + lane; const f32x4* gr = (const f32x4*)a.in[I_NORM_FINAL] + lane; f32x4* orow = (f32x4*)(a.out + (size_t)m * D) + lane;
        f32x4 v[4]; float s = 0.f;
#pragma unroll
        for (int j = 0; j < 4; ++j) { v[j] = xr[64 * j]; s += (v[j][0] * v[j][0] + v[j][1] * v[j][1]) + (v[j][2] * v[j][2] + v[j][3] * v[j][3]); }
        const float rs = 1.0f / sqrtf(wave_sum(s) * (1.f / D) + EPS);
#pragma unroll
        for (int j = 0; j < 4; ++j) orow[64 * j] = v[j] * rs * gr[64 * j];
    }
}
typedef short rt_bf16x8 __attribute__((ext_vector_type(8)));
typedef float rt_f32x16 __attribute__((ext_vector_type(16)));
__device__ __forceinline__ void phase_router(const Args& a, LAS unsigned char* lds, int tid, int lane, int wave) {
    LAS int* hist = (LAS int*)(lds + 135168);
    const float* wgt = (const float*)(a.ws + WS_WGT);
    for (int idx = tid; idx < 32 * 128; idx += 512) { const int e = idx >> 7, ch = idx & 127; const f32x4 w0 = *(const f32x4*)(wgt + e * 1024 + ch * 8), w1 = *(const f32x4*)(wgt + e * 1024 + ch * 8 + 4);
        unsigned hiw[4], low[4];
#pragma unroll
        for (int j = 0; j < 4; ++j) { const float x0 = j < 2 ? w0[2 * j] : w1[2 * j - 4], x1 = j < 2 ? w0[2 * j + 1] : w1[2 * j - 3]; const unsigned h = pk2(x0, x1); hiw[j] = h; low[j] = pk2(x0 - pg8::bf_lo(h), x1 - pg8::bf_hi(h)); }
        const unsigned off = (unsigned)e * 2048u + (unsigned)((ch ^ e) & 127) * 16u;
        *(LAS v4u*)(lds + off) = (v4u){hiw[0], hiw[1], hiw[2], hiw[3]}; *(LAS v4u*)(lds + 65536 + off) = (v4u){low[0], low[1], low[2], low[3]}; }
    if (tid < 32) hist[tid] = 0;
    __syncthreads();
    const int blk = blockIdx.x, r32 = lane & 31, hi = lane >> 5;
    const int tk = blk * 256 + wave * 32 + r32;
    const bf16* xrow = (const bf16*)(a.ws + WS_B0) + (size_t)tk * D + 8 * hi;
    rt_f32x16 acc;
#pragma unroll
    for (int i = 0; i < 16; ++i) acc[i] = 0.f;
    float sq = 0.f;
    for (int kb = 0; kb < 8; ++kb) {
        v4u xv[8];
#pragma unroll
        for (int s8 = 0; s8 < 8; ++s8) xv[s8] = *(const v4u*)(xrow + kb * 128 + s8 * 16);
#pragma unroll
        for (int s8 = 0; s8 < 8; ++s8) { const int ks = kb * 8 + s8;
#pragma unroll
            for (int j = 0; j < 4; ++j) { const float x0 = pg8::bf_lo(xv[s8][j]), x1 = pg8::bf_hi(xv[s8][j]); sq += x0 * x0 + x1 * x1; }
            const unsigned boff = (unsigned)r32 * 2048u + (unsigned)(((2 * ks + hi) ^ r32) & 127) * 16u;
            const rt_bf16x8 bh = *(const LAS rt_bf16x8*)(lds + boff), bl = *(const LAS rt_bf16x8*)(lds + 65536 + boff);
            const rt_bf16x8 fa = __builtin_bit_cast(rt_bf16x8, xv[s8]);
            acc = __builtin_amdgcn_mfma_f32_32x32x16_bf16(fa, bh, acc, 0, 0, 0); acc = __builtin_amdgcn_mfma_f32_32x32x16_bf16(fa, bl, acc, 0, 0, 0); }
    }
    { auto rr = __builtin_amdgcn_permlane32_swap(__float_as_uint(sq), __float_as_uint(sq), false, false); sq = __uint_as_float(rr[0]) + __uint_as_float(rr[1]); }
    const float rs = 1.0f / sqrtf(sq * (1.f / D) + EPS);
    __syncthreads();
    LAS float* lg_t = (LAS float*)(lds + wave * 4608);
    if (hi == 0) lg_t[1056 + r32] = rs;
    LDS_WAIT(); asm volatile("" ::: "memory");
    { const float br = a.in[I_B_R][r32];
#pragma unroll
      for (int i = 0; i < 16; ++i) { const int t = (i & 3) + 8 * (i >> 2) + 4 * hi; lg_t[t * 33 + r32] = acc[i] * lg_t[1056 + t] + br; } }
    LDS_WAIT(); asm volatile("" ::: "memory");
    if (lane < 32) { float lg[32];
#pragma unroll
        for (int e = 0; e < 32; ++e) lg[e] = lg_t[lane * 33 + e];
        int bi[4]; float bv[4];
#pragma unroll
        for (int k = 0; k < 4; ++k) { float best = -INFINITY; int be = 0;
#pragma unroll
            for (int e = 0; e < 32; ++e) if (lg[e] > best) { best = lg[e]; be = e; }
#pragma unroll
            for (int e = 0; e < 32; ++e) lg[e] = (e == be) ? -INFINITY : lg[e];
            bi[k] = be; bv[k] = best; }
        const float e1 = expf(bv[1] - bv[0]), e2 = expf(bv[2] - bv[0]), e3 = expf(bv[3] - bv[0]); const float inv = 1.0f / (1.0f + e1 + e2 + e3);
        ((float*)(a.ws + WS_RS2))[tk] = rs;
        *(v4u*)((int*)(a.ws + WS_TOPI) + (size_t)tk * 4) = (v4u){(unsigned)bi[0], (unsigned)bi[1], (unsigned)bi[2], (unsigned)bi[3]};
        *(f32x4*)((float*)(a.ws + WS_TOPW) + (size_t)tk * 4) = (f32x4){inv, e1 * inv, e2 * inv, e3 * inv};
#pragma unroll
        for (int k = 0; k < 4; ++k) __hip_atomic_fetch_add(&hist[bi[k]], 1, __ATOMIC_RELAXED, __HIP_MEMORY_SCOPE_WORKGROUP); }
    __syncthreads();
    if (tid < 32) ((int*)(a.ws + WS_MISC))[blk * 32 + tid] = hist[tid];
}
__device__ __forceinline__ void phase_slot(const Args& a, LAS unsigned char* lds, int tid) {
    LAS int* tot = (LAS int*)lds, *bef = tot + 32, *st = tot + 64, *ids = tot + 128;
    const int blk = blockIdx.x, half = blk >> 7; const int* hist = (const int*)(a.ws + WS_MISC);
    int* tile_e = (int*)(a.ws + WS_MISC) + 8192 + half * HTILES; int* ntiles = (int*)(a.ws + WS_MISC) + 8192 + 2 * HTILES;
    int* toklist = (int*)(a.ws + WS_TOKL) + (size_t)half * HSLOTS; int* slot_of = (int*)(a.ws + WS_SLOT); const int* topi = (const int*)(a.ws + WS_TOPI);
    LAS int* hl = tot + 2048;
    for (int i = tid; i < 4096; i += 512) hl[i] = hist[half * 4096 + i];
    for (int i = tid; i < 1024; i += 512) ids[i] = topi[(size_t)blk * 1024 + i];
    LAS float* rsl = (LAS float*)(tot + 8192);
    float* rs_slot = (float*)(a.ws + WS_RSS) + (size_t)half * HSLOTS;
    if (tid < 256) rsl[tid] = ((const float*)(a.ws + WS_RS2))[blk * 256 + tid];
    __syncthreads();
    if (tid < 32) { int t = 0, bf = 0; for (int bb = 0; bb < 128; ++bb) { const int hv = hl[bb * 32 + tid]; t += hv; if (half * 128 + bb < blk) bf += hv; } tot[tid] = t; bef[tid] = bf; }
    __syncthreads();
    if (tid == 0) { int s = 0; for (int e = 0; e < 32; ++e) { st[e] = s; s += ((tot[e] + 255) >> 8) << 8; } st[32] = s; }
    __syncthreads();
    LAS int* ccnt = tot + 1152;
    const int lane_ = tid & 63; int ee[2], rk[2];
#pragma unroll
    for (int ps = 0; ps < 2; ++ps) { const int i = tid + 512 * ps; const int e = ids[i]; int r = 0;
        for (int x = 0; x < 32; ++x) { const unsigned long long mk = __ballot(e == x); if (e == x) r = __builtin_popcountll(mk & ((1ull << lane_) - 1ull)); if (lane_ == 0) ccnt[(i >> 6) * 32 + x] = __builtin_popcountll(mk); }
        ee[ps] = e; rk[ps] = r; }
    __syncthreads();
    if (tid < 32) { int run = st[tid] + bef[tid]; for (int c = 0; c < 16; ++c) { const int t = ccnt[c * 32 + tid]; ccnt[c * 32 + tid] = run; run += t; } }
    __syncthreads();
#pragma unroll
    for (int ps = 0; ps < 2; ++ps) { const int i = tid + 512 * ps; const int cnt = ccnt[(i >> 6) * 32 + ee[ps]] + rk[ps]; const int tk = blk * 256 + (i >> 2);
        slot_of[(size_t)tk * 4 + (i & 3)] = cnt; toklist[cnt] = tk; rs_slot[cnt] = rsl[i >> 2]; }
    if (tid < 32) {
        if ((blk & 127) == 0) { for (int s = st[tid] + tot[tid]; s < st[tid + 1]; ++s) { toklist[s] = half * (T / 2); rs_slot[s] = 1.0f; }
            for (int tl = st[tid] >> 8; tl < (st[tid + 1] >> 8); ++tl) tile_e[tl] = tid;
            if (tid == 0) ntiles[half] = st[32] >> 8; } }
}
__device__ __forceinline__ void phase_combine(const Args& a, int lane, int wave, int vcu, int G, bool dry = false) {
    const unsigned char* Yall = (const unsigned char*)(a.ws + WS_Y); const int* slot_of = (const int*)(a.ws + WS_SLOT); const float* tw = (const float*)(a.ws + WS_TOPW);
    f32x4 gr[4];
#pragma unroll
    for (int j = 0; j < 4; ++j) gr[j] = *((const f32x4*)a.in[I_NORM_FINAL] + lane * 4 + j);
    for (int m = vcu * NWAVES + wave; m < T; m += G * NWAVES) { const unsigned char* Y = Yall + (m >= T / 2 ? (size_t)HSLOTS * 1024 : (size_t)0);
        const v4u* xb = (const v4u*)((const bf16*)(a.ws + WS_B0) + (size_t)m * D) + lane * 2; const v4u w0 = xb[0], w1 = xb[1];
        v4u yk[4]; float ck[4];
#pragma unroll
        for (int k = 0; k < 4; ++k) { const int sl = slot_of[(size_t)m * 4 + k]; ck[k] = tw[(size_t)m * 4 + k]; yk[k] = *((const v4u*)(Y + (size_t)sl * 1024) + lane); }
        f32x4 v[4];
        v[0] = (f32x4){pg8::bf_lo(w0.x), pg8::bf_hi(w0.x), pg8::bf_lo(w0.y), pg8::bf_hi(w0.y)}; v[1] = (f32x4){pg8::bf_lo(w0.z), pg8::bf_hi(w0.z), pg8::bf_lo(w0.w), pg8::bf_hi(w0.w)};
        v[2] = (f32x4){pg8::bf_lo(w1.x), pg8::bf_hi(w1.x), pg8::bf_lo(w1.y), pg8::bf_hi(w1.y)}; v[3] = (f32x4){pg8::bf_lo(w1.z), pg8::bf_hi(w1.z), pg8::bf_lo(w1.w), pg8::bf_hi(w1.w)};
#pragma unroll
        for (int k = 0; k < 4; ++k) { const float c = ck[k];
#pragma unroll
            for (int j = 0; j < 4; ++j) { const unsigned w = yk[k][j]; typedef float f2_ __attribute__((ext_vector_type(2)));
                const f2_ lo = __builtin_amdgcn_cvt_pk_f32_fp8((int)w, false), hh = __builtin_amdgcn_cvt_pk_f32_fp8((int)w, true);
                v[j][0] += c * lo[0]; v[j][1] += c * lo[1]; v[j][2] += c * hh[0]; v[j][3] += c * hh[1]; } }
        float s = 0.f;
#pragma unroll
        for (int j = 0; j < 4; ++j) s += (v[j][0] * v[j][0] + v[j][1] * v[j][1]) + (v[j][2] * v[j][2] + v[j][3] * v[j][3]);
        const float rs = 1.0f / sqrtf(wave_sum(s) * (1.f / D) + EPS);
        f32x4* xr = (f32x4*)(a.out + (size_t)m * D) + lane * 4;
#pragma unroll
        for (int j = 0; j < 4; ++j) if (!dry) xr[j] = v[j] * rs * gr[j];
    }
}
#ifndef DBG_STAGE
#define DBG_STAGE 0
#endif
#ifndef Z1_F8_GROUPS
#define Z1_F8_GROUPS 0
#endif
#ifndef Z3_F8_GROUPS
#define Z3_F8_GROUPS 7
#endif
constexpr unsigned zmap(unsigned mask, int base) { unsigned m = 0; int k = 0; for (int g = 0; g < 8; ++g) if ((mask >> g) & 1u) { m |= (unsigned)(base + g) << (4 * k); ++k; } return m; }
constexpr int zcount(unsigned mask) { int k = 0; for (int g = 0; g < 8; ++g) k += (mask >> g) & 1u; return k; }
enum { PH_P0 = 0, PH_Z1, PH_ATT, PH_Z3, PH_BRF, PH_OUT, PH_S, PH_PV, PH_ROUTER, PH_SLOT, PH_G1, PH_G2, PH_CB, N_PHASES };

__global__ void __launch_bounds__(NWAVES * 64, 2) fwd_kernel(Args args) {
    extern __shared__ __attribute__((aligned(16))) unsigned char lds_raw[];
    LAS unsigned char* lds = (LAS unsigned char*)lds_raw;
    volatile LAS unsigned* MISC = (volatile LAS unsigned*)(lds + MISC_OFF);
#define LAUNDER_TID() int tid = threadIdx.x; asm volatile("" : "+v"(tid)); const int lane = tid & 63, wave = __builtin_amdgcn_readfirstlane(tid >> 6)
    const int tid0 = threadIdx.x;
    const int G = gridDim.x; const int bx = blockIdx.x; const int vcu = (G % 8 == 0) ? (bx % 8) * (G / 8) + bx / 8 : bx;
    unsigned char* ws = args.ws;
    if (tid0 < 128) MISC[tid0] = 0u;
    __syncthreads();
    const int lo = args.ph_lo, hi = args.ph_hi;
    XcdBarrier bar; bar.bar = (unsigned*)(ws + WS_CTL) + CW_BAR; bar.x = 0; bar.st = nullptr;
    if (hi - lo > 1) bar = xcd_barrier_post((unsigned*)(ws + WS_CTL) + CW_BAR, MISC + 8);
#ifndef ONLY_PHASE
#define ONLY_PHASE -1
#endif
#ifndef SKIP_MASK
#define SKIP_MASK 0u
#endif
#define IN(k) ((ONLY_PHASE < 0 || ONLY_PHASE == (k)) && !((SKIP_MASK >> (k)) & 1u) && lo <= (k) && (k) < hi)
#ifndef REP_MASK
#define REP_MASK 0u
#endif
#define REPS(k) (((REP_MASK >> (k)) & 1u) ? 2 : 1)
#define REP(k) for (int rep_ = 0; rep_ < REPS(k); ++rep_)
#define DRY(k) (rep_ + 1 < REPS(k))
#ifndef BR1_SHIFT
#define BR1_SHIFT 0
#endif
#ifndef ATT_NS
#define ATT_NS att6
#endif
#ifndef ATT_THRL
#define ATT_THRL 8
#endif
#ifndef Z3_DRY_BROW
#define Z3_DRY_BROW 5120
#endif
#ifndef Z3DRYEXPR
#define Z3DRYEXPR DRY(PH_Z3)
#endif
#define SEAM(k) do { if (IN(k) && IN((k) + 1)) xcd_barrier(bar); } while (0)
    using namespace pg8;
    const bf16_t* B0 = (const bf16_t*)(ws + WS_B0);

    if (IN(PH_P0)) REP(PH_P0) { LAUNDER_TID(); (void)lane; (void)wave; phase_p0(args, lds, tid, lane, wave, vcu, G); } SEAM(PH_P0);
#if DBG_STAGE == 1
    if (IN(PH_Z1)) { LAUNDER_TID(); (void)lane; (void)wave; phase_final_plain(args, args.in[I_X], lane, wave, vcu, G); }
#else
    if (IN(PH_Z1)) REP(PH_Z1) {
        constexpr unsigned MA = zmap(~(unsigned)(Z1_F8_GROUPS) & 31u, 0), MB = zmap((unsigned)(Z1_F8_GROUPS) & 31u, 0); constexpr int NA = zcount(~(unsigned)(Z1_F8_GROUPS) & 31u), NB8 = zcount((unsigned)(Z1_F8_GROUPS) & 31u);
        if constexpr (NA > 0) { OpsZ O{(const char*)B0, (const char*)(ws + WS_WIN), 2048u, 2048u, MA}; StaticOrder S; S.init_tiles(T / 256, 4 * NA, G, bx);
            EpiZ1 E{(bf16_t*)(ws + WS_B1), BUF / 2, (const float*)(ws + WS_RS0), QD_SCALE, 2, MA};
            gemm_phase<EpiZ1, StaticOrder, OpsZ, true>(lds + RING_OFF, O, 1024, S, E); }
        if constexpr (NB8 > 0) { OpsZF8 O{(const char*)(ws + WS_XQ), (const char*)(ws + WS_WIN8), 1024u, 1024u, MB, SC_ONE, SC_W}; StaticOrder S; S.init_tiles(T / 256, 4 * NB8, G, bx);
            EpiZ1 E{(bf16_t*)(ws + WS_B1), BUF / 2, (const float*)(ws + WS_RS0), QD_SCALE, 2, MB};
            gemm_phase<EpiZ1, StaticOrder, OpsZF8, true>(lds + RING_OFF, O, 512, S, E); }
    } SEAM(PH_Z1);
    if (IN(PH_ATT)) REP(PH_ATT) {
#ifdef PROBE_SKIP_MLSTM_DRY
        if (!DRY(PH_ATT))
#endif
#ifdef PROBE_MLSTM_TWICE
        if (bx < NB * 4) mls::mlstm_unit((const unsigned short*)(ws + WS_B1), (unsigned short*)(ws + WS_B2), (const float*)(ws + WS_IF), args.in[I_CONV_W], args.in[I_MGAIN], lds, bx >> 2, bx & 3, true);
        __syncthreads();
#endif
        if (bx < NB * 4) mls::mlstm_unit((const unsigned short*)(ws + WS_B1), (unsigned short*)(ws + WS_B2), (const float*)(ws + WS_IF), args.in[I_CONV_W], args.in[I_MGAIN], lds, bx >> 2, bx & 3, DRY(PH_ATT));
        __syncthreads();
        const float lam = diff_lambda(args);
#ifdef PROBE_SKIP_ATT_DRY
        if (!DRY(PH_ATT))
#endif
        ATT_NS::phase<ATT_THRL>((char*)lds_raw, (const unsigned short*)(ws + WS_B3), (const unsigned short*)(ws + WS_B4), (const unsigned short*)(ws + WS_B5), (unsigned short*)(ws + WS_B3), (unsigned*)(ws + WS_CTL) + CW_Q + 512 * rep_, MISC + 16, lam, args.in[I_DGAIN], ws + WS_SS1  , DRY(PH_ATT),
            [&](int k) {
#ifdef EXPERT_CONV_IN_ATT
                if (k < EXPERT_SLICES && !DRY(PH_ATT)) { LAUNDER_TID(); (void)tid; p0_expert_items(args, lds, lane, wave, bx * EXPERT_SLICES + k, G * EXPERT_SLICES); __syncthreads(); }
#else
                (void)k;
#endif
            }); } SEAM(PH_ATT);
#ifdef DELAY_BEFORE_Z3
    if (IN(PH_Z3)) { const unsigned long long t0 = __builtin_amdgcn_s_memrealtime(); while (__builtin_amdgcn_s_memrealtime() - t0 < (unsigned long long)(DELAY_BEFORE_Z3)) __builtin_amdgcn_s_sleep(8); }
#endif
    if (IN(PH_Z3)) REP(PH_Z3) {
        constexpr unsigned MA = zmap(~(unsigned)(Z3_F8_GROUPS) & 7u, 5), MB = zmap((unsigned)(Z3_F8_GROUPS) & 7u, 5); constexpr int NA = zcount(~(unsigned)(Z3_F8_GROUPS) & 7u), NB8 = zcount((unsigned)(Z3_F8_GROUPS) & 7u);
        if constexpr (NA > 0) { OpsZ O{(const char*)B0, (const char*)(ws + WS_WIN), 2048u, 2048u, MA}; StaticOrder S; S.init_tiles(T / 256, 4 * NA, G, bx);
            EpiZ3 E{(const bf16_t*)(ws + WS_B2), (bf16_t*)(ws + WS_B2), (bf16_t*)(ws + WS_B1), (bf16_t*)(ws + WS_B4), (const float*)(ws + WS_RS0), args.in[I_B_GATE], Z3DRYEXPR, MA, lds + RING_OFF + RING_BYTES + 4096};
            gemm_phase<EpiZ3, StaticOrder, OpsZ, true>(lds + RING_OFF, O, 1024, S, E); }
        if constexpr (NB8 > 0) { OpsZF8 O{(const char*)(ws + WS_XQ), (const char*)(ws + WS_WIN8), 1024u, 1024u, MB, SC_ONE, SC_W}; StaticOrder S; S.init_tiles(T / 256, 4 * NB8, G, bx);
            EpiZ3 E{(const bf16_t*)(ws + WS_B2), (bf16_t*)(ws + WS_B2), (bf16_t*)(ws + WS_B1), (bf16_t*)(ws + WS_B4), (const float*)(ws + WS_RS0), args.in[I_B_GATE], Z3DRYEXPR, MB, lds + RING_OFF + RING_BYTES + 4096};
            gemm_phase<EpiZ3, StaticOrder, OpsZF8, true>(lds + RING_OFF, O, 512, S, E); }
        { OpsPlain O2{(const char*)(ws + WS_MEMN), (const char*)(ws + WS_WKV), 2048u, 2048u}; StaticOrder S2; S2.init_tiles(NB * NMEM / 256, 8, G, (bx + 128) % G);
          EpiPlain E2{(bf16_t*)(ws + WS_KV), 2048, 1.0f};
          gemm_phase<EpiPlain, StaticOrder, OpsPlain, true>(lds + RING_OFF, O2, 1024, S2, E2); }
    } SEAM(PH_Z3);
    if (IN(PH_BRF)) REP(PH_BRF) {
        { OpsDual O{(const char*)(ws + WS_B2), (const char*)(ws + WS_WBM), (const char*)(ws + WS_B3), (const char*)(ws + WS_WBD), 2048u, 2048u, 16}; StaticOrder S; S.init_tiles(T / 256, 4, G, bx);
          EpiBRF E{(const bf16_t*)(ws + WS_B1), (const bf16_t*)(ws + WS_B4), (bf16_t*)(ws + WS_B0)};
          gemm_phase<EpiBRF, StaticOrder, OpsDual, true>(lds + RING_OFF, O, 2048, S, E); }
        { OpsWp O{(const char*)(ws + WS_KV), (const char*)(ws + WS_WQG), 4096u, 2048u}; StaticOrder S; S.init_tiles(NB * 4, 4, G, bx);
          EpiPlainF8 E{(unsigned char*)(ws + WS_WPT), 1024, XS_SCALE * 128.0f};
          gemm_phase<EpiPlainF8, StaticOrder, OpsWp, true>(lds + RING_OFF, O, 256, S, E); }
        { OpsVp O{(const char*)(ws + WS_WO), (const char*)(ws + WS_KV), 2048u, 4096u}; StaticOrder S; S.init_tiles(NB * 4, 4, G, bx);
          EpiPlainF8 E{(unsigned char*)(ws + WS_VPT), 1024, 32.0f};
          gemm_phase<EpiPlainF8, StaticOrder, OpsVp, true>(lds + RING_OFF, O, 256, S, E); }
    } SEAM(PH_BRF);
    if (IN(PH_OUT)) REP(PH_OUT) {
        OpsPlain O{(const char*)B0, (const char*)(ws + WS_WOUT), 2048u, 2048u}; StaticOrder S; S.init_tiles(T / 256, 4, G, bx);
        EpiResB<false> E{(const void*)args.in[I_X], (bf16_t*)(ws + WS_B1), (float*)(ws + WS_SS1), (unsigned char*)(ws + WS_X1Q)};
        gemm_phase<EpiResB<false>, StaticOrder, OpsPlain, true>(lds + RING_OFF, O, 1024, S, E);
    } SEAM(PH_OUT);
#if DBG_STAGE == 2
    if (IN(PH_S)) { LAUNDER_TID(); (void)lane; (void)wave; phase_final_plain(args, args.out, lane, wave, vcu, G); }
#else
    if (IN(PH_S)) REP(PH_S) {
        OpsBatchBF8 O{(const char*)(ws + WS_X1Q), (const char*)(ws + WS_WPT), 1024u, 1024u, (size_t)1024 * 1024, SC_ONE, SC_W}; StaticOrder S; S.init_tiles(T / 256, 4, G, bx);
        EpiS E{(unsigned char*)(ws + WS_B3), (const float*)(ws + WS_SS1), (PG8_LAS float*)(lds + RING_BYTES)};
        gemm_phase<EpiS, StaticOrder, OpsBatchBF8, true>(lds + RING_OFF, O, 512, S, E);
    } SEAM(PH_S);
    if (IN(PH_PV)) REP(PH_PV) {
        OpsBatchBF8 O{(const char*)(ws + WS_B3), (const char*)(ws + WS_VPT), 1024u, 1024u, (size_t)1024 * 1024, SC_P, SC_V}; StaticOrder S; S.init_tiles(T / 256, 4, G, bx);
        EpiResB<true> E{(const void*)(ws + WS_B1), (bf16_t*)(ws + WS_B0), nullptr, (unsigned char*)(ws + WS_X2Q)};
        gemm_phase<EpiResB<true>, StaticOrder, OpsBatchBF8, true>(lds + RING_OFF, O, 512, S, E);
    } SEAM(PH_PV);
#if DBG_STAGE == 3
    if (IN(PH_ROUTER)) { LAUNDER_TID(); (void)lane; (void)wave; phase_final_plain(args, args.out, lane, wave, vcu, G); }
#else
    if (IN(PH_ROUTER)) REP(PH_ROUTER) { LAUNDER_TID(); (void)lane; (void)wave; phase_router(args, lds, tid, lane, wave); } SEAM(PH_ROUTER);
    if (IN(PH_SLOT)) REP(PH_SLOT) { LAUNDER_TID(); (void)lane; (void)wave; phase_slot(args, lds, tid); } SEAM(PH_SLOT);
    if (IN(PH_G1)) REP(PH_G1) { const int nT0 = ((const int*)(ws + WS_MISC))[8192 + 2 * HTILES], nT1 = ((const int*)(ws + WS_MISC))[8192 + 2 * HTILES + 1]; const int* tl = (const int*)(ws + WS_TOKL); const int* te = (const int*)(ws + WS_MISC) + 8192;
        OpsG1 O{(const char*)(ws + WS_X2Q), (const char*)(ws + WS_WGU), tl, te, 1024u, 1024u, SC_ONE, SC_W, nT0}; StaticOrder S; S.init_tiles(nT0 + nT1, 8, G, bx);
        EpiG1 E{(unsigned char*)(ws + WS_H), (const float*)(ws + WS_RSS), tl, te, args.in[I_B_GU], DRY(PH_G1), nT0, lds + RING_OFF + RING_BYTES + 4096};
        gemm_phase<EpiG1, StaticOrder, OpsG1, true>(lds + RING_OFF, O, 512, S, E); } SEAM(PH_G1);
    if (IN(PH_G2)) REP(PH_G2) { const int nT0 = ((const int*)(ws + WS_MISC))[8192 + 2 * HTILES], nT1 = ((const int*)(ws + WS_MISC))[8192 + 2 * HTILES + 1]; const int* te = (const int*)(ws + WS_MISC) + 8192;
        OpsG2 O{(const char*)(ws + WS_H), (const char*)(ws + WS_WDN), te, 1024u, 1024u, SC_ONE, SC_W, nT0}; StaticOrder S; S.init_tiles(nT0 + nT1, 4, G, bx);
        EpiG2 E{(unsigned char*)(ws + WS_Y), te, args.in[I_B_DN], DRY(PH_G2), nT0, lds + RING_OFF + RING_BYTES + 4096};
        gemm_phase<EpiG2, StaticOrder, OpsG2, true>(lds + RING_OFF, O, 512, S, E); } SEAM(PH_G2);
    if (IN(PH_CB)) REP(PH_CB) { LAUNDER_TID(); (void)tid; phase_combine(args, lane, wave, vcu, G, DRY(PH_CB)); }
#endif
#endif
#endif
#undef IN
#undef SEAM
}

#ifndef MK_ONE_LAUNCH
#define MK_ONE_LAUNCH 0
#endif
extern "C" void kernel_launch(void* const* d_in, const int* in_sizes, int n_in, void* d_out, int out_size, void* d_ws, size_t ws_size, hipStream_t stream) {
    static int grid = 0;
    if (grid == 0) {
        if (n_in != N_INPUTS || out_size != T * D || ws_size < WS_END) { fprintf(stderr, "kernel_launch: unexpected shapes (n_in %d, out %d, ws %zu)\n", n_in, out_size, ws_size); grid = -1; return; }
        int dev = 0, cus = 0, per_cu = 0;
        if (hipGetDevice(&dev) != hipSuccess || hipDeviceGetAttribute(&cus, hipDeviceAttributeMultiprocessorCount, dev) != hipSuccess) { grid = -1; return; }
        if (hipFuncSetAttribute((const void*)fwd_kernel, hipFuncAttributeMaxDynamicSharedMemorySize, LDS_BYTES) != hipSuccess) { fprintf(stderr, "kernel_launch: hipFuncSetAttribute failed\n"); grid = -1; return; }
        if (hipOccupancyMaxActiveBlocksPerMultiprocessor(&per_cu, (const void*)fwd_kernel, NWAVES * 64, LDS_BYTES) != hipSuccess || per_cu < 1) fprintf(stderr, "kernel_launch: occupancy query reports %d\n", per_cu);
        (void)hipGetLastError();
        grid = cus;
    }
    if (grid < 0) return;
    (void)hipMemsetAsync((char*)d_ws + WS_CTL, 0, CTL_ZERO_BYTES, stream);
    Args a{};
    for (int i = 0; i < N_INPUTS; ++i) a.in[i] = (const float*)d_in[i];
    a.out = (float*)d_out; a.ws = (unsigned char*)d_ws;
#if MK_ONE_LAUNCH
    a.ph_lo = 0; a.ph_hi = N_PHASES;
    hipLaunchKernelGGL(fwd_kernel, dim3(grid), dim3(NWAVES * 64), LDS_BYTES, stream, a);
#else
    for (int p = 0; p < N_PHASES; ++p) { a.ph_lo = p; a.ph_hi = p + 1; hipLaunchKernelGGL(fwd_kernel, dim3(grid), dim3(NWAVES * 64), LDS_BYTES, stream, a); }
#endif
}
```

```cpp
#define MK_ONE_LAUNCH 1
#define A6_PROD_PRIO 1
#define Z1_F8_GROUPS 19
#define BRF8_MG 4
#include <hip/hip_runtime.h>
#include <cstdio>
#include <cstdint>
#include <cmath>
#include <hip/hip_bf16.h>
namespace pg8 {
#define PG8_LAS __attribute__((address_space(3)))
typedef unsigned short bf16_t;
typedef short bf16x8 __attribute__((ext_vector_type(8)));
typedef float f32x4 __attribute__((ext_vector_type(4)));
typedef float f32x2 __attribute__((ext_vector_type(2)));
typedef unsigned u32x4 __attribute__((ext_vector_type(4)));
typedef unsigned u32x2 __attribute__((ext_vector_type(2)));
typedef int i32x8 __attribute__((ext_vector_type(8)));
typedef int i32x4 __attribute__((ext_vector_type(4)));
constexpr int BM = 256, BK = 64, HALF = 128, HTB = HALF * BK * 2  , STAGE_BYTES = 8 * HTB, NXCD = 8, WGM = 8;

__host__ __device__ __forceinline__ int lds_byte(int r, int c) { const int st = (r >> 4) * 2 + (c >> 5), rr = r & 15, cc = c & 31, ob = rr * 64 + cc * 2; return st * 1024 + (ob ^ (((ob >> 9) & 1) << 5)); }
__host__ __device__ __forceinline__ void stage_rc(int b, int& R, int& C) { const int st = b / 1024, sb = b % 1024, swz = sb ^ (((sb >> 9) & 1) << 5); R = (st >> 1) * 16 + swz / 64; C = (st & 1) * 32 + (swz % 64) / 2; }
__host__ __device__ __forceinline__ int perm32(int rho) { const int n = rho >> 4, i = rho & 15; return 8 * (i >> 2) + 4 * n + (i & 3); }

struct Unit { int pm, pn; int par; };

struct StaticOrder {
    int nM, nN, nwg, G, c;
    __device__ __forceinline__ void init_tiles(int nM_, int nN_, int G_, int c_) { nM = nM_; nN = nN_; nwg = nM * nN; G = G_; c = c_; }
    __device__ __forceinline__ bool next(int i, Unit& u) const {
        const long L = (long)i * G + c; if (L >= nwg) return false;
        int wgid = (int)L; { const int q = nwg / NXCD, r = nwg % NXCD, xcd = wgid % NXCD, off = wgid / NXCD; wgid = (xcd < r ? xcd * (q + 1) : r * (q + 1) + (xcd - r) * q) + off; }
        const int nig = WGM * nN, gid = wgid / nig, fm = gid * WGM, gsz = (nM - fm) < WGM ? (nM - fm) : WGM;
        u.pm = fm + ((wgid % nig) % gsz); u.pn = (wgid % nig) / gsz; return true;
    }
    __device__ __forceinline__ void a_ready(const Unit&) const {}
    __device__ __forceinline__ void done(const Unit&) const {}
};

typedef float f32x2_c __attribute__((ext_vector_type(2))); typedef __bf16 bf16x2_c __attribute__((ext_vector_type(2)));
__device__ __forceinline__ unsigned cvt_pk_bf16(float lo, float hi) { f32x2_c v = {lo, hi}; bf16x2_c b = __builtin_convertvector(v, bf16x2_c); return __builtin_bit_cast(unsigned, b); }
__device__ __forceinline__ float bf_lo(unsigned w) { return __uint_as_float(w << 16); }
__device__ __forceinline__ float bf_hi(unsigned w) { return __uint_as_float(w & 0xffff0000u); }
__device__ __forceinline__ float sigmoidf_(float v) { return __builtin_amdgcn_rcpf(1.0f + __builtin_amdgcn_exp2f(-1.4426950408889634f * v)); }


template <class Epi, class Sched, class Ops, bool ALIGN_EPI>
__device__ __forceinline__ void gemm_phase(PG8_LAS unsigned char* lds, const Ops& O, const int K, const Sched& S, const Epi& E) {
    int tid_ = threadIdx.x; asm volatile("" : "+v"(tid_));
    const int tid = tid_, wid = __builtin_amdgcn_readfirstlane(tid >> 6), lane = tid & 63, wr = wid >> 2, wc = wid & 3, fr = lane & 15, fq = lane >> 4;
    int nt_ = K / BK; asm volatile("" : "+s"(nt_)); const int nt = nt_;
    const unsigned lda2 = O.lda2, ldb2 = O.ldb2;
    unsigned voffA[2], voffB[2]; int RA[2], CA2[2];
#pragma unroll
    for (int i = 0; i < 2; ++i) { int R, C; stage_rc(tid * 16 + i * 8192, R, C); const int Rb = Epi::PERM ? ((R & ~31) + perm32(R & 31)) : R;
        RA[i] = R; CA2[i] = C * 2; voffA[i] = (unsigned)R * lda2 + (unsigned)C * 2u; voffB[i] = (unsigned)Rb * ldb2 + (unsigned)C * 2u;
        if constexpr (Epi::P64) { const unsigned cw = 64u * (unsigned)(R >> 5) + 16u * (unsigned)((R >> 2) & 3) + 4u * (unsigned)((R >> 4) & 1) + (unsigned)(R & 3);
            voffB[i] = cw * ldb2 + (unsigned)C * 2u; } }
    const size_t kstep = (size_t)(BK * 2);
    const size_t hstepA = Ops::GATHER ? 0 : (size_t)HALF * lda2, hstepB = (size_t)HALF * ldb2; (void)hstepB;
    const unsigned ldsw = (unsigned)wid * 1024u;
    const int aoff = lds_byte(wr * 64 + fr, fq * 8), boff = lds_byte(wc * 32 + fr, fq * 8);
    unsigned voC[2][2], voN[2][2];
#define PG8_SA(b, h) (((b) * 2 + (h)) * HTB)
#define PG8_SB(b, h) ((4 + (b) * 2 + (h)) * HTB)
#define PG8_STAGE_B(bufoff, kptr, h) do { _Pragma("unroll") for (int _i = 0; _i < 2; ++_i) \
        __builtin_amdgcn_global_load_lds((const unsigned*)((kptr) + (Epi::P64 ? (size_t)((h) ? voffB[_i] + 8u * ldb2 : voffB[_i]) : (h) * hstepB + voffB[_i])), (PG8_LAS unsigned*)(lds + (bufoff) + ldsw + _i * 8192), 16, 0, 0); } while (0)
#define PG8_STAGE_A(bufoff, kptr, h) do { _Pragma("unroll") for (int _i = 0; _i < 2; ++_i) \
        __builtin_amdgcn_global_load_lds((const unsigned*)((kptr) + (h) * hstepA + (Ops::GATHER ? voC[h][_i] : voffA[_i])), (PG8_LAS unsigned*)(lds + (bufoff) + ldsw + _i * 8192), 16, 0, 0); } while (0)
#define PG8_CAT8(x, y) __builtin_shufflevector(__builtin_bit_cast(i32x4, (x)), __builtin_bit_cast(i32x4, (y)), 0, 1, 2, 3, 4, 5, 6, 7)
#define PG8_LDA(dst, b, h) do { if constexpr (Ops::FP8) { _Pragma("unroll") for (int m = 0; m < 4; ++m) dst##8[m] = PG8_CAT8(*(const PG8_LAS bf16x8*)(lds + PG8_SA(b, h) + aoff + m * 2048), *(const PG8_LAS bf16x8*)(lds + PG8_SA(b, h) + aoff + m * 2048 + 1024)); } \
        else { _Pragma("unroll") for (int m = 0; m < 4; ++m) _Pragma("unroll") for (int k = 0; k < 2; ++k) dst[m][k] = *(const PG8_LAS bf16x8*)(lds + PG8_SA(b, h) + aoff + m * 2048 + k * 1024); } } while (0)
#define PG8_LDB(dst, b, h) do { if constexpr (Ops::FP8) { _Pragma("unroll") for (int n = 0; n < 2; ++n) dst##8[n] = PG8_CAT8(*(const PG8_LAS bf16x8*)(lds + PG8_SB(b, h) + boff + n * 2048), *(const PG8_LAS bf16x8*)(lds + PG8_SB(b, h) + boff + n * 2048 + 1024)); } \
        else { _Pragma("unroll") for (int n = 0; n < 2; ++n) _Pragma("unroll") for (int k = 0; k < 2; ++k) dst[n][k] = *(const PG8_LAS bf16x8*)(lds + PG8_SB(b, h) + boff + n * 2048 + k * 1024); } } while (0)
#define PG8_MMA(ai, bj, At, Bt) do { __builtin_amdgcn_s_setprio(1); if constexpr (Ops::FP8) { _Pragma("unroll") for (int m = 0; m < 4; ++m) _Pragma("unroll") for (int n = 0; n < 2; ++n) \
            asm volatile("v_mfma_scale_f32_16x16x128_f8f6f4 %0, %1, %2, %0, %3, %4 op_sel_hi:[0,0,0]" : "+v"(acc[ai][bj][m][n]) : "v"(Bt##8[n]), "v"(At##8[m]), "v"(sc_b), "v"(sc_a)); } \
        else { _Pragma("unroll") for (int m = 0; m < 4; ++m) _Pragma("unroll") for (int n = 0; n < 2; ++n) _Pragma("unroll") for (int k = 0; k < 2; ++k) \
            acc[ai][bj][m][n] = __builtin_amdgcn_mfma_f32_16x16x32_bf16(Bt[n][k], At[m][k], acc[ai][bj][m][n], 0, 0, 0); } __builtin_amdgcn_s_setprio(0); } while (0)
#define PG8_WAIT_V(n) asm volatile("s_waitcnt vmcnt(" #n ")" ::: "memory")
#define PG8_WAIT_L(n) asm volatile("s_waitcnt lgkmcnt(" #n ")" ::: "memory")
#define PG8_BAR __builtin_amdgcn_s_barrier()
#define PG8_SCHED __builtin_amdgcn_sched_barrier(0)
#define PG8_GLOAD(vo, u) do { if constexpr (Ops::GATHER) { _Pragma("unroll") for (int _h = 0; _h < 2; ++_h) _Pragma("unroll") for (int _i = 0; _i < 2; ++_i) vo[_h][_i] = O.grow(u, _h * HALF + RA[_i]) + (unsigned)CA2[_i]; } } while (0)
    Unit cur, nxt; int ui = 0;
    if (!S.next(0, cur)) return;
    cur.par = 0;
    f32x4 acc[2][2][4][2];
#pragma unroll
    for (int a = 0; a < 2; ++a)
#pragma unroll
        for (int b = 0; b < 2; ++b)
#pragma unroll
            for (int m = 0; m < 4; ++m)
#pragma unroll
                for (int n = 0; n < 2; ++n) acc[a][b][m][n] = (f32x4){0.f, 0.f, 0.f, 0.f};
    bf16x8 At[4][2], B0[2][2], B1[2][2]; i32x8 At8[4], B08[2], B18[2];
    int sc_a = 0x7f7f7f7f, sc_b = 0x7f7f7f7f; if constexpr (Ops::FP8) { sc_a = O.sa; sc_b = O.sb; }
    const char* cA = O.a_tile(cur); const char* cB = O.b_tile(cur);
    const char* cA2 = nullptr; const char* cB2 = nullptr; int nt1 = nt;
    if constexpr (Ops::DUAL) { cA2 = O.a_tile2(cur); cB2 = O.b_tile2(cur); nt1 = O.nt1; }
    PG8_GLOAD(voC, cur);
    S.a_ready(cur);
    if constexpr (Epi::NSTAGE > 0) { if (wid == 0) E.stage(cur, lds + STAGE_BYTES + 4096 + cur.par * 2048, lane); }
    PG8_STAGE_B(PG8_SB(0, 0), cB, 0); PG8_STAGE_B(PG8_SB(0, 1), cB, 1); PG8_STAGE_A(PG8_SA(0, 0), cA, 0); PG8_STAGE_A(PG8_SA(0, 1), cA, 1);
    if (wr == 1) PG8_BAR;
    PG8_WAIT_V(2); PG8_BAR;
    PG8_STAGE_B(PG8_SB(1, 0), cB + kstep, 0); PG8_STAGE_A(PG8_SA(1, 0), cA + kstep, 0); PG8_STAGE_B(PG8_SB(1, 1), cB + kstep, 1);
    PG8_WAIT_V(6); PG8_BAR;
    for (;;) {
        const bool has_next = S.next(ui + 1, nxt); nxt.par = (ui + 1) & 1;
        const char* nA = has_next ? O.a_tile(nxt) : cA; const char* nB = has_next ? O.b_tile(nxt) : cB;
        if constexpr (Ops::GATHER) { if (has_next) { PG8_GLOAD(voN, nxt); } else {
#pragma unroll
            for (int _h = 0; _h < 2; ++_h)
#pragma unroll
                for (int _i = 0; _i < 2; ++_i) voN[_h][_i] = voC[_h][_i]; } }
        const char* nA2 = nullptr; const char* nB2 = nullptr;
        if constexpr (Ops::DUAL) { nA2 = has_next ? O.a_tile2(nxt) : cA2; nB2 = has_next ? O.b_tile2(nxt) : cB2; }
        for (int t = 0; t < nt; t += 2) {
            const bool last = (t == nt - 2);
            const char* a1; const char* a2; const char* b2;
            if constexpr (Ops::DUAL) {
                a1 = (t < nt1 ? cA + (size_t)t * kstep : cA2 + (size_t)(t - nt1) * kstep) + kstep;
                a2 = last ? nA : (t + 2 < nt1 ? cA + (size_t)(t + 2) * kstep : cA2 + (size_t)(t + 2 - nt1) * kstep);
                b2 = last ? nB : (t + 2 < nt1 ? cB + (size_t)(t + 2) * kstep : cB2 + (size_t)(t + 2 - nt1) * kstep);
                if (t == nt1) E.mid(acc, cur, wr, wc, fr, fq);
            } else {
                a1 = cA + (size_t)(t + 1) * kstep;
                a2 = last ? nA : cA + (size_t)(t + 2) * kstep; b2 = last ? nB : cB + (size_t)(t + 2) * kstep;
            }
            const char* a3 = a2 + kstep; const char* b3 = b2 + kstep;
            if (last && has_next) S.a_ready(nxt);
            PG8_LDB(B0, 0, 0); PG8_LDB(B1, 0, 1); PG8_SCHED; PG8_LDA(At, 0, 0); PG8_STAGE_A(PG8_SA(1, 1), a1, 1);
            if constexpr (Ops::GATHER) { if (last) {
#pragma unroll
                for (int _h = 0; _h < 2; ++_h)
#pragma unroll
                    for (int _i = 0; _i < 2; ++_i) voC[_h][_i] = voN[_h][_i]; } }
            PG8_WAIT_V(8); PG8_WAIT_L(0); PG8_BAR; PG8_MMA(0, 0, At, B0); PG8_MMA(0, 1, At, B1); PG8_BAR; PG8_SCHED;
            PG8_LDA(At, 0, 1); PG8_STAGE_B(PG8_SB(0, 0), b2, 0); PG8_STAGE_B(PG8_SB(0, 1), b2, 1); PG8_STAGE_A(PG8_SA(0, 0), a2, 0);
            PG8_WAIT_V(8); PG8_WAIT_L(0); PG8_BAR; PG8_MMA(1, 0, At, B0); PG8_MMA(1, 1, At, B1); PG8_BAR; PG8_SCHED;
            PG8_LDB(B0, 1, 0); PG8_LDB(B1, 1, 1); PG8_SCHED; PG8_LDA(At, 1, 0); PG8_STAGE_A(PG8_SA(0, 1), a2, 1);
            PG8_WAIT_V(8); PG8_WAIT_L(0); PG8_BAR; PG8_MMA(0, 0, At, B0); PG8_MMA(0, 1, At, B1); PG8_BAR; PG8_SCHED;
            PG8_LDA(At, 1, 1); PG8_STAGE_B(PG8_SB(1, 0), b3, 0); PG8_STAGE_B(PG8_SB(1, 1), b3, 1); PG8_STAGE_A(PG8_SA(1, 0), a3, 0);
            PG8_WAIT_V(8); PG8_WAIT_L(0); PG8_BAR; PG8_MMA(1, 0, At, B0); PG8_MMA(1, 1, At, B1); PG8_BAR; PG8_SCHED;
        }
        if constexpr (ALIGN_EPI) { if (wr == 0) PG8_BAR; }
        { int fr_e = fr, fq_e = fq; asm volatile("" : "+v"(fr_e), "+v"(fq_e));
          E(acc, cur, wr, wc, fr_e, fq_e); } S.done(cur);
        if (!has_next) break;
#pragma unroll
        for (int a = 0; a < 2; ++a)
#pragma unroll
            for (int b = 0; b < 2; ++b)
#pragma unroll
                for (int m = 0; m < 4; ++m)
#pragma unroll
                    for (int n = 0; n < 2; ++n) acc[a][b][m][n] = (f32x4){0.f, 0.f, 0.f, 0.f};
        cur = nxt; cA = nA; cB = nB; ++ui;
        if constexpr (Epi::NSTAGE > 0) { if (wid == 0) E.stage(cur, lds + STAGE_BYTES + 4096 + cur.par * 2048, lane); }
        if constexpr (Ops::DUAL) { cA2 = nA2; cB2 = nB2; }
        if constexpr (ALIGN_EPI) { if (wr == 1) PG8_BAR; }
    }
    PG8_WAIT_V(0);
    if constexpr (!ALIGN_EPI) { if (wr == 0) PG8_BAR; }
    PG8_BAR;
#undef PG8_SA
#undef PG8_SB
#undef PG8_STAGE_A
#undef PG8_STAGE_B
#undef PG8_LDA
#undef PG8_CAT8
#undef PG8_LDB
#undef PG8_MMA
#undef PG8_WAIT_V
#undef PG8_WAIT_L
#undef PG8_BAR
#undef PG8_SCHED
#undef PG8_GLOAD
}
}
namespace pg8 {
struct OpsPlain { static constexpr bool FP8 = false, GATHER = false, DUAL = false; const char* A; const char* B; unsigned lda2, ldb2;
    __device__ __forceinline__ const char* a_tile(const Unit& u) const { return A + (size_t)u.pm * 256 * lda2; }
    __device__ __forceinline__ const char* b_tile(const Unit& u) const { return B + (size_t)u.pn * 256 * ldb2; }
    __device__ __forceinline__ unsigned grow(const Unit&, int) const { return 0u; } };
struct OpsPlainF8 { static constexpr bool FP8 = true, GATHER = false, DUAL = false; const char* A; const char* B; unsigned lda2, ldb2; int sa, sb;
    __device__ __forceinline__ const char* a_tile(const Unit& u) const { return A + (size_t)u.pm * 256 * lda2; }
    __device__ __forceinline__ const char* b_tile(const Unit& u) const { return B + (size_t)u.pn * 256 * ldb2; }
    __device__ __forceinline__ unsigned grow(const Unit&, int) const { return 0u; } };
struct OpsZ { static constexpr bool FP8 = false, GATHER = false, DUAL = false; const char* A; const char* B; unsigned lda2, ldb2; unsigned gmap;
    __device__ __forceinline__ const char* a_tile(const Unit& u) const { return A + (size_t)u.pm * 256 * lda2; }
    __device__ __forceinline__ const char* b_tile(const Unit& u) const { return B + (size_t)(((gmap >> (4 * (u.pn >> 2))) & 15u) * 1024u + (u.pn & 3) * 256u) * ldb2; }
    __device__ __forceinline__ unsigned grow(const Unit&, int) const { return 0u; } };
struct OpsZF8 { static constexpr bool FP8 = true, GATHER = false, DUAL = false; const char* A; const char* B; unsigned lda2, ldb2; unsigned gmap; int sa, sb;
    __device__ __forceinline__ const char* a_tile(const Unit& u) const { return A + (size_t)u.pm * 256 * lda2; }
    __device__ __forceinline__ const char* b_tile(const Unit& u) const { return B + (size_t)(((gmap >> (4 * (u.pn >> 2))) & 15u) * 1024u + (u.pn & 3) * 256u) * ldb2; }
    __device__ __forceinline__ unsigned grow(const Unit&, int) const { return 0u; } };
struct OpsBatchB { static constexpr bool FP8 = false, GATHER = false, DUAL = false; const char* A; const char* B; unsigned lda2, ldb2; size_t bstride;
    __device__ __forceinline__ const char* a_tile(const Unit& u) const { return A + (size_t)u.pm * 256 * lda2; }
    __device__ __forceinline__ const char* b_tile(const Unit& u) const { return B + (size_t)(u.pm >> 4) * bstride + (size_t)u.pn * 256 * ldb2; }
    __device__ __forceinline__ unsigned grow(const Unit&, int) const { return 0u; } };
struct OpsBatchBF8 { static constexpr bool FP8 = true, GATHER = false, DUAL = false; const char* A; const char* B; unsigned lda2, ldb2; size_t bstride; int sa, sb;
    __device__ __forceinline__ const char* a_tile(const Unit& u) const { return A + (size_t)u.pm * 256 * lda2; }
    __device__ __forceinline__ const char* b_tile(const Unit& u) const { return B + (size_t)(u.pm >> 4) * bstride + (size_t)u.pn * 256 * ldb2; }
    __device__ __forceinline__ unsigned grow(const Unit&, int) const { return 0u; } };
struct OpsDual { static constexpr bool FP8 = false, GATHER = false, DUAL = true; const char* A; const char* B; const char* A2; const char* B2; unsigned lda2, ldb2; int nt1;
    __device__ __forceinline__ const char* a_tile(const Unit& u) const { return A + (size_t)u.pm * 256 * lda2; }
    __device__ __forceinline__ const char* b_tile(const Unit& u) const { return B + (size_t)u.pn * 256 * ldb2; }
    __device__ __forceinline__ const char* a_tile2(const Unit& u) const { return A2 + (size_t)u.pm * 256 * lda2; }
    __device__ __forceinline__ const char* b_tile2(const Unit& u) const { return B2 + (size_t)u.pn * 256 * ldb2; }
    __device__ __forceinline__ unsigned grow(const Unit&, int) const { return 0u; } };
struct OpsWp { static constexpr bool FP8 = false, GATHER = false, DUAL = false; const char* kv; const char* wq; unsigned lda2, ldb2;
    __device__ __forceinline__ const char* a_tile(const Unit& u) const { return kv + (size_t)(u.pm >> 2) * 256 * 4096 + (size_t)(u.pm & 3) * 512; }
    __device__ __forceinline__ const char* b_tile(const Unit& u) const { return wq + (size_t)u.pn * 256 * 2048 + (size_t)(u.pm & 3) * 512; }
    __device__ __forceinline__ unsigned grow(const Unit&, int) const { return 0u; } };
struct OpsVp { static constexpr bool FP8 = false, GATHER = false, DUAL = false; const char* wo; const char* kv; unsigned lda2, ldb2;
    __device__ __forceinline__ const char* a_tile(const Unit& u) const { return wo + (size_t)(u.pm & 3) * 256 * 2048 + (size_t)u.pn * 512; }
    __device__ __forceinline__ const char* b_tile(const Unit& u) const { return kv + (size_t)(u.pm >> 2) * 256 * 4096 + 2048 + (size_t)u.pn * 512; }
    __device__ __forceinline__ unsigned grow(const Unit&, int) const { return 0u; } };
#define MOE_MP(pm) ((pm) < nT0 ? (pm) : (pm) - nT0 + MOE_HTILES)
constexpr int MOE_HTILES = 544;
struct OpsG1 { static constexpr bool FP8 = true, GATHER = true, DUAL = false; const char* A; const char* W; const int* toklist; const int* tile_e; unsigned lda2, ldb2; int sa, sb; int nT0;
    __device__ __forceinline__ const char* a_tile(const Unit&) const { return A; }
    __device__ __forceinline__ const char* b_tile(const Unit& u) const { return W + (size_t)tile_e[MOE_MP(u.pm)] * ((size_t)2048 * 1024) + (size_t)u.pn * 256 * 1024; }
    __device__ __forceinline__ unsigned grow(const Unit& u, int r) const { return (unsigned)toklist[MOE_MP(u.pm) * 256 + r] * 1024u; } };
struct OpsG2 { static constexpr bool FP8 = true, GATHER = false, DUAL = false; const char* A; const char* W; const int* tile_e; unsigned lda2, ldb2; int sa, sb; int nT0;
    __device__ __forceinline__ const char* a_tile(const Unit& u) const { return A + (size_t)MOE_MP(u.pm) * 256 * 1024; }
    __device__ __forceinline__ const char* b_tile(const Unit& u) const { return W + (size_t)tile_e[MOE_MP(u.pm)] * ((size_t)1024 * 1024) + (size_t)u.pn * 256 * 1024; }
    __device__ __forceinline__ unsigned grow(const Unit&, int) const { return 0u; } };

__device__ __forceinline__ unsigned pk4_fp8(float a, float b, float c, float d) { int w = 0; w = __builtin_amdgcn_cvt_pk_fp8_f32(a, b, w, false); w = __builtin_amdgcn_cvt_pk_fp8_f32(c, d, w, true); return (unsigned)w; }
#define EPI_ARGS const f32x4 (&acc)[2][2][4][2], const Unit& u, int wr, int wc, int fr, int fq
__device__ __forceinline__ u32x4 pack8(const f32x4 a, const f32x4 b) { u32x4 w; w.x = cvt_pk_bf16(a[0], a[1]); w.y = cvt_pk_bf16(a[2], a[3]); w.z = cvt_pk_bf16(b[0], b[1]); w.w = cvt_pk_bf16(b[2], b[3]); return w; }
__device__ __forceinline__ void unpack8(const u32x4 w, f32x4& a, f32x4& b) { a = (f32x4){bf_lo(w.x), bf_hi(w.x), bf_lo(w.y), bf_hi(w.y)}; b = (f32x4){bf_lo(w.z), bf_hi(w.z), bf_lo(w.w), bf_hi(w.w)}; }

struct EpiZ1 { static constexpr bool PERM = true; static constexpr int NSTAGE = 0; static constexpr bool P64 = false; bf16_t* O; size_t tstride; const float* rs; float qscale; int qtile; unsigned gmap;
    __device__ __forceinline__ void operator()(EPI_ARGS) const {
        const int t = (int)((gmap >> (4 * (u.pn >> 2))) & 15u); bf16_t* base = O + (size_t)t * tstride; const float sc = (t == qtile) ? qscale : 1.f;
        const int col0 = (u.pn & 3) * 256 + wc * 32 + 8 * fq; const int r0 = u.pm * 256 + wr * 64 + fr;
#ifdef KV_ROWMAJOR
        const int W = 10;
#else
        const int W = (t == 3) ? 6 : (t == 4) ? 7 : 10;
#endif
        size_t cpart[2];
#pragma unroll
        for (int bj = 0; bj < 2; ++bj) { const int col = col0 + bj * 128; cpart[bj] = ((size_t)(col >> W) << (12 + W)) + (size_t)(col & ((1 << W) - 1)); }
#pragma unroll
        for (int ai = 0; ai < 2; ++ai)
#pragma unroll
            for (int m = 0; m < 4; ++m) { const float s = sc; const int row = r0 + ai * 128 + m * 16; bf16_t* rowp = base + ((size_t)(row >> 12) << 22) + ((size_t)(row & 4095) << W);
#pragma unroll
                for (int bj = 0; bj < 2; ++bj) *(u32x4*)(rowp + cpart[bj]) = pack8(acc[ai][bj][m][0] * s, acc[ai][bj][m][1] * s); }
    } };
struct EpiZ3 { static constexpr bool PERM = true; static constexpr int NSTAGE = 1; static constexpr bool P64 = false; const bf16_t* HM; bf16_t* HO; bf16_t* GM; bf16_t* GD; const float* rs; const float* bgate; bool dry; unsigned gmap; PG8_LAS unsigned char* elds;
    __device__ __forceinline__ void stage(const Unit& u, PG8_LAS unsigned char* dst, int lane) const {
        const int t = (int)((gmap >> (4 * (u.pn >> 2))) & 15u) - 5;
        if (t >= 1) __builtin_amdgcn_global_load_lds((const unsigned*)(bgate + (t - 1) * 1024 + (u.pn & 3) * 256 + lane * 4), (PG8_LAS unsigned*)dst, 16, 0, 0); }
    __device__ __forceinline__ void operator()(EPI_ARGS) const {
        const int t = (int)((gmap >> (4 * (u.pn >> 2))) & 15u) - 5; const int col0 = (u.pn & 3) * 256 + wc * 32 + 8 * fq; const int r0 = u.pm * 256 + wr * 64 + fr;
#ifdef Z3_FULLDRY
        if (dry) return;
#endif
        float sv[2][4];
#pragma unroll
        for (int ai = 0; ai < 2; ++ai)
#pragma unroll
            for (int m = 0; m < 4; ++m) sv[ai][m] = 1.0f;
        if (t == 0) {
#pragma unroll
            for (int ai = 0; ai < 2; ++ai) { u32x4 hv[4][2];
#pragma unroll
                for (int m = 0; m < 4; ++m)
#pragma unroll
                    for (int bj = 0; bj < 2; ++bj) hv[m][bj] = *(const u32x4*)(HM + (size_t)(r0 + ai * 128 + m * 16) * 1024 + col0 + bj * 128);
#pragma unroll
                for (int m = 0; m < 4; ++m) { const float s = sv[ai][m]; bf16_t* rowp = HO + (size_t)(r0 + ai * 128 + m * 16) * 1024 + col0;
#pragma unroll
                    for (int bj = 0; bj < 2; ++bj) { f32x4 h0, h1; unpack8(hv[m][bj], h0, h1); f32x4 o0, o1;
#pragma unroll
                        for (int i = 0; i < 4; ++i) { o0[i] = sigmoidf_(acc[ai][bj][m][0][i] * s) * h0[i]; o1[i] = sigmoidf_(acc[ai][bj][m][1][i] * s) * h1[i]; }
                        if (!dry) *(u32x4*)(rowp + bj * 128) = pack8(o0, o1); } } }
        } else {
            bf16_t* dst = (t == 1) ? GM : GD; const PG8_LAS float* bb = (const PG8_LAS float*)(elds + u.par * 2048) + wc * 32 + 8 * fq;
            f32x4 bv[2][2];
#pragma unroll
            for (int bj = 0; bj < 2; ++bj)
#pragma unroll
                for (int n = 0; n < 2; ++n) bv[bj][n] = *(const PG8_LAS f32x4*)(bb + bj * 128 + 4 * n);
#pragma unroll
            for (int ai = 0; ai < 2; ++ai)
#pragma unroll
                for (int m = 0; m < 4; ++m) { const float s = sv[ai][m]; bf16_t* rowp = dst + (size_t)(r0 + ai * 128 + m * 16) * 1024 + col0;
#pragma unroll
                    for (int bj = 0; bj < 2; ++bj) { f32x4 o0, o1;
#pragma unroll
                        for (int i = 0; i < 4; ++i) { o0[i] = sigmoidf_(acc[ai][bj][m][0][i] * s + bv[bj][0][i]); o1[i] = sigmoidf_(acc[ai][bj][m][1][i] * s + bv[bj][1][i]); }
                        *(u32x4*)(rowp + bj * 128) = pack8(o0, o1); } }
        }
    } };
struct EpiGate { static constexpr bool PERM = true; static constexpr int NSTAGE = 0; static constexpr bool P64 = false; const bf16_t* Gt; const bf16_t* ADD; bf16_t* Out; bool dry;
    __device__ __forceinline__ void operator()(EPI_ARGS) const {
        if (dry) return;
        const int col0 = u.pn * 256 + wc * 32 + 8 * fq;
#pragma unroll
        for (int ai = 0; ai < 2; ++ai) { u32x4 gv[4][2], av[4][2];
#pragma unroll
            for (int m = 0; m < 4; ++m)
#pragma unroll
                for (int bj = 0; bj < 2; ++bj) { const size_t ro = (size_t)(u.pm * 256 + ai * 128 + wr * 64 + m * 16 + fr) * 1024 + col0 + bj * 128; gv[m][bj] = *(const u32x4*)(Gt + ro); av[m][bj] = ADD ? *(const u32x4*)(ADD + ro) : (u32x4){0u, 0u, 0u, 0u}; }
#pragma unroll
            for (int m = 0; m < 4; ++m)
#pragma unroll
                for (int bj = 0; bj < 2; ++bj) { const size_t ro = (size_t)(u.pm * 256 + ai * 128 + wr * 64 + m * 16 + fr) * 1024 + col0 + bj * 128; f32x4 g0, g1, a0, a1; unpack8(gv[m][bj], g0, g1); unpack8(av[m][bj], a0, a1);
                    *(u32x4*)(Out + ro) = pack8(a0 + g0 * acc[ai][bj][m][0], a1 + g1 * acc[ai][bj][m][1]); } }
    } };
#ifndef BRF_MG
#define BRF_MG 4
#endif
struct EpiBRF { static constexpr bool PERM = true; static constexpr int NSTAGE = 0; static constexpr bool P64 = false; const bf16_t* GM; const bf16_t* GD; bf16_t* Out;
    __device__ __forceinline__ void mid(f32x4 (&acc)[2][2][4][2], const Unit& u, int wr, int wc, int fr, int fq) const {
        const int col0 = u.pn * 256 + wc * 32 + 8 * fq;
#pragma unroll
        for (int ai = 0; ai < 2; ++ai) { u32x4 gm[BRF_MG][2], gd[BRF_MG][2];
#pragma unroll
            for (int mb = 0; mb < 4; mb += BRF_MG) {
#pragma unroll
                for (int mi = 0; mi < BRF_MG; ++mi) { const size_t ro = (size_t)(u.pm * 256 + ai * 128 + wr * 64 + (mb + mi) * 16 + fr) * 1024 + col0;
#pragma unroll
                    for (int bj = 0; bj < 2; ++bj) { gm[mi][bj] = *(const u32x4*)(GM + ro + bj * 128); gd[mi][bj] = *(const u32x4*)(GD + ro + bj * 128); } }
#pragma unroll
                for (int mi = 0; mi < BRF_MG; ++mi) { const int m = mb + mi;
#pragma unroll
                    for (int bj = 0; bj < 2; ++bj) { f32x4 m0, m1, d0, d1; unpack8(gm[mi][bj], m0, m1); unpack8(gd[mi][bj], d0, d1);
#pragma unroll
                        for (int i = 0; i < 4; ++i) { acc[ai][bj][m][0][i] *= m0[i] * __builtin_amdgcn_rcpf(d0[i]); acc[ai][bj][m][1][i] *= m1[i] * __builtin_amdgcn_rcpf(d1[i]); } } }
                asm volatile("" ::: "memory"); } }
    }
    __device__ __forceinline__ void operator()(EPI_ARGS) const {
        const int col0 = u.pn * 256 + wc * 32 + 8 * fq;
#pragma unroll
        for (int ai = 0; ai < 2; ++ai) { u32x4 gd[4][2];
#pragma unroll
            for (int m = 0; m < 4; ++m)
#pragma unroll
                for (int bj = 0; bj < 2; ++bj) gd[m][bj] = *(const u32x4*)(GD + (size_t)(u.pm * 256 + ai * 128 + wr * 64 + m * 16 + fr) * 1024 + col0 + bj * 128);
#pragma unroll
            for (int m = 0; m < 4; ++m)
#pragma unroll
                for (int bj = 0; bj < 2; ++bj) { f32x4 d0, d1; unpack8(gd[m][bj], d0, d1);
                    *(u32x4*)(Out + (size_t)(u.pm * 256 + ai * 128 + wr * 64 + m * 16 + fr) * 1024 + col0 + bj * 128) = pack8(acc[ai][bj][m][0] * d0, acc[ai][bj][m][1] * d1); } }
    } };
__device__ __forceinline__ unsigned gate_q4(const f32x4 g) {
    const unsigned k0 = min((unsigned)(g[0] * 256.0f), 255u), k1 = min((unsigned)(g[1] * 256.0f), 255u), k2 = min((unsigned)(g[2] * 256.0f), 255u), k3 = min((unsigned)(g[3] * 256.0f), 255u);
    return k0 | (k1 << 8) | (k2 << 16) | (k3 << 24); }
__device__ __forceinline__ f32x4 gate_dq4(const unsigned w) {
    return (f32x4){(float)(w & 255u) * (1.0f / 256.0f) + (0.5f / 256.0f), (float)((w >> 8) & 255u) * (1.0f / 256.0f) + (0.5f / 256.0f), (float)((w >> 16) & 255u) * (1.0f / 256.0f) + (0.5f / 256.0f), (float)(w >> 24) * (1.0f / 256.0f) + (0.5f / 256.0f)}; }
struct EpiZ3G { static constexpr bool PERM = true; static constexpr int NSTAGE = 1; static constexpr bool P64 = true; unsigned char* GM; unsigned char* GD; const float* bgate; unsigned gmap; PG8_LAS unsigned char* elds;
    __device__ __forceinline__ void stage(const Unit& u, PG8_LAS unsigned char* dst, int lane) const {
        const int t = (int)((gmap >> (4 * (u.pn >> 2))) & 15u) - 6;
        __builtin_amdgcn_global_load_lds((const unsigned*)(bgate + t * 1024 + (u.pn & 3) * 256 + lane * 4), (PG8_LAS unsigned*)dst, 16, 0, 0); }
    __device__ __forceinline__ void operator()(EPI_ARGS) const {
        const int t = (int)((gmap >> (4 * (u.pn >> 2))) & 15u) - 6; unsigned char* dst = (t == 0) ? GM : GD;
        const int col0 = (u.pn & 3) * 256 + wc * 64 + 16 * fq; const PG8_LAS float* bb = (const PG8_LAS float*)(elds + u.par * 2048) + wc * 64 + 16 * fq;
        f32x4 bv[2][2];
#pragma unroll
        for (int bj = 0; bj < 2; ++bj)
#pragma unroll
            for (int n = 0; n < 2; ++n) bv[bj][n] = *(const PG8_LAS f32x4*)(bb + bj * 8 + 4 * n);
#pragma unroll
        for (int ai = 0; ai < 2; ++ai)
#pragma unroll
            for (int m = 0; m < 4; ++m) { unsigned char* rowp = dst + (size_t)(u.pm * 256 + ai * 128 + wr * 64 + m * 16 + fr) * 1024 + col0; u32x4 pk;
#pragma unroll
                for (int bj = 0; bj < 2; ++bj)
#pragma unroll
                    for (int n = 0; n < 2; ++n) { f32x4 g;
#pragma unroll
                        for (int i = 0; i < 4; ++i) g[i] = sigmoidf_(acc[ai][bj][m][n][i] + bv[bj][n][i]);
                        pk[2 * bj + n] = gate_q4(g); }
                *(u32x4*)rowp = pk; }
    } };
#ifndef BRF8_MG
#define BRF8_MG 2
#endif
struct EpiBRF8 { static constexpr bool PERM = true; static constexpr int NSTAGE = 0; static constexpr bool P64 = true; const unsigned char* GM; const unsigned char* GD; bf16_t* Out;
    __device__ __forceinline__ void mid(f32x4 (&acc)[2][2][4][2], const Unit& u, int wr, int wc, int fr, int fq) const {
        unsigned rb = (unsigned)(u.pm * 256 + wr * 64 + fr) * 1024u + (unsigned)(u.pn * 256 + wc * 64 + 16 * fq); asm volatile("" : "+v"(rb));
#pragma unroll
        for (int ai = 0; ai < 2; ++ai) {
#pragma unroll
            for (int mb = 0; mb < 4; mb += BRF8_MG) { u32x4 gm[BRF8_MG], gd[BRF8_MG];
#pragma unroll
                for (int mi = 0; mi < BRF8_MG; ++mi) { const unsigned ro = rb + (unsigned)(ai * 128 + (mb + mi) * 16) * 1024u; gm[mi] = *(const u32x4*)(GM + ro); gd[mi] = *(const u32x4*)(GD + ro); }
#pragma unroll
                for (int mi = 0; mi < BRF8_MG; ++mi) { const int m = mb + mi;
#pragma unroll
                    for (int bj = 0; bj < 2; ++bj)
#pragma unroll
                        for (int n = 0; n < 2; ++n) { const f32x4 mm = gate_dq4(gm[mi][2 * bj + n]), dd = gate_dq4(gd[mi][2 * bj + n]);
#pragma unroll
                            for (int i = 0; i < 4; ++i) acc[ai][bj][m][n][i] *= mm[i] * __builtin_amdgcn_rcpf(dd[i]); } }
                asm volatile("" ::: "memory"); } }
    }
    __device__ __forceinline__ void operator()(EPI_ARGS) const {
        unsigned rb = (unsigned)(u.pm * 256 + wr * 64 + fr) * 1024u + (unsigned)(u.pn * 256 + wc * 64 + 16 * fq); asm volatile("" : "+v"(rb));
#pragma unroll
        for (int ai = 0; ai < 2; ++ai) { u32x4 gd[4];
#pragma unroll
            for (int m = 0; m < 4; ++m) gd[m] = *(const u32x4*)(GD + (rb + (unsigned)(ai * 128 + m * 16) * 1024u));
#pragma unroll
            for (int m = 0; m < 4; ++m)
#pragma unroll
                for (int bj = 0; bj < 2; ++bj) { const f32x4 d0 = gate_dq4(gd[m][2 * bj]), d1 = gate_dq4(gd[m][2 * bj + 1]);
                    *(u32x4*)(Out + (rb + (unsigned)(ai * 128 + m * 16) * 1024u + (unsigned)(bj * 8))) = pack8(acc[ai][bj][m][0] * d0, acc[ai][bj][m][1] * d1); } }
    } };
template <bool BASE_BF16> struct EpiResB { static constexpr bool PERM = true; static constexpr int NSTAGE = 0; static constexpr bool P64 = true; const void* base; bf16_t* xb; float* ss; unsigned char* xq;
    __device__ __forceinline__ void operator()(EPI_ARGS) const {
        const int col0 = u.pn * 256 + wc * 64 + 16 * fq;
#pragma unroll
        for (int ai = 0; ai < 2; ++ai) { f32x4 bvv[4][2][2];
#pragma unroll
            for (int m = 0; m < 4; ++m)
#pragma unroll
                for (int bj = 0; bj < 2; ++bj) { const size_t off = (size_t)(u.pm * 256 + ai * 128 + wr * 64 + m * 16 + fr) * 1024 + col0 + bj * 8;
                    if constexpr (BASE_BF16) { const u32x4 w = *(const u32x4*)((const bf16_t*)base + off); unpack8(w, bvv[m][bj][0], bvv[m][bj][1]); }
                    else { bvv[m][bj][0] = *(const f32x4*)((const float*)base + off); bvv[m][bj][1] = *(const f32x4*)((const float*)base + off + 4); } }
#pragma unroll
            for (int m = 0; m < 4; ++m) { const int r = u.pm * 256 + ai * 128 + wr * 64 + m * 16 + fr; const size_t ro = (size_t)r * 1024 + col0; float sq = 0.f; u32x4 q8;
#pragma unroll
                for (int bj = 0; bj < 2; ++bj) { const f32x4 o0 = bvv[m][bj][0] + acc[ai][bj][m][0], o1 = bvv[m][bj][1] + acc[ai][bj][m][1];
                    const u32x4 w = pack8(o0, o1); *(u32x4*)(xb + ro + bj * 8) = w;
                    f32x4 q0, q1; unpack8(w, q0, q1);
                    sq += ((q0[0] * q0[0] + q0[1] * q0[1]) + (q0[2] * q0[2] + q0[3] * q0[3])) + ((q1[0] * q1[0] + q1[1] * q1[1]) + (q1[2] * q1[2] + q1[3] * q1[3]));
                    q8[2 * bj] = pk4_fp8(q0[0], q0[1], q0[2], q0[3]); q8[2 * bj + 1] = pk4_fp8(q1[0], q1[1], q1[2], q1[3]); }
                if (xq) *(u32x4*)(xq + ro) = q8;
                if (ss) { sq += __shfl_xor(sq, 16); sq += __shfl_xor(sq, 32);
                    if (fq == 0) ss[(size_t)r * 16 + u.pn * 4 + wc] = sq; } } }
    } };
struct EpiS { static constexpr bool PERM = true; static constexpr int NSTAGE = 0; static constexpr bool P64 = true; unsigned char* P; const float* ss; PG8_LAS float* xl;
    __device__ __forceinline__ void operator()(EPI_ARGS) const {
        const int col0 = u.pn * 256 + wc * 64 + 16 * fq;
        float rsv[2][4];
#pragma unroll
        for (int ai = 0; ai < 2; ++ai)
#pragma unroll
            for (int m = 0; m < 4; ++m) { const int r = u.pm * 256 + ai * 128 + wr * 64 + m * 16 + fr; const f32x4 s0 = *((const f32x4*)(ss + (size_t)r * 16) + fq);
                float sq = (s0[0] + s0[1]) + (s0[2] + s0[3]); sq += __shfl_xor(sq, 16); sq += __shfl_xor(sq, 32);
                const float s = 1.0f / sqrtf(sq * (1.0f / 1024.0f) + 1e-6f); rsv[ai][m] = s; float sum = 0.f;
#pragma unroll
                for (int bj = 0; bj < 2; ++bj)
#pragma unroll
                    for (int n = 0; n < 2; ++n)
#pragma unroll
                        for (int i = 0; i < 4; ++i) sum += __builtin_amdgcn_exp2f(acc[ai][bj][m][n][i] * s);
                sum += __shfl_xor(sum, 16); sum += __shfl_xor(sum, 32);
                if (fq == 0) xl[(ai * 128 + wr * 64 + m * 16 + fr) * 4 + wc] = sum; }
        asm volatile("s_waitcnt lgkmcnt(0)" ::: "memory"); __builtin_amdgcn_s_barrier(); asm volatile("" ::: "memory");
#pragma unroll
        for (int ai = 0; ai < 2; ++ai)
#pragma unroll
            for (int m = 0; m < 4; ++m) { const int rl = ai * 128 + wr * 64 + m * 16 + fr; const f32x4 t4 = *(const PG8_LAS f32x4*)(xl + rl * 4); const float inv = 256.0f / ((t4[0] + t4[1]) + (t4[2] + t4[3])); const float s = rsv[ai][m];
                u32x4 pk;
#pragma unroll
                for (int bj = 0; bj < 2; ++bj) { f32x4 e0, e1;
#pragma unroll
                    for (int i = 0; i < 4; ++i) { e0[i] = __builtin_amdgcn_exp2f(acc[ai][bj][m][0][i] * s) * inv; e1[i] = __builtin_amdgcn_exp2f(acc[ai][bj][m][1][i] * s) * inv; }
                    pk[2 * bj] = pk4_fp8(e0[0], e0[1], e0[2], e0[3]); pk[2 * bj + 1] = pk4_fp8(e1[0], e1[1], e1[2], e1[3]); }
                *(u32x4*)(P + (size_t)(u.pm * 256 + rl) * 1024 + col0) = pk; }
    } };
struct EpiPlain { static constexpr bool PERM = true; static constexpr int NSTAGE = 0; static constexpr bool P64 = false; bf16_t* O; int ldc; float scale;
    __device__ __forceinline__ void operator()(EPI_ARGS) const {
        const int col0 = u.pn * 256 + wc * 32 + 8 * fq;
#pragma unroll
        for (int ai = 0; ai < 2; ++ai)
#pragma unroll
            for (int m = 0; m < 4; ++m) { bf16_t* rowp = O + (size_t)(u.pm * 256 + ai * 128 + wr * 64 + m * 16 + fr) * ldc + col0;
#pragma unroll
                for (int bj = 0; bj < 2; ++bj) *(u32x4*)(rowp + bj * 128) = pack8(acc[ai][bj][m][0] * scale, acc[ai][bj][m][1] * scale); }
    } };
struct EpiPlainF8 { static constexpr bool PERM = true; static constexpr int NSTAGE = 0; static constexpr bool P64 = false; unsigned char* O; int ldc; float scale;
    __device__ __forceinline__ void operator()(EPI_ARGS) const {
        const int col0 = u.pn * 256 + wc * 32 + 8 * fq;
#pragma unroll
        for (int ai = 0; ai < 2; ++ai)
#pragma unroll
            for (int m = 0; m < 4; ++m) { unsigned char* rowp = O + (size_t)(u.pm * 256 + ai * 128 + wr * 64 + m * 16 + fr) * ldc + col0;
#pragma unroll
                for (int bj = 0; bj < 2; ++bj) { const f32x4 v0 = acc[ai][bj][m][0] * scale, v1 = acc[ai][bj][m][1] * scale;
                    *(u32x2*)(rowp + bj * 128) = (u32x2){pk4_fp8(v0[0], v0[1], v0[2], v0[3]), pk4_fp8(v1[0], v1[1], v1[2], v1[3])}; } }
    } };
struct EpiG1 { static constexpr bool PERM = true; static constexpr int NSTAGE = 2; static constexpr bool P64 = false; unsigned char* H; const float* rs; const int* toklist; const int* tile_e; const float* bgu; bool dry; int nT0; PG8_LAS unsigned char* elds;
    __device__ __forceinline__ void stage(const Unit& u, PG8_LAS unsigned char* dst, int lane) const {
        const int mp = MOE_MP(u.pm); const float* bsrc = bgu + (size_t)tile_e[mp] * 2048 + u.pn * 128 + (lane & 31) * 4 + (lane >> 5) * 1024;
        __builtin_amdgcn_global_load_lds((const unsigned*)bsrc, (PG8_LAS unsigned*)dst, 16, 0, 0);
        __builtin_amdgcn_global_load_lds((const unsigned*)(rs + (size_t)mp * 256 + lane * 4), (PG8_LAS unsigned*)(dst + 1024), 16, 0, 0); }
    __device__ __forceinline__ void operator()(EPI_ARGS) const {
#ifdef PROBE_EPI_DRY
        if (dry) return;
#endif
        const int mp = MOE_MP(u.pm); const int colh = u.pn * 128 + wc * 32 + 8 * fq; const PG8_LAS float* el = (const PG8_LAS float*)(elds + u.par * 2048);
        f32x4 bgv[2], buv[2];
#pragma unroll
        for (int n = 0; n < 2; ++n) { bgv[n] = *(const PG8_LAS f32x4*)(el + wc * 32 + 8 * fq + 4 * n); buv[n] = *(const PG8_LAS f32x4*)(el + 128 + wc * 32 + 8 * fq + 4 * n); }
        float sv[2][4];
#pragma unroll
        for (int ai = 0; ai < 2; ++ai)
#pragma unroll
            for (int m = 0; m < 4; ++m) sv[ai][m] = el[256 + ai * 128 + wr * 64 + m * 16 + fr];
#pragma unroll
        for (int n = 0; n < 2; ++n) buv[n] += 1.0f;
#pragma unroll
        for (int ai = 0; ai < 2; ++ai)
#pragma unroll
            for (int m = 0; m < 4; ++m) { const int slot = mp * 256 + ai * 128 + wr * 64 + m * 16 + fr; const float s = sv[ai][m]; f32x4 o[2];
#pragma unroll
                for (int n = 0; n < 2; ++n)
#pragma unroll
                    for (int i = 0; i < 4; ++i) { const float g = fminf(acc[ai][0][m][n][i] * s + bgv[n][i], 7.0f); const float up1 = fminf(fmaxf(acc[ai][1][m][n][i] * s + buv[n][i], -6.0f), 8.0f);
                        o[n][i] = up1 * (g * sigmoidf_(1.702f * g)); }
                *(u32x2*)(H + (size_t)slot * 1024 + colh) = (u32x2){pk4_fp8(o[0][0], o[0][1], o[0][2], o[0][3]), pk4_fp8(o[1][0], o[1][1], o[1][2], o[1][3])}; }
    } };
struct EpiG2 { static constexpr bool PERM = true; static constexpr int NSTAGE = 1; static constexpr bool P64 = true; unsigned char* Y; const int* tile_e; const float* bdn; bool dry; int nT0; PG8_LAS unsigned char* elds;
    __device__ __forceinline__ void stage(const Unit& u, PG8_LAS unsigned char* dst, int lane) const {
        const int mp = MOE_MP(u.pm); const float* src = bdn + (size_t)tile_e[mp] * 1024 + u.pn * 256 + lane * 4;
        __builtin_amdgcn_global_load_lds((const unsigned*)src, (PG8_LAS unsigned*)dst, 16, 0, 0); }
    __device__ __forceinline__ void operator()(EPI_ARGS) const {
        const int mp = MOE_MP(u.pm); const int col0 = u.pn * 256 + wc * 64 + 16 * fq; const PG8_LAS float* bb = (const PG8_LAS float*)(elds + u.par * 2048) + wc * 64 + 16 * fq;
        f32x4 bv[2][2];
#pragma unroll
        for (int bj = 0; bj < 2; ++bj)
#pragma unroll
            for (int n = 0; n < 2; ++n) bv[bj][n] = *(const PG8_LAS f32x4*)(bb + bj * 8 + 4 * n);
#pragma unroll
        for (int ai = 0; ai < 2; ++ai)
#pragma unroll
            for (int m = 0; m < 4; ++m) { unsigned char* rowp = Y + (size_t)(mp * 256 + ai * 128 + wr * 64 + m * 16 + fr) * 1024 + col0; u32x4 pk;
#pragma unroll
                for (int bj = 0; bj < 2; ++bj) { const f32x4 v0 = acc[ai][bj][m][0] + bv[bj][0], v1 = acc[ai][bj][m][1] + bv[bj][1];
                    pk[2 * bj] = pk4_fp8(v0[0], v0[1], v0[2], v0[3]); pk[2 * bj + 1] = pk4_fp8(v1[0], v1[1], v1[2], v1[3]); }
                *(u32x4*)rowp = pk; }
    } };
#undef EPI_ARGS
#undef MOE_MP
}
constexpr int NWAVES = 8;
constexpr int NB = 16, SEQ = 4096, D = 1024, T = NB * SEQ;
constexpr int NMEM = 256, NE = 32, TOPK = 4;
constexpr float EPS = 1e-6f;
constexpr float LOG2E = 1.4426950408889634f;
constexpr float QD_SCALE = 0.125f * LOG2E;
constexpr float XS_SCALE = 0.0625f * LOG2E;
constexpr float LAM_INIT = 0.2f;

constexpr size_t MiB = 1u << 20;
constexpr size_t WS_CTL = 0, CTL_ZERO_BYTES = 1 * MiB;
constexpr size_t WS_RS0 = 1 * MiB;
constexpr size_t WS_RS1 = 1 * MiB + 256 * 1024;
constexpr size_t WS_RS2 = 1 * MiB + 512 * 1024;
constexpr size_t WS_MISC = 1 * MiB + 768 * 1024;
constexpr size_t WS_IF = 2 * MiB;
constexpr size_t WS_SS1 = 4 * MiB;
constexpr size_t WS_PSUM = 12 * MiB;
constexpr size_t WS_TOPI = 16 * MiB, WS_TOPW = 17 * MiB, WS_SLOT = 18 * MiB;
constexpr size_t WS_TOKL = 19 * MiB;
constexpr size_t WS_RSS = 20 * MiB + 512 * 1024;
constexpr int HSLOTS = 139264, HTILES = 544;
constexpr size_t WS_WGT = 22 * MiB;
constexpr size_t WS_WIN = 24 * MiB;
constexpr size_t WS_WBM = 40 * MiB, WS_WBD = 42 * MiB, WS_WOUT = 44 * MiB, WS_WQG = 46 * MiB, WS_WKV = 48 * MiB, WS_WO = 52 * MiB;
constexpr size_t WS_MEMN = 54 * MiB;
constexpr size_t WS_B0 = 64 * MiB, BUF = 128 * MiB;
constexpr size_t WS_B1 = WS_B0 + BUF, WS_B2 = WS_B0 + 2 * BUF, WS_B3 = WS_B0 + 3 * BUF, WS_B4 = WS_B0 + 4 * BUF, WS_B5 = WS_B0 + 5 * BUF;
constexpr size_t WS_KV = WS_WIN, WS_WPT = WS_B5 + 16 * MiB, WS_VPT = WS_B5 + 48 * MiB;
constexpr size_t WS_H = WS_B1;
constexpr size_t WS_X2Q = 896 * MiB;
constexpr size_t WS_XQ = 896 * MiB;
constexpr size_t WS_WIN8 = 992 * MiB;
constexpr int SC_P = 0x77777777, SC_V = 0x7a7a7a7a;
constexpr size_t WS_X1Q = WS_B4;
constexpr int SC_ONE = 0x7f7f7f7f, SC_W = 0x78787878;
constexpr size_t WS_Y = WS_B1 + 272 * MiB;
constexpr size_t WS_WGU = 832 * MiB, WS_WDN = 960 * MiB, WS_END = 1024 * MiB;
static_assert(WS_Y + 272 * MiB <= WS_WGU, "map"); static_assert(HTILES == 544, "MOE_HTILES");

constexpr int CW_TMO = 0, CW_CODE = 1, CW_BAR = 4096, CW_Q = 8192;

constexpr int RING_OFF = 0, RING_BYTES = 131072;
constexpr int LDS_BYTES = 163840;
constexpr int MISC_OFF = LDS_BYTES - 512;

#define GAS __attribute__((address_space(1)))
#define LAS __attribute__((address_space(3)))
typedef unsigned short bf16;
typedef unsigned v4u __attribute__((ext_vector_type(4)));
typedef unsigned v2u __attribute__((ext_vector_type(2)));
typedef float f32x4 __attribute__((ext_vector_type(4)));
typedef GAS unsigned gu32;
#define RLX_AGENT __ATOMIC_RELAXED, __HIP_MEMORY_SCOPE_AGENT
#define LDS_WAIT() asm volatile("s_waitcnt lgkmcnt(0)" ::: "memory")
#define VM_WAIT() asm volatile("s_waitcnt vmcnt(0)" ::: "memory")
__device__ __forceinline__ unsigned pk2(float lo, float hi) { return pg8::cvt_pk_bf16(lo, hi); }
__device__ __forceinline__ float bf2f(bf16 v) { return __uint_as_float((unsigned)v << 16); }

#define XB_TMO      128
#define XB_XCNT(j)  (256  + 64 * (j))
#define XB_XSUB(j)  (1280 + 64 * (j))
#define XB_XGEN(j)  (2304 + 64 * (j))
#define XB_TOP      3328
#define XB_TOPGEN   3392
#define XCD_BAR_WORDS 3456
#define XB_SPIN_CAP (1u << 22)
__device__ __forceinline__ unsigned xb_ld(unsigned* p)              { return __hip_atomic_load(p, __ATOMIC_RELAXED, __HIP_MEMORY_SCOPE_AGENT); }
__device__ __forceinline__ unsigned xb_add(unsigned* p, unsigned v) { return __hip_atomic_fetch_add(p, v, __ATOMIC_RELAXED, __HIP_MEMORY_SCOPE_AGENT); }
__device__ __forceinline__ unsigned xb_xcc_id() { return (unsigned)__builtin_amdgcn_s_getreg((3 << 11) | 20) & 0xFu; }
#define XB_SPIN(cond, bar) do { unsigned _sp = 0; while (cond) { __builtin_amdgcn_s_sleep(1); \
    if ((++_sp & 255u) == 0u) { if (xb_ld(&(bar)[XB_TMO])) break; if (_sp > XB_SPIN_CAP) { atomicAdd(&(bar)[XB_TMO], 1u); break; } } } } while (0)
struct XcdBarrier { unsigned* bar; unsigned x; volatile LAS unsigned* st; };
__device__ __forceinline__ XcdBarrier xcd_barrier_post(unsigned* bar, volatile LAS unsigned* st) {
    XcdBarrier b; b.bar = bar; b.x = xb_xcc_id(); b.st = st;
    if (threadIdx.x == 0) (void)xb_add(&bar[XB_XCNT(b.x)], 1u);
    return b;
}
__device__ __forceinline__ void xcd_barrier_complete(unsigned* bar, unsigned x, unsigned& nloc, unsigned& nx) {
    const unsigned G = gridDim.x * gridDim.y * gridDim.z;
    unsigned sum, cnt, mine, sp = 0u;
    for (;;) {
        sum = 0u; cnt = 0u; mine = 0u;
#pragma unroll
        for (unsigned j = 0; j < 16; ++j) { const unsigned c = xb_ld(&bar[XB_XCNT(j)]); sum += c; cnt += (c > 0u) ? 1u : 0u; mine = (j == x) ? c : mine; }
        if (sum == G) break;
        __builtin_amdgcn_s_sleep(1);
        if ((++sp & 255u) == 0u) { if (xb_ld(&bar[XB_TMO])) break; if (sp > XB_SPIN_CAP) { atomicAdd(&bar[XB_TMO], 1u); break; } }
    }
    nloc = mine > 0u ? mine : 1u; nx = cnt > 0u ? cnt : 1u;
}
#ifdef SIMPLE_BARRIER
__device__ __forceinline__ void xcd_barrier(const XcdBarrier& b) {
    asm volatile("s_waitcnt vmcnt(0)" ::: "memory");
    __syncthreads();
    if (threadIdx.x == 0) {
        unsigned* bar = b.bar;
        const unsigned n = ++b.st[2];
        __builtin_amdgcn_fence(__ATOMIC_RELEASE, "agent");
        asm volatile("s_waitcnt vmcnt(0)" ::: "memory");
        xb_add(&bar[XB_TOP], 1u);
        const unsigned want = n * (gridDim.x);
        unsigned sp = 0; while (xb_ld(&bar[XB_TOP]) < want) { __builtin_amdgcn_s_sleep(2); if (++sp > (1u << 24)) break; }
        __builtin_amdgcn_fence(__ATOMIC_ACQUIRE, "agent");
        asm volatile("s_waitcnt vmcnt(0)" ::: "memory");
    }
    __syncthreads();
}
#else
__device__ __forceinline__ void xcd_barrier(const XcdBarrier& b) {
    asm volatile("s_waitcnt vmcnt(0)" ::: "memory");
    __syncthreads();
    if (threadIdx.x == 0) {
        unsigned* bar = b.bar;
        __builtin_amdgcn_s_waitcnt(0);
        unsigned nloc = b.st[0], nx = b.st[1];
        if (nloc == 0u) { xcd_barrier_complete(bar, b.x, nloc, nx); b.st[0] = nloc; b.st[1] = nx; }
        const unsigned old = xb_add(&bar[XB_XSUB(b.x)], 1u);
        const unsigned gen = old / nloc;
        if (old + 1u == (gen + 1u) * nloc) {
            __builtin_amdgcn_fence(__ATOMIC_RELEASE, "agent");
            asm volatile("s_waitcnt vmcnt(0)" ::: "memory");
            const unsigned og = xb_add(&bar[XB_TOP], 1u);
            const unsigned tg = og / nx;
            if (og + 1u == (tg + 1u) * nx) xb_add(&bar[XB_TOPGEN], 1u);
            else XB_SPIN(xb_ld(&bar[XB_TOPGEN]) == tg, bar);
            __builtin_amdgcn_fence(__ATOMIC_ACQUIRE, "agent");
            xb_add(&bar[XB_XGEN(b.x)], 1u);
            asm volatile("s_waitcnt vmcnt(0)" ::: "memory");
        } else {
            XB_SPIN(xb_ld(&bar[XB_XGEN(b.x)]) == gen, bar);
            __builtin_amdgcn_fence(__ATOMIC_ACQUIRE, "agent");
            asm volatile("s_waitcnt vmcnt(0)" ::: "memory");
        }
    }
    __syncthreads();
}
#endif

enum { I_X = 0, I_MEM, I_NORM_MIX, I_W_IN, I_CONV_W, I_B_IF, I_MGAIN, I_DLAM, I_DGAIN, I_W_BM, I_W_BD, I_B_GATE, I_W_OUT, I_NORM_XATTN, I_NORM_MEM, I_WQ, I_WKV, I_WO,
       I_NORM_FFN, I_W_R, I_B_R, I_W_GU, I_B_GU, I_W_DN, I_B_DN, I_NORM_FINAL, N_INPUTS };
struct Args { const float* in[N_INPUTS]; float* out; unsigned char* ws; int ph_lo, ph_hi; };

__device__ __forceinline__ float wave_sum(float v) {
#pragma unroll
    for (int o = 1; o < 64; o <<= 1) v += __shfl_xor(v, o);
    return v;
}
#ifndef EXPERT_SLICES
#define EXPERT_SLICES 4
#endif
namespace att6 {
using bf16x8=__attribute__((ext_vector_type(8)))short;
using s16x4=__attribute__((ext_vector_type(4)))short;
using f32x16=__attribute__((ext_vector_type(16)))float;
using u32x4=__attribute__((ext_vector_type(4)))unsigned;
typedef short v4i16_t __attribute__((ext_vector_type(4)));
typedef float f32x2_t __attribute__((ext_vector_type(2))); typedef __bf16 bf16x2_t __attribute__((ext_vector_type(2)));
#define A6_LAS __attribute__((address_space(3)))
typedef A6_LAS const char* lds_cptr;
typedef A6_LAS char* lds_ptr;
constexpr int SEQ=4096,DM=1024,QB=256,KVBLK=64;
constexpr int KSLOT=8192,VSLOT=16384,PSLOT=32768;
constexpr int L_K=0,L_V=3*KSLOT,L_P=L_V+3*VSLOT,L_F=L_P+2*PSLOT,L_FL=L_F+2*1024,L_L=L_FL+64,L_BYTES=L_L+1024;
__device__ __forceinline__ int crow(int r,int hi){return (r&3)+8*(r>>2)+4*hi;}
__device__ __forceinline__ unsigned cvtpk(float lo,float hi){f32x2_t v={lo,hi};bf16x2_t b=__builtin_convertvector(v,bf16x2_t);return __builtin_bit_cast(unsigned,b);}
__device__ __forceinline__ void glds16(const void*gsrc,unsigned lds_dst){unsigned keep;
  asm volatile("s_mov_b32 %0, m0\n\ts_mov_b32 m0, %2\n\ts_nop 0\n\tglobal_load_lds_dwordx4 %1, off\n\ts_mov_b32 m0, %0":"=&s"(keep):"v"(gsrc),"s"(lds_dst):"memory");}
__device__ __forceinline__ s16x4 vtr(lds_cptr p){ return __builtin_bit_cast(s16x4,__builtin_amdgcn_ds_read_tr16_b64_v4i16((A6_LAS v4i16_t*)p)); }
#define A6_WAIT_BAR(N) asm volatile("s_waitcnt vmcnt(" #N ") lgkmcnt(0)\n\ts_barrier":::"memory")
#define A6_MFMA(a,b,c) __builtin_amdgcn_mfma_f32_32x32x16_bf16((a),(b),(c),0,0,0)

template<int THRL> __device__ __forceinline__ void prod_tile(const bf16x8(&kf)[8],const bf16x8(&qr)[4],f32x16&negm,float&mhat,float&l_reg,const bool first,const int hi,const int r32,const int lane,
                                                             lds_ptr pdst,A6_LAS float*fdst,A6_LAS unsigned*flg){
  f32x16 C0=A6_MFMA(kf[0],qr[0],negm),C1=A6_MFMA(kf[1],qr[0],negm);
  C0=A6_MFMA(kf[2],qr[1],C0);C1=A6_MFMA(kf[3],qr[1],C1);C0=A6_MFMA(kf[4],qr[2],C0);C1=A6_MFMA(kf[5],qr[2],C1);C0=A6_MFMA(kf[6],qr[3],C0);C1=A6_MFMA(kf[7],qr[3],C1);
  float ma=__builtin_fmaxf(__builtin_fmaxf(C0[0],C0[1]),C1[0]),mb=__builtin_fmaxf(__builtin_fmaxf(C0[2],C0[3]),C1[1]); ma=__builtin_fmaxf(__builtin_fmaxf(ma,C1[2]),C1[3]);
  #pragma unroll
  for(int r=4;r<16;r+=4){ma=__builtin_fmaxf(__builtin_fmaxf(ma,C0[r]),C0[r+1]);mb=__builtin_fmaxf(__builtin_fmaxf(mb,C0[r+2]),C0[r+3]);ma=__builtin_fmaxf(__builtin_fmaxf(ma,C1[r]),C1[r+1]);mb=__builtin_fmaxf(__builtin_fmaxf(mb,C1[r+2]),C1[r+3]);}
  float rm=__builtin_fmaxf(ma,mb);
  { auto rr=__builtin_amdgcn_permlane32_swap(__float_as_uint(rm),__float_as_uint(rm),false,false); rm=__builtin_fmaxf(__uint_as_float(rr[0]),__uint_as_float(rr[1])); }
  unsigned flag=0u;
  if(first||__any(rm>(float)THRL)){ const float dl=first?rm:__builtin_fmaxf(rm,0.f); mhat+=dl;
    #pragma unroll
    for(int r=0;r<16;++r){C0[r]-=dl;C1[r]-=dl;}
    #pragma unroll
    for(int r=0;r<16;++r)negm[r]=-mhat;
    if(!first){ const float f=__builtin_amdgcn_exp2f(-dl); l_reg*=f; if(hi==0)fdst[r32]=f; flag=1u; } }
  #pragma unroll
  for(int r=0;r<16;++r){C0[r]=__builtin_amdgcn_exp2f(C0[r]);C1[r]=__builtin_amdgcn_exp2f(C1[r]);}
  { float sa=C0[0]+C1[0],sb=C0[1]+C1[1];
    #pragma unroll
    for(int r=2;r<16;r+=2){sa+=C0[r];sb+=C0[r+1];asm volatile("":"+v"(sa),"+v"(sb));sa+=C1[r];sb+=C1[r+1];asm volatile("":"+v"(sa),"+v"(sb));}
    l_reg+=sa+sb; }
  *(A6_LAS u32x4*)(pdst)     =(u32x4){cvtpk(C0[0],C0[1]),cvtpk(C0[2],C0[3]),cvtpk(C0[4],C0[5]),cvtpk(C0[6],C0[7])};
  *(A6_LAS u32x4*)(pdst+1024)=(u32x4){cvtpk(C0[8],C0[9]),cvtpk(C0[10],C0[11]),cvtpk(C0[12],C0[13]),cvtpk(C0[14],C0[15])};
  *(A6_LAS u32x4*)(pdst+2048)=(u32x4){cvtpk(C1[0],C1[1]),cvtpk(C1[2],C1[3]),cvtpk(C1[4],C1[5]),cvtpk(C1[6],C1[7])};
  *(A6_LAS u32x4*)(pdst+3072)=(u32x4){cvtpk(C1[8],C1[9]),cvtpk(C1[10],C1[11]),cvtpk(C1[12],C1[13]),cvtpk(C1[14],C1[15])};
  if(lane==0)*flg=flag;
}
__device__ __forceinline__ void cons_epi(const f32x16(&o)[4],const int c,const float lam,const float*dgain,const int hi,const int r32,const int lane,A6_LAS const float*lb,A6_LAS unsigned short*os,
                                         unsigned char*pk,unsigned short*Orow,const bool dry){
  if(c==0){
    #pragma unroll
    for(int i=0;i<8;++i){ u32x4 w; const int r=2*i; const float r0=__builtin_amdgcn_rcpf(lb[crow(r,hi)]),r1=__builtin_amdgcn_rcpf(lb[crow(r+1,hi)]);
      #pragma unroll
      for(int j=0;j<4;++j) w[j]=cvtpk(o[j][r]*r0,o[j][r+1]*r1);
      *(u32x4*)(pk+i*1024+lane*16)=w; }
  } else {
    #pragma unroll
    for(int ih=0;ih<2;++ih){ u32x4 w[4];
      #pragma unroll
      for(int i=0;i<4;++i)w[i]=*(const u32x4*)(pk+(ih*4+i)*1024+lane*16);
      #pragma unroll
      for(int i=0;i<4;++i){ const int r=2*(ih*4+i); const float r0=lam*__builtin_amdgcn_rcpf(lb[crow(r,hi)]),r1=lam*__builtin_amdgcn_rcpf(lb[crow(r+1,hi)]);
        #pragma unroll
        for(int j=0;j<4;++j){
          const float p0=__uint_as_float(w[i][j]<<16),p1=__uint_as_float(w[i][j]&0xffff0000u);
          os[crow(r,hi)*128+j*32+r32]  =(unsigned short)(cvtpk(p0-o[j][r]*r0,0.f)&0xffffu);
          os[crow(r+1,hi)*128+j*32+r32]=(unsigned short)(cvtpk(p1-o[j][r+1]*r1,0.f)&0xffffu); } }
      asm volatile("":::"memory"); }
    asm volatile("s_waitcnt lgkmcnt(0)":::"memory");
    if(!dry){
      A6_LAS const unsigned short*src=os+r32*128+hi*64;
      u32x4 v[8]; float sq=0.f;
      #pragma unroll
      for(int i=0;i<8;++i){v[i]=*(A6_LAS const u32x4*)(src+i*8);
        #pragma unroll
        for(int j=0;j<4;++j){const float lo=__uint_as_float(v[i][j]<<16),hh=__uint_as_float(v[i][j]&0xffff0000u);sq+=lo*lo+hh*hh;}}
      {auto rr=__builtin_amdgcn_permlane32_swap(__float_as_uint(sq),__float_as_uint(sq),false,false);sq=__uint_as_float(rr[0])+__uint_as_float(rr[1]);}
      const float rn=1.0f/sqrtf(sq*(1.f/128.f)+1e-6f);
      unsigned short*Ow=Orow+(long)r32*DM+hi*64;
      #pragma unroll
      for(int i=0;i<8;++i){u32x4 ov;
        #pragma unroll
        for(int j=0;j<4;++j){const float lo=__uint_as_float(v[i][j]<<16)*rn,hh=__uint_as_float(v[i][j]&0xffff0000u)*rn;ov[j]=cvtpk(lo,hh);}
        *(u32x4*)(Ow+i*8)=ov;}
    }
  }
}

template<int THRL> __device__ __forceinline__ void unit(int b,int h8,int c,int qb,float lam,const float*dgain,const unsigned short*Q,const unsigned short*K,const unsigned short*V,unsigned short*O,char*shm,unsigned char*park,bool dry){
  int tid_=threadIdx.x; asm volatile("":"+v"(tid_));
  const int tid=tid_,lane=tid&63,r32=lane&31,hi=lane>>5; const int wid=__builtin_amdgcn_readfirstlane(tid>>6);
  const int pr=wid&3;
  const long rowbase=(long)b*SEQ; const int q0=qb*QB;
  const unsigned short*Kh=K+((long)(b*16+2*h8+c)*SEQ)*64,*Vh=V+((long)(b*8+h8)*SEQ)*128;
  const unsigned lds0=(unsigned)(uintptr_t)shm;
  const unsigned short*ksrc=Kh+(long)lane*64+wid*8;
  const unsigned short*vsrc=Vh+(long)(16*(wid&3)+(lane>>2))*128+(wid>>2)*32+(lane&3)*8;
  const unsigned kdst=lds0+L_K+wid*1024, vdst=lds0+L_V+wid*1024;
  #define A6_DMA_K(t,slot) glds16(ksrc+(long)(t)*tstr,(unsigned)__builtin_amdgcn_readfirstlane(kdst+(slot)*KSLOT))
  #define A6_DMA_V(t,slot) do{ const unsigned vs_=(unsigned)__builtin_amdgcn_readfirstlane(vdst+(slot)*VSLOT); glds16(vsrc+(long)(t)*2*tstr,vs_); glds16(vsrc+(long)(t)*2*tstr+64,vs_+8192u); }while(0)
  #define A6_STEP_WAIT(t) do{ if((t)+1<NT){A6_WAIT_BAR(3);}else if((t)+1==NT){A6_WAIT_BAR(2);}else{A6_WAIT_BAR(0);} }while(0)
  #define A6_STEP_DMA(t) do{ if((t)+2<NT)A6_DMA_K((t)+2,s2); if((t)+1<NT)A6_DMA_V((t)+1,s1); }while(0)
#ifdef PROBE_DMA_TILE0
  const long tstr=dry?0:(long)KVBLK*64;
#else
  const long tstr=(long)KVBLK*64;
#endif
  const lds_cptr shm3=(lds_cptr)shm;
  const int NT=(q0+QB)/KVBLK;
  A6_DMA_K(0,0); A6_DMA_K(1,1); A6_DMA_V(0,0);
  int s0=0,s1=1,s2=2;
  if(wid<4){
#ifdef A6_PROD_PRIO
    __builtin_amdgcn_s_setprio(A6_PROD_PRIO);
#endif
    const unsigned short*Qw=Q+(rowbase+q0+pr*64)*DM+(2*h8+c)*64;
    bf16x8 qa[4],qc[4];
    #pragma unroll
    for(int d0=0;d0<4;++d0){qa[d0]=*reinterpret_cast<const bf16x8*>(&Qw[(long)r32*DM+d0*16+hi*8]);qc[d0]=*reinterpret_cast<const bf16x8*>(&Qw[(long)(32+r32)*DM+d0*16+hi*8]);}
    float mh0=0.f,mh1=0.f,l0=0.f,l1=0.f; f32x16 ng0,ng1;
    #pragma unroll
    for(int r=0;r<16;++r){ng0[r]=0.f;ng1[r]=0.f;}
    const lds_cptr kp0=shm3+L_K+hi*1024+r32*16;
    const lds_ptr pd0=(lds_ptr)shm3+L_P+(2*pr)*4096+lane*16;
    A6_LAS float*const fd0=(A6_LAS float*)((lds_ptr)shm3+L_F)+(2*pr)*32;
    A6_LAS unsigned*const fl0=(A6_LAS unsigned*)((lds_ptr)shm3+L_FL)+2*pr;
    for(int t=0;t<=NT;++t){
      A6_STEP_WAIT(t);
      A6_STEP_DMA(t);
      if(t<NT){
        if(t-(NT-4)<=pr){
          const int ps=t&1; const lds_cptr kp=kp0+s0*KSLOT; bf16x8 kf[8];
          #pragma unroll
          for(int j=0;j<4;++j){kf[2*j]=*(A6_LAS const bf16x8*)(kp+j*2048);kf[2*j+1]=*(A6_LAS const bf16x8*)(kp+j*2048+512);}
          prod_tile<THRL>(kf,qa,ng0,mh0,l0,t==0,hi,r32,lane,pd0+ps*PSLOT,fd0+ps*256,fl0+ps*8);
          prod_tile<THRL>(kf,qc,ng1,mh1,l1,t==0,hi,r32,lane,pd0+ps*PSLOT+4096,fd0+ps*256+32,fl0+ps*8+1);
        }
        if(t==NT-1){
          {auto rr=__builtin_amdgcn_permlane32_swap(__float_as_uint(l0),__float_as_uint(l0),false,false);l0=__uint_as_float(rr[0])+__uint_as_float(rr[1]);}
          {auto rr=__builtin_amdgcn_permlane32_swap(__float_as_uint(l1),__float_as_uint(l1),false,false);l1=__uint_as_float(rr[0])+__uint_as_float(rr[1]);}
          A6_LAS float*lb=(A6_LAS float*)((lds_ptr)shm3+L_L)+(2*pr)*32;
          if(hi==0){lb[r32]=l0;lb[32+r32]=l1;} }
      }
      { const int x=s0; s0=s1; s1=s2; s2=x; }
    }
  } else {
#ifdef A6_CONS_PRIO
    __builtin_amdgcn_s_setprio(A6_CONS_PRIO);
#endif
    f32x16 oa[4],ob[4];
    #pragma unroll
    for(int d=0;d<4;++d)
      #pragma unroll
      for(int r=0;r<16;++r){oa[d][r]=0.f;ob[d][r]=0.f;}
    const lds_cptr vp0=shm3+L_V+((lane>>4)&1)*32+(lane&3)*8+(4*hi+((lane&15)>>2))*64;
    const lds_cptr ps0=shm3+L_P+(2*pr)*4096+lane*16;
    A6_LAS const float*const fs0=(A6_LAS const float*)(shm3+L_F)+(2*pr)*32;
    A6_LAS const unsigned*const fl0=(A6_LAS const unsigned*)(shm3+L_FL)+2*pr;
    int sp=0;
    for(int t=0;t<=NT;++t){
      A6_STEP_WAIT(t);
      A6_STEP_DMA(t);
      if(t>=1){
        const int tt=t-1;
        if(tt-(NT-4)<=pr){
          const int ps=tt&1;
          const unsigned f0=(unsigned)__builtin_amdgcn_readfirstlane((int)fl0[ps*8]),f1=(unsigned)__builtin_amdgcn_readfirstlane((int)fl0[ps*8+1]);
          if(f0){
            #pragma unroll
            for(int r=0;r<16;++r){const float f=fs0[ps*256+crow(r,hi)];
              #pragma unroll
              for(int d=0;d<4;++d)oa[d][r]*=f;} }
          if(f1){
            #pragma unroll
            for(int r=0;r<16;++r){const float f=fs0[ps*256+32+crow(r,hi)];
              #pragma unroll
              for(int d=0;d<4;++d)ob[d][r]*=f;} }
          bf16x8 pa[4],pb[4];
          #pragma unroll
          for(int i=0;i<4;++i){pa[i]=*(A6_LAS const bf16x8*)(ps0+ps*PSLOT+i*1024);pb[i]=*(A6_LAS const bf16x8*)(ps0+ps*PSLOT+4096+i*1024);}
          const lds_cptr vp=vp0+sp*VSLOT;
          s16x4 vlo[4],vhi[4];
          #define A6_VRD(i) do{ vlo[(i)&3]=vtr(vp+(((i)&3)*4+((i)>>2))*1024); vhi[(i)&3]=vtr(vp+(((i)&3)*4+((i)>>2))*1024+512); }while(0)
          A6_VRD(0);A6_VRD(1);A6_VRD(2);A6_VRD(3); __builtin_amdgcn_sched_barrier(0);
          #pragma unroll
          for(int i=0;i<16;++i){ const int d=i&3,ks=i>>2;
            const bf16x8 vf=(bf16x8){vlo[d][0],vlo[d][1],vlo[d][2],vlo[d][3],vhi[d][0],vhi[d][1],vhi[d][2],vhi[d][3]};
            oa[d]=A6_MFMA(pa[ks],vf,oa[d]); ob[d]=A6_MFMA(pb[ks],vf,ob[d]);
            if(i+4<16)A6_VRD(i+4);
            __builtin_amdgcn_sched_barrier(0); }
          #undef A6_VRD
        }
        sp=(sp==2)?0:sp+1;
      }
      { const int x=s0; s0=s1; s1=s2; s2=x; }
    }
    { A6_LAS const float*lb=(A6_LAS const float*)(shm3+L_L)+(2*pr)*32;
      unsigned char*pk=park+(size_t)(blockIdx.x*8+2*pr)*8192;
      unsigned short*Or=O+(rowbase+q0+pr*64)*DM+h8*128;
      cons_epi(oa,c,lam,dgain,hi,r32,lane,lb,   (A6_LAS unsigned short*)((lds_ptr)shm3+L_P+pr*8192),      pk,     Or,             dry);
      cons_epi(ob,c,lam,dgain,hi,r32,lane,lb+32,(A6_LAS unsigned short*)((lds_ptr)shm3+L_P+PSLOT+pr*8192),pk+8192,Or+(long)32*DM,dry); }
  }
#if defined(A6_PROD_PRIO) || defined(A6_CONS_PRIO)
  __builtin_amdgcn_s_setprio(0);
#endif
  asm volatile("s_waitcnt lgkmcnt(0)\n\ts_barrier":::"memory");
  #undef A6_DMA_K
  #undef A6_DMA_V
  #undef A6_STEP_WAIT
  #undef A6_STEP_DMA
}
template<int THRL=8,class Between> __device__ __forceinline__ void phase(char*lds,const unsigned short*Q,const unsigned short*K,const unsigned short*V,unsigned short*O,unsigned*qhead,volatile __attribute__((address_space(3))) unsigned*qslot,float lam,const float*dgain,unsigned char*park,bool dry,const Between&between){
  const int x=blockIdx.x&7; unsigned*const qh=qhead+x*64; int nun=0;
  for(;;){
    if(threadIdx.x==0)*qslot=__hip_atomic_fetch_add(qh,1u,__ATOMIC_RELAXED,__HIP_MEMORY_SCOPE_AGENT);
    __syncthreads();
    const unsigned idx=*qslot;
    if(idx>=256u)break;
    between(nun++);
#ifndef A6_QG
#define A6_QG 2
#endif
    const int g4=(int)(idx>>(4+A6_QG)),j=(int)(idx&((16u<<A6_QG)-1u)),qb=15-(j>>A6_QG),b=(g4<<A6_QG)+(j&((1<<A6_QG)-1)),h8=x;
    for(int c=0;c<2;++c) unit<THRL>(b,h8,c,qb,lam,dgain,Q,K,V,O,lds,park,dry);
  }
  for(;nun<EXPERT_SLICES;)between(nun++);
}
#undef A6_WAIT_BAR
#undef A6_MFMA
#undef A6_LAS
}
namespace mls {
typedef short bf16x8 __attribute__((ext_vector_type(8)));
typedef short s16x4 __attribute__((ext_vector_type(4)));
typedef float f32x16 __attribute__((ext_vector_type(16)));
typedef float f32x4 __attribute__((ext_vector_type(4)));
typedef unsigned u32x4 __attribute__((ext_vector_type(4)));
typedef unsigned u32x2 __attribute__((ext_vector_type(2)));
typedef short v4i16_t __attribute__((ext_vector_type(4)));
typedef float f32x2_t __attribute__((ext_vector_type(2))); typedef __bf16 bf16x2_t __attribute__((ext_vector_type(2)));
#define MLS_LAS __attribute__((address_space(3)))
#define MLS_BAR() asm volatile("s_waitcnt lgkmcnt(0)\n\ts_barrier" ::: "memory")
#define MLS_MFMA(a, b, c) __builtin_amdgcn_mfma_f32_32x32x16_bf16((a), (b), (c), 0, 0, 0)
__device__ __forceinline__ int crow(int r, int hi) { return (r & 3) + 8 * (r >> 2) + 4 * hi; }
__device__ __forceinline__ unsigned off_b(unsigned row, unsigned ch) { return 256u * row + 16u * (ch ^ (((row & 3) << 2) | ((row >> 2) & 3))); }
__device__ __forceinline__ unsigned cvtpk(float lo, float hi) { f32x2_t v = {lo, hi}; bf16x2_t b = __builtin_convertvector(v, bf16x2_t); return __builtin_bit_cast(unsigned, b); }
__device__ __forceinline__ float bflo(unsigned w) { return __uint_as_float(w << 16); }
__device__ __forceinline__ float bfhi(unsigned w) { return __uint_as_float(w & 0xffff0000u); }
__device__ __forceinline__ bf16x8 row_frag(MLS_LAS const unsigned char* tile, int lane, int s) { return *(MLS_LAS const bf16x8*)(tile + off_b(lane & 31, 2 * s + (lane >> 5))); }
__device__ __forceinline__ bf16x8 tr_frag(MLS_LAS const unsigned char* tile, int lane, int c, int ks) {
    const unsigned h = lane >> 5, blk = (lane >> 4) & 1, q = (lane & 15) >> 2, p = lane & 3;
    const unsigned a0 = off_b(16 * ks + 8 * h + q, 4 * c + 2 * blk + (p >> 1)) + 8 * (p & 1), a1 = off_b(16 * ks + 8 * h + 4 + q, 4 * c + 2 * blk + (p >> 1)) + 8 * (p & 1);
    const s16x4 lo = __builtin_bit_cast(s16x4, __builtin_amdgcn_ds_read_tr16_b64_v4i16((MLS_LAS v4i16_t*)(tile + a0)));
    const s16x4 hi = __builtin_bit_cast(s16x4, __builtin_amdgcn_ds_read_tr16_b64_v4i16((MLS_LAS v4i16_t*)(tile + a1)));
    return (bf16x8){lo[0], lo[1], lo[2], lo[3], hi[0], hi[1], hi[2], hi[3]};
}
constexpr int L_QS = 0, L_KS = 16384, L_KW = 32768, L_VS = 49152, L_SP = 81920, L_HS = 90112, L_SM = 155648;
constexpr int G_A = 0, G_MM = 64, G_WI = 128, G_WK = 192, G_EI = 256, G_DEC = 320, G_STRIDE = 328, S_R0 = 656, S_R1 = 720, S_NQ = 784, S_NV = 848;
constexpr float LOG2E_ = 1.4426950408889634f;

__device__ __forceinline__ void gate_scan(MLS_LAS float* sm, const float lf, const float ig, int lane, int gb, float& m) {
    float b = lf;
#pragma unroll
    for (int o = 1; o < 64; o <<= 1) { const float v = __shfl_up(b, o); if (lane >= o) b += v; }
    const float a = ig - b; float am = a;
#pragma unroll
    for (int o = 1; o < 64; o <<= 1) { const float v = __shfl_up(am, o); if (lane >= o) am = fmaxf(am, v); }
    const float mm = fmaxf(m, am), mt = b + mm;
    const float blast = __shfl(b, 63), amall = __shfl(am, 63);
    const float mnew = blast + fmaxf(m, amall);
    MLS_LAS float* g = sm + gb * G_STRIDE;
    g[G_A + lane] = a; g[G_MM + lane] = mm; g[G_WI + lane] = expf(m - mm); g[G_WK + lane] = expf(blast + a - mnew); g[G_EI + lane] = expf(-mt);
    if (lane == 0) g[G_DEC] = expf(blast + m - mnew);
    m = mnew;
}

__device__ __forceinline__ void mlstm_unit(const unsigned short* QKM, unsigned short* VM, const float* IF, const float* convw, const float* mgain, MLS_LAS unsigned char* lds, int b, int h, bool dry = false) {
    int tid_ = threadIdx.x; asm volatile("" : "+v"(tid_));
    const int tid0 = tid_, w = __builtin_amdgcn_readfirstlane(tid0 >> 6);
    MLS_LAS float* sm = (MLS_LAS float*)(lds + L_SM);
    MLS_LAS float* hs = (MLS_LAS float*)(lds + L_HS);
    f32x16 CT[4];
#pragma unroll
    for (int j = 0; j < 4; ++j)
#pragma unroll
        for (int i = 0; i < 16; ++i) CT[j][i] = 0.f;
    if (tid0 < 128) sm[S_NV + tid0] = 0.f;
    float mrun = 0.f;
    float nlf = 0.f, nig = 0.f;
    if (w == 3) { const size_t tk = (size_t)b * SEQ + (tid0 & 63); gate_scan(sm, IF[tk * 8 + 4 + h], IF[tk * 8 + h], tid0 & 63, 0, mrun); nlf = IF[(tk + 64) * 8 + 4 + h]; nig = IF[(tk + 64) * 8 + h]; }
    __syncthreads();
    u32x4 pq[7], pv[4];
#define MLS_PREFETCH(CH) do { int tidp = tid0; asm volatile("" : "+v"(tidp)); const int cgp = tidp & 15, whp = (tidp >> 4) & 1, rbp = tidp >> 5; const int chnp = whp * 512 + h * 128 + cgp * 8; \
        _Pragma("unroll") for (int rr = 0; rr < 7; ++rr) { const int t = (CH) * 64 + rbp * 4 + rr - 3; pq[rr] = (u32x4){0u, 0u, 0u, 0u}; if (t >= 0) pq[rr] = *(const u32x4*)(QKM + ((size_t)b * SEQ + t) * 1024 + chnp); } \
        _Pragma("unroll") for (int i = 0; i < 4; ++i) { const int idx = tidp + 512 * i, s = idx >> 5, c8 = idx & 31; pv[i] = *(const u32x4*)(VM + ((size_t)b * SEQ + (CH) * 64 + s) * 1024 + h * 256 + c8 * 8); } } while (0)
    MLS_PREFETCH(0);
    for (int ch = 0; ch < SEQ / 64; ++ch) {
        const size_t tok0 = (size_t)b * SEQ + ch * 64; const int gb = ch & 1;
        MLS_LAS const float* g = sm + gb * G_STRIDE;
#define MLS_FRESH() int tid = tid0; asm volatile("" : "+v"(tid)); const int lane = tid & 63, hi = lane >> 5, r32 = lane & 31; (void)hi; (void)r32
        { MLS_FRESH(); const int cg = tid & 15, which = (tid >> 4) & 1, rb = tid >> 5; const int chn0 = which * 512 + h * 128 + cg * 8;
          float cwv[4][8];
#pragma unroll
          for (int j = 0; j < 4; ++j) { const f32x4 c0 = *(const f32x4*)(convw + j * 1024 + chn0), c1 = *(const f32x4*)(convw + j * 1024 + chn0 + 4);
              cwv[j][0] = c0[0]; cwv[j][1] = c0[1]; cwv[j][2] = c0[2]; cwv[j][3] = c0[3]; cwv[j][4] = c1[0]; cwv[j][5] = c1[1]; cwv[j][6] = c1[2]; cwv[j][7] = c1[3]; }
          float xr[7][8];
#pragma unroll
          for (int rr = 0; rr < 7; ++rr) { const u32x4 wv = pq[rr];
              xr[rr][0] = bflo(wv[0]); xr[rr][1] = bfhi(wv[0]); xr[rr][2] = bflo(wv[1]); xr[rr][3] = bfhi(wv[1]); xr[rr][4] = bflo(wv[2]); xr[rr][5] = bfhi(wv[2]); xr[rr][6] = bflo(wv[3]); xr[rr][7] = bfhi(wv[3]); }
#pragma unroll
          for (int r = 0; r < 4; ++r) { const int t = rb * 4 + r; float o[8];
#pragma unroll
              for (int e = 0; e < 8; ++e) { const float cv = cwv[0][e] * xr[r][e] + cwv[1][e] * xr[r + 1][e] + cwv[2][e] * xr[r + 2][e] + cwv[3][e] * xr[r + 3][e];
                  o[e] = cv * __builtin_amdgcn_rcpf(1.0f + __builtin_amdgcn_exp2f(-LOG2E_ * cv)); }
              const unsigned ob = (unsigned)(t >> 5) * 8192u + off_b(t & 31, cg);
              if (which == 0) { const float sc = 0.08838834764831845f;
                  *(MLS_LAS u32x4*)(lds + L_QS + ob) = (u32x4){cvtpk(o[0] * sc, o[1] * sc), cvtpk(o[2] * sc, o[3] * sc), cvtpk(o[4] * sc, o[5] * sc), cvtpk(o[6] * sc, o[7] * sc)};
              } else { const float wkv = g[G_WK + t];
                  *(MLS_LAS u32x4*)(lds + L_KS + ob) = (u32x4){cvtpk(o[0], o[1]), cvtpk(o[2], o[3]), cvtpk(o[4], o[5]), cvtpk(o[6], o[7])};
                  *(MLS_LAS u32x4*)(lds + L_KW + ob) = (u32x4){cvtpk(o[0] * wkv, o[1] * wkv), cvtpk(o[2] * wkv, o[3] * wkv), cvtpk(o[4] * wkv, o[5] * wkv), cvtpk(o[6] * wkv, o[7] * wkv)}; } }
#pragma unroll
          for (int i = 0; i < 4; ++i) { const int idx = tid + 512 * i, s = idx >> 5, c8 = idx & 31;
              const u32x4 vv = pv[i];
              *(MLS_LAS u32x4*)(lds + L_VS + (unsigned)((s >> 5) * 2 + (c8 >> 4)) * 8192u + off_b(s & 31, c8 & 15)) = vv; } }
        MLS_BAR();
        { MLS_FRESH();
        if (w < 3) { const int sb = (w == 2) ? 1 : 0, tb = (w == 0) ? 0 : 1;
            f32x16 acc;
#pragma unroll
            for (int i = 0; i < 16; ++i) acc[i] = 0.f;
#pragma unroll
            for (int kk = 0; kk < 8; ++kk) acc = MLS_MFMA(row_frag(lds + L_KS + sb * 8192, lane, kk), row_frag(lds + L_QS + tb * 8192, lane, kk), acc);
            const int t = 32 * tb + r32; const float mmv = g[G_MM + t]; float rsum = 0.f;
#pragma unroll
            for (int gq = 0; gq < 4; ++gq) { float v4[4];
#pragma unroll
                for (int e = 0; e < 4; ++e) { const int s = 32 * sb + 8 * gq + 4 * hi + e; const float dv = __builtin_amdgcn_exp2f((g[G_A + s] - mmv) * LOG2E_);
                    v4[e] = (s <= t) ? acc[4 * gq + e] * dv : 0.f; rsum += v4[e]; }
                *(MLS_LAS u32x2*)(lds + L_SP + t * 128 + (((4 * sb + gq) ^ (t & 7)) << 4) + 8 * hi) = (u32x2){cvtpk(v4[0], v4[1]), cvtpk(v4[2], v4[3])}; }
            { auto rr = __builtin_amdgcn_permlane32_swap(__float_as_uint(rsum), __float_as_uint(rsum), false, false); rsum = __uint_as_float(rr[0]) + __uint_as_float(rr[1]); }
            if (hi == 0) sm[(sb ? S_R1 : S_R0) + t] = rsum;
        } else if (w == 3) {
            if (lane < 32) sm[S_R1 + lane] = 0.f;
            if (ch + 1 < SEQ / 64) { gate_scan(sm, nlf, nig, lane, gb ^ 1, mrun);
                if (ch + 2 < SEQ / 64) { nlf = IF[(tok0 + 128 + lane) * 8 + 4 + h]; nig = IF[(tok0 + 128 + lane) * 8 + h]; } }
        } else { const int u = tid - 256, t = u >> 2, p = u & 3; float acc = 0.f;
#pragma unroll
            for (int j = 0; j < 4; ++j) { const u32x4 qw = *(MLS_LAS const u32x4*)(lds + L_QS + (t >> 5) * 8192 + off_b(t & 31, 4 * p + j)); MLS_LAS const float* nv = sm + S_NV + 32 * p + 8 * j;
                acc += (bflo(qw[0]) * nv[0] + bfhi(qw[0]) * nv[1]) + (bflo(qw[1]) * nv[2] + bfhi(qw[1]) * nv[3]) + (bflo(qw[2]) * nv[4] + bfhi(qw[2]) * nv[5]) + (bflo(qw[3]) * nv[6] + bfhi(qw[3]) * nv[7]); }
            acc += __shfl_xor(acc, 1); acc += __shfl_xor(acc, 2);
            if (p == 0) sm[S_NQ + t] = acc; } }
        MLS_BAR();
        if (ch + 1 < SEQ / 64) MLS_PREFETCH(ch + 1);
        { MLS_FRESH(); f32x16 H0, H1;
#pragma unroll
          for (int i = 0; i < 16; ++i) { H0[i] = 0.f; H1[i] = 0.f; }
#pragma unroll
          for (int jb = 0; jb < 4; ++jb)
#pragma unroll
              for (int u = 0; u < 2; ++u) {
                  const bf16x8 Bf = __builtin_bit_cast(bf16x8, (u32x4){cvtpk(CT[jb][8 * u], CT[jb][8 * u + 1]), cvtpk(CT[jb][8 * u + 2], CT[jb][8 * u + 3]), cvtpk(CT[jb][8 * u + 4], CT[jb][8 * u + 5]), cvtpk(CT[jb][8 * u + 6], CT[jb][8 * u + 7])});
                  const unsigned a0 = off_b(r32, 4 * jb + 2 * u) + 8 * hi, a1 = off_b(r32, 4 * jb + 2 * u + 1) + 8 * hi;
                  const u32x2 p00 = *(MLS_LAS const u32x2*)(lds + L_QS + a0), p01 = *(MLS_LAS const u32x2*)(lds + L_QS + a1), p10 = *(MLS_LAS const u32x2*)(lds + L_QS + 8192 + a0), p11 = *(MLS_LAS const u32x2*)(lds + L_QS + 8192 + a1);
                  H0 = MLS_MFMA(__builtin_bit_cast(bf16x8, (u32x4){p00[0], p00[1], p01[0], p01[1]}), Bf, H0);
                  H1 = MLS_MFMA(__builtin_bit_cast(bf16x8, (u32x4){p10[0], p10[1], p11[0], p11[1]}), Bf, H1); }
#pragma unroll
          for (int i = 0; i < 16; ++i) { H0[i] *= g[G_WI + crow(i, hi)]; H1[i] *= g[G_WI + 32 + crow(i, hi)]; }
          bf16x8 Vf[2][2];
#pragma unroll
          for (int sh = 0; sh < 2; ++sh)
#pragma unroll
              for (int ks = 0; ks < 2; ++ks) Vf[sh][ks] = tr_frag(lds + L_VS + (sh * 2 + (w >> 2)) * 8192, lane, w & 3, ks);
#pragma unroll
          for (int u = 0; u < 2; ++u) {
              const bf16x8 s00 = *(MLS_LAS const bf16x8*)(lds + L_SP + r32 * 128 + (((2 * u + hi) ^ (r32 & 7)) << 4));
              const bf16x8 s10 = *(MLS_LAS const bf16x8*)(lds + L_SP + (32 + r32) * 128 + (((2 * u + hi) ^ (r32 & 7)) << 4));
              const bf16x8 s11 = *(MLS_LAS const bf16x8*)(lds + L_SP + (32 + r32) * 128 + (((4 + 2 * u + hi) ^ (r32 & 7)) << 4));
              H0 = MLS_MFMA(s00, Vf[0][u], H0); H1 = MLS_MFMA(s10, Vf[0][u], H1); H1 = MLS_MFMA(s11, Vf[1][u], H1); }
#pragma unroll
          for (int i = 0; i < 16; ++i) { hs[crow(i, hi) * 256 + 32 * w + r32] = H0[i]; hs[(32 + crow(i, hi)) * 256 + 32 * w + r32] = H1[i]; }
          const float decay = g[G_DEC];
#pragma unroll
          for (int jb = 0; jb < 4; ++jb) {
#pragma unroll
              for (int i = 0; i < 16; ++i) CT[jb][i] *= decay;
#pragma unroll
              for (int sh = 0; sh < 2; ++sh)
#pragma unroll
                  for (int ks = 0; ks < 2; ++ks) CT[jb] = MLS_MFMA(tr_frag(lds + L_KW + sh * 8192, lane, jb, ks), Vf[sh][ks], CT[jb]); }
          { const int dk = tid >> 2, p = tid & 3; float acc = 0.f;
#pragma unroll
            for (int e = 0; e < 16; ++e) { const int s = 16 * p + e; acc += __uint_as_float((unsigned)*(MLS_LAS const unsigned short*)(lds + L_KW + (s >> 5) * 8192 + off_b(s & 31, dk >> 3) + (dk & 7) * 2) << 16); }
            acc += __shfl_xor(acc, 1); acc += __shfl_xor(acc, 2);
            if (p == 0) sm[S_NV + dk] = decay * sm[S_NV + dk] + acc; } }
        MLS_BAR();
        { MLS_FRESH(); const int t = tid >> 3, seg = tid & 7;
          const float den = fmaxf(fabsf(sm[S_R0 + t] + sm[S_R1 + t] + g[G_WI + t] * sm[S_NQ + t]), g[G_EI + t]); const float inv = 1.0f / den;
          f32x4 v[8]; float sq = 0.f;
#pragma unroll
          for (int j = 0; j < 8; ++j) { v[j] = *(MLS_LAS const f32x4*)(hs + t * 256 + seg * 32 + j * 4) * inv; sq += (v[j][0] * v[j][0] + v[j][1] * v[j][1]) + (v[j][2] * v[j][2] + v[j][3] * v[j][3]); }
          sq += __shfl_xor(sq, 1); sq += __shfl_xor(sq, 2); sq += __shfl_xor(sq, 4);
          const float rn = 1.0f / sqrtf(sq * (1.f / 256.f) + 1e-6f);
          unsigned short* op = VM + (tok0 + t) * 1024 + h * 256 + seg * 32;
#pragma unroll
          for (int j = 0; j < 4; ++j) { const f32x4 a0 = v[2 * j] * rn, a1 = v[2 * j + 1] * rn;
              if (!dry) *(u32x4*)(op + 8 * j) = (u32x4){cvtpk(a0[0], a0[1]), cvtpk(a0[2], a0[3]), cvtpk(a1[0], a1[1]), cvtpk(a1[2], a1[3])}; } }
    }
    __syncthreads();
}
}
__device__ __forceinline__ void transpose_item(const float* W, int ldw, int k0, int n0, bf16* WT, int ldt, int drow0, const float* gain, LAS float* scr, int lane, int gmask = 0x7fffffff, float gscale = 1.0f) {
    const int rg = lane >> 3, c4 = lane & 7;
    f32x4 v[8];
#pragma unroll
    for (int i = 0; i < 8; ++i) v[i] = *(const f32x4*)(W + (size_t)(k0 + 8 * i + rg) * ldw + n0 + 4 * c4);
#pragma unroll
    for (int i = 0; i < 8; ++i) { const int kk = 8 * i + rg; const float g = gain ? gain[(k0 + kk) & gmask] * gscale : 1.0f; LAS float* d = scr + kk * 33 + 4 * c4; d[0] = v[i][0] * g; d[1] = v[i][1] * g; d[2] = v[i][2] * g; d[3] = v[i][3] * g; }
    LDS_WAIT(); asm volatile("" ::: "memory");
    const int c = lane & 7;
#pragma unroll
    for (int j = 0; j < 4; ++j) { const int n = (lane >> 3) + 8 * j; const LAS float* s = scr + (8 * c) * 33 + n;
        v4u o; o.x = pk2(s[0 * 33], s[1 * 33]); o.y = pk2(s[2 * 33], s[3 * 33]); o.z = pk2(s[4 * 33], s[5 * 33]); o.w = pk2(s[6 * 33], s[7 * 33]);
        *(v4u*)(WT + (size_t)(drow0 + n) * ldt + k0 + 8 * c) = o; }
    LDS_WAIT(); asm volatile("" ::: "memory");
}
__device__ __forceinline__ void transpose_item_f8(const float* W, int ldw, int k0, int n0, unsigned char* WT, int ldt, int drow0, const float* gain, LAS float* scr, int lane) {
    const int rg = lane >> 3, c4 = lane & 7;
    f32x4 v[8];
#pragma unroll
    for (int i = 0; i < 8; ++i) v[i] = *(const f32x4*)(W + (size_t)(k0 + 8 * i + rg) * ldw + n0 + 4 * c4);
#pragma unroll
    for (int i = 0; i < 8; ++i) { const int kk = 8 * i + rg; const float g = (gain ? gain[k0 + kk] : 1.0f) * 128.0f; LAS float* d = scr + kk * 33 + 4 * c4; d[0] = v[i][0] * g; d[1] = v[i][1] * g; d[2] = v[i][2] * g; d[3] = v[i][3] * g; }
    LDS_WAIT(); asm volatile("" ::: "memory");
    const int c = lane & 7;
#pragma unroll
    for (int j = 0; j < 4; ++j) { const int n = (lane >> 3) + 8 * j; const LAS float* s = scr + (8 * c) * 33 + n;
        v2u o; o.x = pg8::pk4_fp8(s[0 * 33], s[1 * 33], s[2 * 33], s[3 * 33]); o.y = pg8::pk4_fp8(s[4 * 33], s[5 * 33], s[6 * 33], s[7 * 33]);
        *(v2u*)(WT + (size_t)(drow0 + n) * ldt + k0 + 8 * c) = o; }
    LDS_WAIT(); asm volatile("" ::: "memory");
}
__device__ __forceinline__ int win_src_col(int drow0) {
    return drow0 < 2048 ? drow0 : drow0 < 3072 ? 3080 + (drow0 - 2048) : drow0 < 4096 ? 4104 + (drow0 - 3072) : drow0 < 5120 ? 5128 + (drow0 - 4096) : drow0 < 6144 ? 2048 + (drow0 - 5120) : 6152 + (drow0 - 6144);
}
__device__ __forceinline__ float log_sigmoid_(float x) { return x < 0.f ? x - log1pf(expf(x)) : -log1pf(expf(-x)); }

__device__ __forceinline__ void p0_expert_items(const Args& a, LAS unsigned char* lds, int lane, int wave, int part, int nparts) {
    unsigned char* ws = a.ws;
    LAS float* scr = (LAS float*)(lds + wave * 16384);
    constexpr int I_GU = 32 * 16 * 64, I_DN = 32 * 16 * 32;
    for (int it = part * NWAVES + wave; it < I_GU + I_DN; it += nparts * NWAVES) {
        int r = it;
        if (r < I_GU) { const int e = r >> 10, q = r & 1023, kb = q >> 6, nb = q & 63, n0 = 32 * nb;
            const int drow0 = n0 < 1024 ? (n0 >> 7) * 256 + (n0 & 127) : ((n0 - 1024) >> 7) * 256 + 128 + ((n0 - 1024) & 127);
            transpose_item_f8(a.in[I_W_GU] + (size_t)e * 1024 * 2048, 2048, 64 * kb, n0, (unsigned char*)(ws + WS_WGU) + (size_t)e * 2048 * 1024, 1024, drow0, a.in[I_NORM_FFN], scr, lane); continue; } r -= I_GU;
        { const int e = r >> 9, q = r & 511; transpose_item_f8(a.in[I_W_DN] + (size_t)e * 1024 * 1024, 1024, 64 * (q >> 5), 32 * (q & 31), (unsigned char*)(ws + WS_WDN) + (size_t)e * 1024 * 1024, 1024, 32 * (q & 31), nullptr, scr, lane); }
    }
}
__device__ __forceinline__ void phase_p0(const Args& a, LAS unsigned char* lds, int tid, int lane, int wave, int vcu, int G) {
    unsigned char* ws = a.ws;
    const int gw = vcu * NWAVES + wave, NGW = G * NWAVES;
    LAS float* scr = (LAS float*)(lds + wave * 16384);
    constexpr int I_IN = 16 * 256, I_SQ = 16 * 32, I_KV = 16 * 64, I_GU = 32 * 16 * 64, I_DN = 32 * 16 * 32;
#ifdef EXPERT_CONV_IN_ATT
    constexpr int NITEMS = I_IN + 4 * I_SQ + I_KV;
#else
    constexpr int NITEMS = I_IN + 4 * I_SQ + I_KV + I_GU + I_DN;
#endif
    for (int it = gw; it < NITEMS; it += NGW) {
        int r = it;
        if (r < I_IN) { const int kb = r >> 8, nb = r & 255; transpose_item(a.in[I_W_IN], 8200, 64 * kb, win_src_col(32 * nb), (bf16*)(ws + WS_WIN), 1024, 32 * nb, a.in[I_NORM_MIX], scr, lane);
            transpose_item_f8(a.in[I_W_IN], 8200, 64 * kb, win_src_col(32 * nb), (unsigned char*)(ws + WS_WIN8), 1024, 32 * nb, a.in[I_NORM_MIX], scr, lane); continue; } r -= I_IN;
        if (r < I_SQ) { transpose_item(a.in[I_W_BM], 1024, 64 * (r >> 5), 32 * (r & 31), (bf16*)(ws + WS_WBM), 1024, 32 * (r & 31), a.in[I_MGAIN], scr, lane); continue; }     r -= I_SQ;
        if (r < I_SQ) { transpose_item(a.in[I_W_BD], 1024, 64 * (r >> 5), 32 * (r & 31), (bf16*)(ws + WS_WBD), 1024, 32 * (r & 31), a.in[I_DGAIN], scr, lane, 127, 1.0f - LAM_INIT); continue; }     r -= I_SQ;
        if (r < I_SQ) { transpose_item(a.in[I_W_OUT], 1024, 64 * (r >> 5), 32 * (r & 31), (bf16*)(ws + WS_WOUT), 1024, 32 * (r & 31), nullptr, scr, lane); continue; } r -= I_SQ;
        if (r < I_SQ) { transpose_item(a.in[I_WO], 1024, 64 * (r >> 5), 32 * (r & 31), (bf16*)(ws + WS_WO), 1024, 32 * (r & 31), nullptr, scr, lane); continue; } r -= I_SQ;
        if (r < I_KV) { transpose_item(a.in[I_WKV], 2048, 64 * (r >> 6), 32 * (r & 63), (bf16*)(ws + WS_WKV), 1024, 32 * (r & 63), nullptr, scr, lane); continue; } r -= I_KV;
        if (r < I_GU) { const int e = r >> 10, q = r & 1023, kb = q >> 6, nb = q & 63, n0 = 32 * nb;
            const int drow0 = n0 < 1024 ? (n0 >> 7) * 256 + (n0 & 127) : ((n0 - 1024) >> 7) * 256 + 128 + ((n0 - 1024) & 127);
            transpose_item_f8(a.in[I_W_GU] + (size_t)e * 1024 * 2048, 2048, 64 * kb, n0, (unsigned char*)(ws + WS_WGU) + (size_t)e * 2048 * 1024, 1024, drow0, a.in[I_NORM_FFN], scr, lane); continue; } r -= I_GU;
        { const int e = r >> 9, q = r & 511; transpose_item_f8(a.in[I_W_DN] + (size_t)e * 1024 * 1024, 1024, 64 * (q >> 5), 32 * (q & 31), (unsigned char*)(ws + WS_WDN) + (size_t)e * 1024 * 1024, 1024, 32 * (q & 31), nullptr, scr, lane); }
    }
    for (int idx = (vcu * 512 + tid); idx < 1024 * 1024 / 4; idx += G * 512) { const int row = idx >> 8; const float g = a.in[I_NORM_XATTN][row];
        const f32x4 v = *(const f32x4*)(a.in[I_WQ] + (size_t)idx * 4); v2u o; o.x = pk2(v[0] * g, v[1] * g); o.y = pk2(v[2] * g, v[3] * g); *(v2u*)((bf16*)(ws + WS_WQG) + (size_t)idx * 4) = o; }
    for (int idx = (vcu * 512 + tid); idx < 32 * 1024; idx += G * 512) { const int e = idx >> 10, k = idx & 1023; ((float*)(ws + WS_WGT))[idx] = a.in[I_NORM_FFN][k] * a.in[I_W_R][k * 32 + e]; }
    __syncthreads();
    LAS float* wif = (LAS float*)lds;
    for (int idx = tid; idx < 8192; idx += 512) { const int j = idx & 7, k = idx >> 3; wif[j * 1024 + k] = a.in[I_NORM_MIX][k] * a.in[I_W_IN][(size_t)k * 8200 + 3072 + j]; }
    __syncthreads();
    for (int m0 = 2 * gw; m0 < T; m0 += 2 * NGW) {
        f32x4 v[2][4]; float s[2] = {0.f, 0.f}; float p[2][8];
#pragma unroll
        for (int q = 0; q < 2; ++q) { const f32x4* xr = (const f32x4*)(a.in[I_X] + (size_t)(m0 + q) * D) + 2 * lane;
#pragma unroll
            for (int j = 0; j < 4; ++j) v[q][j] = xr[128 * (j >> 1) + (j & 1)]; }
#pragma unroll
        for (int q = 0; q < 2; ++q) {
#pragma unroll
            for (int j = 0; j < 4; ++j) s[q] += (v[q][j][0] * v[q][j][0] + v[q][j][1] * v[q][j][1]) + (v[q][j][2] * v[q][j][2] + v[q][j][3] * v[q][j][3]);
#pragma unroll
            for (int g = 0; g < 8; ++g) { float pp = 0.f;
#pragma unroll
                for (int j = 0; j < 4; ++j) { const f32x4 w = *(const LAS f32x4*)(wif + g * 1024 + 8 * lane + 512 * (j >> 1) + 4 * (j & 1)); pp += (v[q][j][0] * w[0] + v[q][j][1] * w[1]) + (v[q][j][2] * w[2] + v[q][j][3] * w[3]); }
                p[q][g] = pp; } }
        float rs[2], gval[2];
#pragma unroll
        for (int q = 0; q < 2; ++q) { rs[q] = 1.0f / sqrtf(wave_sum(s[q]) * (1.f / D) + EPS);
            { v4u* o16 = (v4u*)((bf16*)(ws + WS_B0) + (size_t)(m0 + q) * D) + lane; const float r_ = rs[q];
#pragma unroll
              for (int jj = 0; jj < 2; ++jj) o16[64 * jj] = (v4u){pk2(v[q][2 * jj][0] * r_, v[q][2 * jj][1] * r_), pk2(v[q][2 * jj][2] * r_, v[q][2 * jj][3] * r_), pk2(v[q][2 * jj + 1][0] * r_, v[q][2 * jj + 1][1] * r_), pk2(v[q][2 * jj + 1][2] * r_, v[q][2 * jj + 1][3] * r_)};
              v2u* o8 = (v2u*)((unsigned char*)(ws + WS_XQ) + (size_t)(m0 + q) * D) + lane;
#pragma unroll
              for (int jj = 0; jj < 2; ++jj) o8[64 * jj] = (v2u){pg8::pk4_fp8(v[q][2 * jj][0] * r_, v[q][2 * jj][1] * r_, v[q][2 * jj][2] * r_, v[q][2 * jj][3] * r_), pg8::pk4_fp8(v[q][2 * jj + 1][0] * r_, v[q][2 * jj + 1][1] * r_, v[q][2 * jj + 1][2] * r_, v[q][2 * jj + 1][3] * r_)}; }
            float r4[4], r2[2], r1;
#pragma unroll
            for (int g = 0; g < 4; ++g) { const bool up = (lane & 32) != 0; const float send = up ? p[q][g] : p[q][g + 4], keep = up ? p[q][g + 4] : p[q][g]; r4[g] = keep + __shfl_xor(send, 32); }
#pragma unroll
            for (int g = 0; g < 2; ++g) { const bool up = (lane & 16) != 0; const float send = up ? r4[g] : r4[g + 2], keep = up ? r4[g + 2] : r4[g]; r2[g] = keep + __shfl_xor(send, 16); }
            { const bool up = (lane & 8) != 0; const float send = up ? r2[0] : r2[1], keep = up ? r2[1] : r2[0]; r1 = keep + __shfl_xor(send, 8); }
            r1 += __shfl_xor(r1, 4); r1 += __shfl_xor(r1, 2); r1 += __shfl_xor(r1, 1);
            gval[q] = r1; }
#pragma unroll
        for (int q = 0; q < 2; ++q) { const int g = ((lane >> 5) & 1) * 4 + ((lane >> 4) & 1) * 2 + ((lane >> 3) & 1);
            if ((lane & 7) == 0) { const float val = gval[q] * rs[q] + a.in[I_B_IF][g]; ((float*)(ws + WS_IF))[(size_t)(m0 + q) * 8 + g] = g < 4 ? val : log_sigmoid_(val); }
            if (lane == 0) ((float*)(ws + WS_RS0))[m0 + q] = rs[q]; }
    }
    for (int m = gw; m < NB * NMEM; m += NGW) {
        const f32x4* xr = (const f32x4*)(a.in[I_MEM] + (size_t)m * D) + lane; const f32x4* gr = (const f32x4*)a.in[I_NORM_MEM] + lane;
        f32x4 v[4]; float s = 0.f;
#pragma unroll
        for (int j = 0; j < 4; ++j) { v[j] = xr[64 * j]; s += (v[j][0] * v[j][0] + v[j][1] * v[j][1]) + (v[j][2] * v[j][2] + v[j][3] * v[j][3]); }
        const float rs = 1.0f / sqrtf(wave_sum(s) * (1.f / D) + EPS);
        unsigned long long* o8 = (unsigned long long*)((bf16*)(ws + WS_MEMN) + (size_t)m * D) + lane;
#pragma unroll
        for (int j = 0; j < 4; ++j) { const f32x4 g = gr[64 * j]; o8[64 * j] = (unsigned long long)pk2(v[j][0] * rs * g[0], v[j][1] * rs * g[1]) | ((unsigned long long)pk2(v[j][2] * rs * g[2], v[j][3] * rs * g[3]) << 32); }
    }
}

__device__ __forceinline__ void att_naive_unit(const Args& a, LAS unsigned char* lds, int tid, int b, int h, int qblk, float lam) {
    const bf16* QD = (const bf16*)(a.ws + WS_B3); const bf16* KD = (const bf16*)(a.ws + WS_B4); const bf16* VD = (const bf16*)(a.ws + WS_B5); bf16* HD = (bf16*)(a.ws + WS_B3);
    const int row = tid >> 2, c = (tid >> 1) & 1, vh = tid & 1;
    const int qpos = qblk * 128 + row; const size_t tok = (size_t)b * SEQ + qpos;
    float q[64];
    { const v4u* qp = (const v4u*)(QD + tok * 1024 + h * 128 + c * 64);
#pragma unroll
      for (int i = 0; i < 8; ++i) { const v4u w = qp[i]; q[8 * i + 0] = pg8::bf_lo(w.x); q[8 * i + 1] = pg8::bf_hi(w.x); q[8 * i + 2] = pg8::bf_lo(w.y); q[8 * i + 3] = pg8::bf_hi(w.y);
          q[8 * i + 4] = pg8::bf_lo(w.z); q[8 * i + 5] = pg8::bf_hi(w.z); q[8 * i + 6] = pg8::bf_lo(w.w); q[8 * i + 7] = pg8::bf_hi(w.w); } }
    const int kmax = ((qpos >> 6) + 1) << 6, ukmax = qblk * 128 + 128;
    float o[64];
#pragma unroll
    for (int i = 0; i < 64; ++i) o[i] = 0.f;
    float mrun = -INFINITY, l = 0.f;
    LAS float* Ks = (LAS float*)lds; LAS float* Vs = (LAS float*)(lds + 8192);
    for (int kt = 0; kt < ukmax; kt += 16) {
        __syncthreads();
        { const int kr = tid >> 5, cc = (tid & 31) * 4; const size_t ko = ((size_t)b * SEQ + kt + kr) * 1024 + h * 128 + cc;
          const v2u kw = *(const v2u*)(KD + ko), vw = *(const v2u*)(VD + ko);
          *(LAS f32x4*)(Ks + kr * 128 + cc) = (f32x4){pg8::bf_lo(kw.x), pg8::bf_hi(kw.x), pg8::bf_lo(kw.y), pg8::bf_hi(kw.y)};
          *(LAS f32x4*)(Vs + kr * 128 + cc) = (f32x4){pg8::bf_lo(vw.x), pg8::bf_hi(vw.x), pg8::bf_lo(vw.y), pg8::bf_hi(vw.y)}; }
        __syncthreads();
#pragma unroll 1
        for (int j = 0; j < 16; ++j) {
            if (kt + j >= kmax) continue;
            float d = 0.f; const LAS f32x4* kp = (const LAS f32x4*)(Ks + j * 128 + c * 64);
#pragma unroll
            for (int i = 0; i < 16; ++i) { const f32x4 kk = kp[i]; d += (q[4 * i] * kk[0] + q[4 * i + 1] * kk[1]) + (q[4 * i + 2] * kk[2] + q[4 * i + 3] * kk[3]); }
            const float mnew = fmaxf(mrun, d); const float alpha = __builtin_amdgcn_exp2f(mrun - mnew), p = __builtin_amdgcn_exp2f(d - mnew);
            l = l * alpha + p; mrun = mnew;
            const LAS f32x4* vp = (const LAS f32x4*)(Vs + j * 128 + vh * 64);
#pragma unroll
            for (int i = 0; i < 16; ++i) { const f32x4 vv = vp[i]; o[4 * i] = o[4 * i] * alpha + p * vv[0]; o[4 * i + 1] = o[4 * i + 1] * alpha + p * vv[1]; o[4 * i + 2] = o[4 * i + 2] * alpha + p * vv[2]; o[4 * i + 3] = o[4 * i + 3] * alpha + p * vv[3]; }
        }
    }
    const float inv = 1.0f / l; float sq = 0.f;
#pragma unroll
    for (int i = 0; i < 64; ++i) { o[i] *= inv; const float other = __shfl_xor(o[i], 2); o[i] = o[i] - lam * other; sq += o[i] * o[i]; }
    sq += __shfl_xor(sq, 1);
    const float rn = 1.0f / sqrtf(sq * (1.f / 128.f) + EPS) * (1.0f - LAM_INIT);
    if (c == 0) { const float* dg = a.in[I_DGAIN] + vh * 64; v4u* op = (v4u*)(HD + tok * 1024 + h * 128 + vh * 64);
#pragma unroll
        for (int i = 0; i < 8; ++i) { v4u w; w.x = pk2(o[8 * i] * rn * dg[8 * i], o[8 * i + 1] * rn * dg[8 * i + 1]); w.y = pk2(o[8 * i + 2] * rn * dg[8 * i + 2], o[8 * i + 3] * rn * dg[8 * i + 3]);
            w.z = pk2(o[8 * i + 4] * rn * dg[8 * i + 4], o[8 * i + 5] * rn * dg[8 * i + 5]); w.w = pk2(o[8 * i + 6] * rn * dg[8 * i + 6], o[8 * i + 7] * rn * dg[8 * i + 7]); op[i] = w; } }
}
__device__ __forceinline__ float diff_lambda(const Args& a) {
    const float* lp = a.in[I_DLAM]; float s1 = 0.f, s2 = 0.f;
    for (int i = 0; i < 64; ++i) { s1 += lp[i] * lp[64 + i]; s2 += lp[128 + i] * lp[192 + i]; }
    return expf(s1) - expf(s2) + LAM_INIT;
}
__device__ __forceinline__ void phase_att_naive(const Args& a, LAS unsigned char* lds, int tid, int vcu, int G) {
    const float lam = diff_lambda(a);
    for (int i = 0;; ++i) { const int u = i * G + vcu; if (u >= NB * 8 * 32) break;
        const int bh = u >> 5, r = (u & 31), rot = (r + 2 * (i >> 1)) & 31, qblk = (i & 1) ? 31 - rot : rot;
        att_naive_unit(a, lds, tid, bh >> 3, bh & 7, qblk, lam);
        __syncthreads(); }
}

__device__ __forceinline__ float bfdot8(const v4u w, const float* c) {
    return (c[0] * pg8::bf_lo(w.x) + c[1] * pg8::bf_hi(w.x)) + (c[2] * pg8::bf_lo(w.y) + c[3] * pg8::bf_hi(w.y)) + (c[4] * pg8::bf_lo(w.z) + c[5] * pg8::bf_hi(w.z)) + (c[6] * pg8::bf_lo(w.w) + c[7] * pg8::bf_hi(w.w));
}
__device__ __forceinline__ void mlstm_naive_unit(const Args& a, LAS unsigned char* lds, int tid, int lane, int wave, int b, int h) {
    const bf16* QKM = (const bf16*)(a.ws + WS_B1); bf16* VM = (bf16*)(a.ws + WS_B2); const float* IF = (const float*)(a.ws + WS_IF);
    LAS bf16* qs = (LAS bf16*)lds;
    LAS bf16* ks = (LAS bf16*)(lds + 16384);
    LAS bf16* vs = (LAS bf16*)(lds + 32768);
    LAS float* Sm = (LAS float*)(lds + 65536);
    LAS float* hs = (LAS float*)(lds + 81920);
    LAS float* sm = (LAS float*)(lds + 147456);
    LAS float* ig = sm, *lf = sm + 64, *bcum = sm + 128, *aarr = sm + 192, *mt = sm + 256, *wint = sm + 320, *wk = sm + 384, *den = sm + 448, *nvec = sm + 512, *scal = sm + 640, *hsqw = sm + 704;
    const int dv = tid >> 1, half = tid & 1;
    float Creg[64];
#pragma unroll
    for (int j = 0; j < 64; ++j) Creg[j] = 0.f;
    if (tid < 128) nvec[tid] = 0.f;
    if (tid == 0) scal[0] = 0.f;
    const float* cw = a.in[I_CONV_W];
    for (int ch = 0; ch < SEQ / 64; ++ch) {
        const size_t tok0 = (size_t)b * SEQ + ch * 64;
        __syncthreads();
        if (tid < 64) { ig[tid] = IF[(tok0 + tid) * 8 + h]; lf[tid] = IF[(tok0 + tid) * 8 + 4 + h]; }
        { const int col = tid & 127, which = (tid >> 7) & 1, tq = tid >> 8;
          const int chn = which * 512 + h * 128 + col; const float w0 = cw[chn], w1 = cw[1024 + chn], w2 = cw[2048 + chn], w3 = cw[3072 + chn];
          const int t0 = ch * 64 + 32 * tq; float x0, x1, x2;
          x0 = (t0 - 3 >= 0) ? bf2f(QKM[((size_t)b * SEQ + t0 - 3) * 1024 + chn]) : 0.f; x1 = (t0 - 2 >= 0) ? bf2f(QKM[((size_t)b * SEQ + t0 - 2) * 1024 + chn]) : 0.f; x2 = (t0 - 1 >= 0) ? bf2f(QKM[((size_t)b * SEQ + t0 - 1) * 1024 + chn]) : 0.f;
          LAS bf16* dst = which ? ks : qs; const float scl = which ? 1.0f : 0.08838834764831845f;
          for (int t = 0; t < 32; ++t) { const float x3 = bf2f(QKM[((size_t)b * SEQ + t0 + t) * 1024 + chn]); const float cv = w0 * x0 + w1 * x1 + w2 * x2 + w3 * x3; const float sv = cv * pg8::sigmoidf_(cv) * scl;
              dst[(32 * tq + t) * 128 + col] = (bf16)(pk2(sv, 0.f) & 0xffffu); x0 = x1; x1 = x2; x2 = x3; } }
        for (int idx = tid; idx < 64 * 32; idx += 512) { const int t = idx >> 5, c8 = (idx & 31) * 8; *(LAS v4u*)(vs + t * 256 + c8) = *(const v4u*)(VM + (tok0 + t) * 1024 + h * 256 + c8); }
        __syncthreads();
        if (tid == 0) { const float m = scal[0]; float bsum = 0.f, amax = -INFINITY;
            for (int t = 0; t < 64; ++t) { bsum += lf[t]; bcum[t] = bsum; const float av = ig[t] - bsum; aarr[t] = av; amax = fmaxf(amax, av); const float mm = fmaxf(m, amax); mt[t] = bsum + mm; wint[t] = expf(m - mm); }
            const float mm = fmaxf(m, amax), mnew = bsum + mm;
            for (int s = 0; s < 64; ++s) wk[s] = expf(bsum + aarr[s] - mnew);
            scal[1] = expf(bsum + m - mnew); scal[2] = mnew; }
        __syncthreads();
        for (int i = 0; i < 8; ++i) { const int idx = tid + 512 * i, t = idx >> 6, s = idx & 63; float val = 0.f;
            if (s <= t) { float d = 0.f;
#pragma unroll 2
                for (int k8 = 0; k8 < 16; ++k8) { const v4u qw = *(const LAS v4u*)(qs + t * 128 + k8 * 8), kw = *(const LAS v4u*)(ks + s * 128 + k8 * 8);
                    d += (pg8::bf_lo(qw.x) * pg8::bf_lo(kw.x) + pg8::bf_hi(qw.x) * pg8::bf_hi(kw.x)) + (pg8::bf_lo(qw.y) * pg8::bf_lo(kw.y) + pg8::bf_hi(qw.y) * pg8::bf_hi(kw.y))
                       + (pg8::bf_lo(qw.z) * pg8::bf_lo(kw.z) + pg8::bf_hi(qw.z) * pg8::bf_hi(kw.z)) + (pg8::bf_lo(qw.w) * pg8::bf_lo(kw.w) + pg8::bf_hi(qw.w) * pg8::bf_hi(kw.w)); }
                val = d * expf(bcum[t] + aarr[s] - mt[t]); }
            Sm[idx] = val; }
        __syncthreads();
        if (tid < 64) { float rsum = 0.f; for (int s = 0; s < 64; ++s) rsum += Sm[tid * 64 + s];
            float nq = 0.f; for (int k = 0; k < 128; ++k) nq += nvec[k] * bf2f(qs[tid * 128 + k]);
            den[tid] = fmaxf(fabsf(rsum + wint[tid] * nq), expf(-mt[tid])); }
        __syncthreads();
#pragma unroll 1
        for (int t = 0; t < 64; ++t) {
            float part = 0.f;
#pragma unroll
            for (int k8 = 0; k8 < 8; ++k8) part += bfdot8(*(const LAS v4u*)(qs + t * 128 + half * 64 + k8 * 8), &Creg[k8 * 8]);
            float ip = 0.f;
#pragma unroll 4
            for (int s = half * 32; s < half * 32 + 32; ++s) ip += Sm[t * 64 + s] * bf2f(vs[s * 256 + dv]);
            float tot = ip + wint[t] * part; tot += __shfl_xor(tot, 1);
            const float hv = tot / den[t];
            if (half == 0) hs[t * 256 + dv] = hv;
            const float sq = wave_sum(half == 0 ? hv * hv : 0.f);
            if (lane == 0) hsqw[wave * 64 + t] = sq;
        }
        __syncthreads();
        for (int i = 0; i < 32; ++i) { const int idx = tid + 512 * i, t = idx >> 8, dd = idx & 255; float ssum = 0.f;
#pragma unroll
            for (int w = 0; w < 8; ++w) ssum += hsqw[w * 64 + t];
            const float rn = 1.0f / sqrtf(ssum * (1.f / 256.f) + EPS);
            VM[(tok0 + t) * 1024 + h * 256 + dd] = (bf16)(pk2(hs[idx] * rn * a.in[I_MGAIN][h * 256 + dd], 0.f) & 0xffffu); }
        { const float decay = scal[1];
#pragma unroll
          for (int j = 0; j < 64; ++j) Creg[j] *= decay;
#pragma unroll 1
          for (int s = 0; s < 64; ++s) { const float wv = wk[s] * bf2f(vs[s * 256 + dv]);
#pragma unroll
              for (int k8 = 0; k8 < 8; ++k8) { const v4u kw = *(const LAS v4u*)(ks + s * 128 + half * 64 + k8 * 8);
                  Creg[k8 * 8 + 0] += wv * pg8::bf_lo(kw.x); Creg[k8 * 8 + 1] += wv * pg8::bf_hi(kw.x); Creg[k8 * 8 + 2] += wv * pg8::bf_lo(kw.y); Creg[k8 * 8 + 3] += wv * pg8::bf_hi(kw.y);
                  Creg[k8 * 8 + 4] += wv * pg8::bf_lo(kw.z); Creg[k8 * 8 + 5] += wv * pg8::bf_hi(kw.z); Creg[k8 * 8 + 6] += wv * pg8::bf_lo(kw.w); Creg[k8 * 8 + 7] += wv * pg8::bf_hi(kw.w); } }
          float nn = 0.f;
          if (tid < 128) { nn = decay * nvec[tid]; for (int s = 0; s < 64; ++s) nn += wk[s] * bf2f(ks[s * 128 + tid]); }
          __syncthreads();
          if (tid < 128) nvec[tid] = nn;
          if (tid == 0) scal[0] = scal[2]; }
    }
    __syncthreads();
}
__device__ __forceinline__ void phase_mlstm_naive(const Args& a, LAS unsigned char* lds, int tid, int lane, int wave, int vcu, int G) {
    for (int u = vcu; u < NB * 4; u += G) mlstm_naive_unit(a, lds, tid, lane, wave, u >> 2, u & 3);
}

__device__ __forceinline__ void phase_rs1(const Args& a, int tid, int vcu, int G) {
    const float* ss = (const float*)(a.ws + WS_SS1); float* rs = (float*)(a.ws + WS_RS1);
    for (int r = vcu * 512 + tid; r < T; r += G * 512) { const f32x4* p = (const f32x4*)(ss + (size_t)r * 16); const f32x4 s0 = p[0], s1 = p[1], s2 = p[2], s3 = p[3];
        const float s = ((s0[0] + s0[1]) + (s0[2] + s0[3])) + ((s1[0] + s1[1]) + (s1[2] + s1[3])) + ((s2[0] + s2[1]) + (s2[2] + s2[3])) + ((s3[0] + s3[1]) + (s3[2] + s3[3]));
        rs[r] = 1.0f / sqrtf(s * (1.f / D) + EPS); }
}
__device__ __forceinline__ void phase_pnorm(const Args& a, int lane, int wave, int vcu, int G, bool dry = false) {
    bf16* P = (bf16*)(a.ws + WS_B3); const float* ps = (const float*)(a.ws + WS_PSUM);
    for (int r = vcu * NWAVES + wave; r < T; r += G * NWAVES) { const int hh = lane >> 4; const f32x4 s = *(const f32x4*)(ps + (size_t)r * 16 + hh * 4);
        const float inv = 1.0f / ((s[0] + s[1]) + (s[2] + s[3]));
        v4u* p = (v4u*)(P + (size_t)r * 1024 + lane * 16);
#pragma unroll
        for (int i = 0; i < 2; ++i) { const v4u w = p[i]; v4u o; o.x = pk2(pg8::bf_lo(w.x) * inv, pg8::bf_hi(w.x) * inv); o.y = pk2(pg8::bf_lo(w.y) * inv, pg8::bf_hi(w.y) * inv);
            o.z = pk2(pg8::bf_lo(w.z) * inv, pg8::bf_hi(w.z) * inv); o.w = pk2(pg8::bf_lo(w.w) * inv, pg8::bf_hi(w.w) * inv); if (!dry) p[i] = o; } }
}
__device__ __forceinline__ void phase_final_plain(const Args& a, const float* src, int lane, int wave, int vcu, int G) {
    for (int m = vcu * NWAVES + wave; m < T; m += G * NWAVES) {
        const f32x4* xr = (const f32x4*)(src + (size_t)m * D) + lane; const f32x4* gr = (const f32x4*)a.in[I_NORM_FINAL] + lane; f32x4* orow = (f32x4*)(a.out + (size_t)m * D) + lane;
        f32x4 v[4]; float s = 0.f;
#pragma unroll
        for (int j = 0; j < 4; ++j) { v[j] = xr[64 * j]; s += (v[j][0] * v[j][0] + v[j][1] * v[j][1]) + (v[j][2] * v[j][2] + v[j][3] * v[j][3]); }
        const float rs = 1.0f / sqrtf(wave_sum(s) * (1.f / D) + EPS);
#pragma unroll
        for (int j = 0; j < 4; ++j) orow[64 * j] = v[j] * rs * gr[64 * j];
    }
}
typedef short rt_bf16x8 __attribute__((ext_vector_type(8)));
typedef float rt_f32x16 __attribute__((ext_vector_type(16)));
__device__ __forceinline__ void phase_router(const Args& a, LAS unsigned char* lds, int tid, int lane, int wave) {
    LAS int* hist = (LAS int*)(lds + 135168);
    const float* wgt = (const float*)(a.ws + WS_WGT);
    for (int idx = tid; idx < 32 * 128; idx += 512) { const int e = idx >> 7, ch = idx & 127; const f32x4 w0 = *(const f32x4*)(wgt + e * 1024 + ch * 8), w1 = *(const f32x4*)(wgt + e * 1024 + ch * 8 + 4);
        unsigned hiw[4], low[4];
#pragma unroll
        for (int j = 0; j < 4; ++j) { const float x0 = j < 2 ? w0[2 * j] : w1[2 * j - 4], x1 = j < 2 ? w0[2 * j + 1] : w1[2 * j - 3]; const unsigned h = pk2(x0, x1); hiw[j] = h; low[j] = pk2(x0 - pg8::bf_lo(h), x1 - pg8::bf_hi(h)); }
        const unsigned off = (unsigned)e * 2048u + (unsigned)((ch ^ e) & 127) * 16u;
        *(LAS v4u*)(lds + off) = (v4u){hiw[0], hiw[1], hiw[2], hiw[3]}; *(LAS v4u*)(lds + 65536 + off) = (v4u){low[0], low[1], low[2], low[3]}; }
    if (tid < 32) hist[tid] = 0;
    __syncthreads();
    const int blk = blockIdx.x, r32 = lane & 31, hi = lane >> 5;
    const int tk = blk * 256 + wave * 32 + r32;
    const bf16* xrow = (const bf16*)(a.ws + WS_B0) + (size_t)tk * D + 8 * hi;
    rt_f32x16 acc;
#pragma unroll
    for (int i = 0; i < 16; ++i) acc[i] = 0.f;
    float sq = 0.f;
    for (int kb = 0; kb < 8; ++kb) {
        v4u xv[8];
#pragma unroll
        for (int s8 = 0; s8 < 8; ++s8) xv[s8] = *(const v4u*)(xrow + kb * 128 + s8 * 16);
#pragma unroll
        for (int s8 = 0; s8 < 8; ++s8) { const int ks = kb * 8 + s8;
#pragma unroll
            for (int j = 0; j < 4; ++j) { const float x0 = pg8::bf_lo(xv[s8][j]), x1 = pg8::bf_hi(xv[s8][j]); sq += x0 * x0 + x1 * x1; }
            const unsigned boff = (unsigned)r32 * 2048u + (unsigned)(((2 * ks + hi) ^ r32) & 127) * 16u;
            const rt_bf16x8 bh = *(const LAS rt_bf16x8*)(lds + boff), bl = *(const LAS rt_bf16x8*)(lds + 65536 + boff);
            const rt_bf16x8 fa = __builtin_bit_cast(rt_bf16x8, xv[s8]);
            acc = __builtin_amdgcn_mfma_f32_32x32x16_bf16(fa, bh, acc, 0, 0, 0); acc = __builtin_amdgcn_mfma_f32_32x32x16_bf16(fa, bl, acc, 0, 0, 0); }
    }
    { auto rr = __builtin_amdgcn_permlane32_swap(__float_as_uint(sq), __float_as_uint(sq), false, false); sq = __uint_as_float(rr[0]) + __uint_as_float(rr[1]); }
    const float rs = 1.0f / sqrtf(sq * (1.f / D) + EPS);
    __syncthreads();
    LAS float* lg_t = (LAS float*)(lds + wave * 4608);
    if (hi == 0) lg_t[1056 + r32] = rs;
    LDS_WAIT(); asm volatile("" ::: "memory");
    { const float br = a.in[I_B_R][r32];
#pragma unroll
      for (int i = 0; i < 16; ++i) { const int t = (i & 3) + 8 * (i >> 2) + 4 * hi; lg_t[t * 33 + r32] = acc[i] * lg_t[1056 + t] + br; } }
    LDS_WAIT(); asm volatile("" ::: "memory");
    if (lane < 32) { float lg[32];
#pragma unroll
        for (int e = 0; e < 32; ++e) lg[e] = lg_t[lane * 33 + e];
        int bi[4]; float bv[4];
#pragma unroll
        for (int k = 0; k < 4; ++k) { float best = -INFINITY; int be = 0;
#pragma unroll
            for (int e = 0; e < 32; ++e) if (lg[e] > best) { best = lg[e]; be = e; }
#pragma unroll
            for (int e = 0; e < 32; ++e) lg[e] = (e == be) ? -INFINITY : lg[e];
            bi[k] = be; bv[k] = best; }
        const float e1 = expf(bv[1] - bv[0]), e2 = expf(bv[2] - bv[0]), e3 = expf(bv[3] - bv[0]); const float inv = 1.0f / (1.0f + e1 + e2 + e3);
        ((float*)(a.ws + WS_RS2))[tk] = rs;
        *(v4u*)((int*)(a.ws + WS_TOPI) + (size_t)tk * 4) = (v4u){(unsigned)bi[0], (unsigned)bi[1], (unsigned)bi[2], (unsigned)bi[3]};
        *(f32x4*)((float*)(a.ws + WS_TOPW) + (size_t)tk * 4) = (f32x4){inv, e1 * inv, e2 * inv, e3 * inv};
#pragma unroll
        for (int k = 0; k < 4; ++k) __hip_atomic_fetch_add(&hist[bi[k]], 1, __ATOMIC_RELAXED, __HIP_MEMORY_SCOPE_WORKGROUP); }
    __syncthreads();
    if (tid < 32) ((int*)(a.ws + WS_MISC))[blk * 32 + tid] = hist[tid];
}
__device__ __forceinline__ void phase_slot(const Args& a, LAS unsigned char* lds, int tid) {
    LAS int* tot = (LAS int*)lds, *bef = tot + 32, *st = tot + 64, *ids = tot + 128;
    const int blk = blockIdx.x, half = blk >> 7; const int* hist = (const int*)(a.ws + WS_MISC);
    int* tile_e = (int*)(a.ws + WS_MISC) + 8192 + half * HTILES; int* ntiles = (int*)(a.ws + WS_MISC) + 8192 + 2 * HTILES;
    int* toklist = (int*)(a.ws + WS_TOKL) + (size_t)half * HSLOTS; int* slot_of = (int*)(a.ws + WS_SLOT); const int* topi = (const int*)(a.ws + WS_TOPI);
    LAS int* hl = tot + 2048;
    for (int i = tid; i < 4096; i += 512) hl[i] = hist[half * 4096 + i];
    for (int i = tid; i < 1024; i += 512) ids[i] = topi[(size_t)blk * 1024 + i];
    LAS float* rsl = (LAS float*)(tot + 8192);
    float* rs_slot = (float*)(a.ws + WS_RSS) + (size_t)half * HSLOTS;
    if (tid < 256) rsl[tid] = ((const float*)(a.ws + WS_RS2))[blk * 256 + tid];
    __syncthreads();
    if (tid < 32) { int t = 0, bf = 0; for (int bb = 0; bb < 128; ++bb) { const int hv = hl[bb * 32 + tid]; t += hv; if (half * 128 + bb < blk) bf += hv; } tot[tid] = t; bef[tid] = bf; }
    __syncthreads();
    if (tid == 0) { int s = 0; for (int e = 0; e < 32; ++e) { st[e] = s; s += ((tot[e] + 255) >> 8) << 8; } st[32] = s; }
    __syncthreads();
    LAS int* ccnt = tot + 1152;
    const int lane_ = tid & 63; int ee[2], rk[2];
#pragma unroll
    for (int ps = 0; ps < 2; ++ps) { const int i = tid + 512 * ps; const int e = ids[i]; int r = 0;
        for (int x = 0; x < 32; ++x) { const unsigned long long mk = __ballot(e == x); if (e == x) r = __builtin_popcountll(mk & ((1ull << lane_) - 1ull)); if (lane_ == 0) ccnt[(i >> 6) * 32 + x] = __builtin_popcountll(mk); }
        ee[ps] = e; rk[ps] = r; }
    __syncthreads();
    if (tid < 32) { int run = st[tid] + bef[tid]; for (int c = 0; c < 16; ++c) { const int t = ccnt[c * 32 + tid]; ccnt[c * 32 + tid] = run; run += t; } }
    __syncthreads();
#pragma unroll
    for (int ps = 0; ps < 2; ++ps) { const int i = tid + 512 * ps; const int cnt = ccnt[(i >> 6) * 32 + ee[ps]] + rk[ps]; const int tk = blk * 256 + (i >> 2);
        slot_of[(size_t)tk * 4 + (i & 3)] = cnt; toklist[cnt] = tk; rs_slot[cnt] = rsl[i >> 2]; }
    if (tid < 32) {
        if ((blk & 127) == 0) { for (int s = st[tid] + tot[tid]; s < st[tid + 1]; ++s) { toklist[s] = half * (T / 2); rs_slot[s] = 1.0f; }
            for (int tl = st[tid] >> 8; tl < (st[tid + 1] >> 8); ++tl) tile_e[tl] = tid;
            if (tid == 0) ntiles[half] = st[32] >> 8; } }
}
__device__ __forceinline__ void phase_combine(const Args& a, int lane, int wave, int vcu, int G, bool dry = false) {
    const unsigned char* Yall = (const unsigned char*)(a.ws + WS_Y); const int* slot_of = (const int*)(a.ws + WS_SLOT); const float* tw = (const float*)(a.ws + WS_TOPW);
    f32x4 gr[4];
#pragma unroll
    for (int j = 0; j < 4; ++j) gr[j] = *((const f32x4*)a.in[I_NORM_FINAL] + lane * 4 + j);
    for (int m = vcu * NWAVES + wave; m < T; m += G * NWAVES) { const unsigned char* Y = Yall + (m >= T / 2 ? (size_t)HSLOTS * 1024 : (size_t)0);
        const v4u* xb = (const v4u*)((const bf16*)(a.ws + WS_B0) + (size_t)m * D) + lane * 2; const v4u w0 = xb[0], w1 = xb[1];
        v4u yk[4]; float ck[4];
#pragma unroll
        for (int k = 0; k < 4; ++k) { const int sl = slot_of[(size_t)m * 4 + k]; ck[k] = tw[(size_t)m * 4 + k]; yk[k] = *((const v4u*)(Y + (size_t)sl * 1024) + lane); }
        f32x4 v[4];
        v[0] = (f32x4){pg8::bf_lo(w0.x), pg8::bf_hi(w0.x), pg8::bf_lo(w0.y), pg8::bf_hi(w0.y)}; v[1] = (f32x4){pg8::bf_lo(w0.z), pg8::bf_hi(w0.z), pg8::bf_lo(w0.w), pg8::bf_hi(w0.w)};
        v[2] = (f32x4){pg8::bf_lo(w1.x), pg8::bf_hi(w1.x), pg8::bf_lo(w1.y), pg8::bf_hi(w1.y)}; v[3] = (f32x4){pg8::bf_lo(w1.z), pg8::bf_hi(w1.z), pg8::bf_lo(w1.w), pg8::bf_hi(w1.w)};
#pragma unroll
        for (int k = 0; k < 4; ++k) { const float c = ck[k];
#pragma unroll
            for (int j = 0; j < 4; ++j) { const unsigned w = yk[k][j]; typedef float f2_ __attribute__((ext_vector_type(2)));
                const f2_ lo = __builtin_amdgcn_cvt_pk_f32_fp8((int)w, false), hh = __builtin_amdgcn_cvt_pk_f32_fp8((int)w, true);
                v[j][0] += c * lo[0]; v[j][1] += c * lo[1]; v[j][2] += c * hh[0]; v[j][3] += c * hh[1]; } }
        float s = 0.f;
#pragma unroll
        for (int j = 0; j < 4; ++j) s += (v[j][0] * v[j][0] + v[j][1] * v[j][1]) + (v[j][2] * v[j][2] + v[j][3] * v[j][3]);
        const float rs = 1.0f / sqrtf(wave_sum(s) * (1.f / D) + EPS);
        f32x4* xr = (f32x4*)(a.out + (size_t)m * D) + lane * 4;
#pragma unroll
        for (int j = 0; j < 4; ++j) if (!dry) xr[j] = v[j] * rs * gr[j];
    }
}
#ifndef DBG_STAGE
#define DBG_STAGE 0
#endif
#ifndef Z1_F8_GROUPS
#define Z1_F8_GROUPS 0
#endif
#ifndef Z3_F8_GROUPS
#define Z3_F8_GROUPS 7
#endif
constexpr unsigned zmap(unsigned mask, int base) { unsigned m = 0; int k = 0; for (int g = 0; g < 8; ++g) if ((mask >> g) & 1u) { m |= (unsigned)(base + g) << (4 * k); ++k; } return m; }
constexpr int zcount(unsigned mask) { int k = 0; for (int g = 0; g < 8; ++g) k += (mask >> g) & 1u; return k; }
enum { PH_P0 = 0, PH_Z1, PH_ATT, PH_Z3, PH_BRF, PH_OUT, PH_S, PH_PV, PH_ROUTER, PH_SLOT, PH_G1, PH_G2, PH_CB, N_PHASES };

__global__ void __launch_bounds__(NWAVES * 64, 2) fwd_kernel(Args args) {
    extern __shared__ __attribute__((aligned(16))) unsigned char lds_raw[];
    LAS unsigned char* lds = (LAS unsigned char*)lds_raw;
    volatile LAS unsigned* MISC = (volatile LAS unsigned*)(lds + MISC_OFF);
#define LAUNDER_TID() int tid = threadIdx.x; asm volatile("" : "+v"(tid)); const int lane = tid & 63, wave = __builtin_amdgcn_readfirstlane(tid >> 6)
    const int tid0 = threadIdx.x;
    const int G = gridDim.x; const int bx = blockIdx.x; const int vcu = (G % 8 == 0) ? (bx % 8) * (G / 8) + bx / 8 : bx;
    unsigned char* ws = args.ws;
    if (tid0 < 128) MISC[tid0] = 0u;
    __syncthreads();
    const int lo = args.ph_lo, hi = args.ph_hi;
    XcdBarrier bar; bar.bar = (unsigned*)(ws + WS_CTL) + CW_BAR; bar.x = 0; bar.st = nullptr;
    if (hi - lo > 1) bar = xcd_barrier_post((unsigned*)(ws + WS_CTL) + CW_BAR, MISC + 8);
#ifndef ONLY_PHASE
#define ONLY_PHASE -1
#endif
#ifndef SKIP_MASK
#define SKIP_MASK 0u
#endif
#define IN(k) ((ONLY_PHASE < 0 || ONLY_PHASE == (k)) && !((SKIP_MASK >> (k)) & 1u) && lo <= (k) && (k) < hi)
#ifndef REP_MASK
#define REP_MASK 0u
#endif
#define REPS(k) (((REP_MASK >> (k)) & 1u) ? 2 : 1)
#define REP(k) for (int rep_ = 0; rep_ < REPS(k); ++rep_)
#define DRY(k) (rep_ + 1 < REPS(k))
#ifndef BR1_SHIFT
#define BR1_SHIFT 0
#endif
#ifndef ATT_NS
#define ATT_NS att6
#endif
#ifndef ATT_THRL
#define ATT_THRL 8
#endif
#ifndef Z3_DRY_BROW
#define Z3_DRY_BROW 5120
#endif
#ifndef Z3DRYEXPR
#define Z3DRYEXPR DRY(PH_Z3)
#endif
#define SEAM(k) do { if (IN(k) && IN((k) + 1)) xcd_barrier(bar); } while (0)
    using namespace pg8;
    const bf16_t* B0 = (const bf16_t*)(ws + WS_B0);

    if (IN(PH_P0)) REP(PH_P0) { LAUNDER_TID(); (void)lane; (void)wave; phase_p0(args, lds, tid, lane, wave, vcu, G); } SEAM(PH_P0);
#if DBG_STAGE == 1
    if (IN(PH_Z1)) { LAUNDER_TID(); (void)lane; (void)wave; phase_final_plain(args, args.in[I_X], lane, wave, vcu, G); }
#else
    if (IN(PH_Z1)) REP(PH_Z1) {
        constexpr unsigned MA = zmap(~(unsigned)(Z1_F8_GROUPS) & 31u, 0), MB = zmap((unsigned)(Z1_F8_GROUPS) & 31u, 0); constexpr int NA = zcount(~(unsigned)(Z1_F8_GROUPS) & 31u), NB8 = zcount((unsigned)(Z1_F8_GROUPS) & 31u);
        if constexpr (NA > 0) { OpsZ O{(const char*)B0, (const char*)(ws + WS_WIN), 2048u, 2048u, MA}; StaticOrder S; S.init_tiles(T / 256, 4 * NA, G, bx);
            EpiZ1 E{(bf16_t*)(ws + WS_B1), BUF / 2, (const float*)(ws + WS_RS0), QD_SCALE, 2, MA};
            gemm_phase<EpiZ1, StaticOrder, OpsZ, true>(lds + RING_OFF, O, 1024, S, E); }
        if constexpr (NB8 > 0) { OpsZF8 O{(const char*)(ws + WS_XQ), (const char*)(ws + WS_WIN8), 1024u, 1024u, MB, SC_ONE, SC_W}; StaticOrder S; S.init_tiles(T / 256, 4 * NB8, G, bx);
            EpiZ1 E{(bf16_t*)(ws + WS_B1), BUF / 2, (const float*)(ws + WS_RS0), QD_SCALE, 2, MB};
            gemm_phase<EpiZ1, StaticOrder, OpsZF8, true>(lds + RING_OFF, O, 512, S, E); }
    } SEAM(PH_Z1);
    if (IN(PH_ATT)) REP(PH_ATT) {
#ifdef PROBE_SKIP_MLSTM_DRY
        if (!DRY(PH_ATT))
#endif
#ifdef PROBE_MLSTM_TWICE
        if (bx < NB * 4) mls::mlstm_unit((const unsigned short*)(ws + WS_B1), (unsigned short*)(ws + WS_B2), (const float*)(ws + WS_IF), args.in[I_CONV_W], args.in[I_MGAIN], lds, bx >> 2, bx & 3, true);
        __syncthreads();
#endif
        if (bx < NB * 4) mls::mlstm_unit((const unsigned short*)(ws + WS_B1), (unsigned short*)(ws + WS_B2), (const float*)(ws + WS_IF), args.in[I_CONV_W], args.in[I_MGAIN], lds, bx >> 2, bx & 3, DRY(PH_ATT));
        __syncthreads();
        const float lam = diff_lambda(args);
#ifdef PROBE_SKIP_ATT_DRY
        if (!DRY(PH_ATT))
#endif
        ATT_NS::phase<ATT_THRL>((char*)lds_raw, (const unsigned short*)(ws + WS_B3), (const unsigned short*)(ws + WS_B4), (const unsigned short*)(ws + WS_B5), (unsigned short*)(ws + WS_B3), (unsigned*)(ws + WS_CTL) + CW_Q + 512 * rep_, MISC + 16, lam, args.in[I_DGAIN], ws + WS_SS1  , DRY(PH_ATT),
            [&](int k) {
                static_assert((Z3_F8_GROUPS) == 7, "WS_KV reuses the bf16 input-projection weights: no Z3 group may still read them");
                if (k == 0 && !DRY(PH_ATT) && bx >= 64 && bx < 192) {
                    OpsPlain O2{(const char*)(ws + WS_MEMN), (const char*)(ws + WS_WKV), 2048u, 2048u}; StaticOrder S2; S2.init_tiles(NB * NMEM / 256, 8, 128, bx - 64);
                    EpiPlain E2{(bf16_t*)(ws + WS_KV), 2048, 1.0f};
                    gemm_phase<EpiPlain, StaticOrder, OpsPlain, true>(lds + RING_OFF, O2, 1024, S2, E2); __syncthreads(); }
#ifdef EXPERT_CONV_IN_ATT
                if (k < EXPERT_SLICES && !DRY(PH_ATT)) { LAUNDER_TID(); (void)tid; p0_expert_items(args, lds, lane, wave, bx * EXPERT_SLICES + k, G * EXPERT_SLICES); __syncthreads(); }
#else
                (void)k;
#endif
            }); } SEAM(PH_ATT);
#ifdef DELAY_BEFORE_Z3
    if (IN(PH_Z3)) { const unsigned long long t0 = __builtin_amdgcn_s_memrealtime(); while (__builtin_amdgcn_s_memrealtime() - t0 < (unsigned long long)(DELAY_BEFORE_Z3)) __builtin_amdgcn_s_sleep(8); }
#endif
    if (IN(PH_Z3)) REP(PH_Z3) {
        constexpr unsigned MA = zmap(~(unsigned)(Z3_F8_GROUPS) & 7u, 5), MB = zmap((unsigned)(Z3_F8_GROUPS) & 7u, 5); constexpr int NA = zcount(~(unsigned)(Z3_F8_GROUPS) & 7u), NB8 = zcount((unsigned)(Z3_F8_GROUPS) & 7u);
        if constexpr (NA > 0) { OpsZ O{(const char*)B0, (const char*)(ws + WS_WIN), 2048u, 2048u, MA}; StaticOrder S; S.init_tiles(T / 256, 4 * NA, G, bx);
            EpiZ3 E{(const bf16_t*)(ws + WS_B2), (bf16_t*)(ws + WS_B2), (bf16_t*)(ws + WS_B1), (bf16_t*)(ws + WS_B4), (const float*)(ws + WS_RS0), args.in[I_B_GATE], Z3DRYEXPR, MA, lds + RING_OFF + RING_BYTES + 4096};
            gemm_phase<EpiZ3, StaticOrder, OpsZ, true>(lds + RING_OFF, O, 1024, S, E); }
        if constexpr (NB8 > 0) {
            static_assert((Z3_F8_GROUPS) == 7, "all three Z3 groups run from the e4m3 copies");
            { constexpr unsigned M0 = zmap(1u, 5); OpsZF8 O{(const char*)(ws + WS_XQ), (const char*)(ws + WS_WIN8), 1024u, 1024u, M0, SC_ONE, SC_W}; StaticOrder S; S.init_tiles(T / 256, 4, G, bx);
              EpiZ3 E{(const bf16_t*)(ws + WS_B2), (bf16_t*)(ws + WS_B2), (bf16_t*)(ws + WS_B1), (bf16_t*)(ws + WS_B4), (const float*)(ws + WS_RS0), args.in[I_B_GATE], Z3DRYEXPR, M0, lds + RING_OFF + RING_BYTES + 4096};
              gemm_phase<EpiZ3, StaticOrder, OpsZF8, true>(lds + RING_OFF, O, 512, S, E); }
            { constexpr unsigned M1 = zmap(6u, 5); OpsZF8 O{(const char*)(ws + WS_XQ), (const char*)(ws + WS_WIN8), 1024u, 1024u, M1, SC_ONE, SC_W}; StaticOrder S; S.init_tiles(T / 256, 8, G, bx);
              EpiZ3G E{(unsigned char*)(ws + WS_B1), (unsigned char*)(ws + WS_B4), args.in[I_B_GATE], M1, lds + RING_OFF + RING_BYTES + 4096};
              gemm_phase<EpiZ3G, StaticOrder, OpsZF8, true>(lds + RING_OFF, O, 512, S, E); } }
    } SEAM(PH_Z3);
    if (IN(PH_BRF)) REP(PH_BRF) {
        { OpsDual O{(const char*)(ws + WS_B2), (const char*)(ws + WS_WBM), (const char*)(ws + WS_B3), (const char*)(ws + WS_WBD), 2048u, 2048u, 16}; StaticOrder S; S.init_tiles(T / 256, 4, G, bx);
          EpiBRF8 E{(const unsigned char*)(ws + WS_B1), (const unsigned char*)(ws + WS_B4), (bf16_t*)(ws + WS_B0)};
          gemm_phase<EpiBRF8, StaticOrder, OpsDual, true>(lds + RING_OFF, O, 2048, S, E); }
        { OpsWp O{(const char*)(ws + WS_KV), (const char*)(ws + WS_WQG), 4096u, 2048u}; StaticOrder S; S.init_tiles(NB * 4, 4, G, bx);
          EpiPlainF8 E{(unsigned char*)(ws + WS_WPT), 1024, XS_SCALE * 128.0f};
          gemm_phase<EpiPlainF8, StaticOrder, OpsWp, true>(lds + RING_OFF, O, 256, S, E); }
        { OpsVp O{(const char*)(ws + WS_WO), (const char*)(ws + WS_KV), 2048u, 4096u}; StaticOrder S; S.init_tiles(NB * 4, 4, G, bx);
          EpiPlainF8 E{(unsigned char*)(ws + WS_VPT), 1024, 32.0f};
          gemm_phase<EpiPlainF8, StaticOrder, OpsVp, true>(lds + RING_OFF, O, 256, S, E); }
    } SEAM(PH_BRF);
    if (IN(PH_OUT)) REP(PH_OUT) {
        OpsPlain O{(const char*)B0, (const char*)(ws + WS_WOUT), 2048u, 2048u}; StaticOrder S; S.init_tiles(T / 256, 4, G, bx);
        EpiResB<false> E{(const void*)args.in[I_X], (bf16_t*)(ws + WS_B1), (float*)(ws + WS_SS1), (unsigned char*)(ws + WS_X1Q)};
        gemm_phase<EpiResB<false>, StaticOrder, OpsPlain, true>(lds + RING_OFF, O, 1024, S, E);
    } SEAM(PH_OUT);
#if DBG_STAGE == 2
    if (IN(PH_S)) { LAUNDER_TID(); (void)lane; (void)wave; phase_final_plain(args, args.out, lane, wave, vcu, G); }
#else
    if (IN(PH_S)) REP(PH_S) {
        OpsBatchBF8 O{(const char*)(ws + WS_X1Q), (const char*)(ws + WS_WPT), 1024u, 1024u, (size_t)1024 * 1024, SC_ONE, SC_W}; StaticOrder S; S.init_tiles(T / 256, 4, G, bx);
        EpiS E{(unsigned char*)(ws + WS_B3), (const float*)(ws + WS_SS1), (PG8_LAS float*)(lds + RING_BYTES)};
        gemm_phase<EpiS, StaticOrder, OpsBatchBF8, true>(lds + RING_OFF, O, 512, S, E);
    } SEAM(PH_S);
    if (IN(PH_PV)) REP(PH_PV) {
        OpsBatchBF8 O{(const char*)(ws + WS_B3), (const char*)(ws + WS_VPT), 1024u, 1024u, (size_t)1024 * 1024, SC_P, SC_V}; StaticOrder S; S.init_tiles(T / 256, 4, G, bx);
        EpiResB<true> E{(const void*)(ws + WS_B1), (bf16_t*)(ws + WS_B0), nullptr, (unsigned char*)(ws + WS_X2Q)};
        gemm_phase<EpiResB<true>, StaticOrder, OpsBatchBF8, true>(lds + RING_OFF, O, 512, S, E);
    } SEAM(PH_PV);
#if DBG_STAGE == 3
    if (IN(PH_ROUTER)) { LAUNDER_TID(); (void)lane; (void)wave; phase_final_plain(args, args.out, lane, wave, vcu, G); }
#else
    if (IN(PH_ROUTER)) REP(PH_ROUTER) { LAUNDER_TID(); (void)lane; (void)wave; phase_router(args, lds, tid, lane, wave); } SEAM(PH_ROUTER);
    if (IN(PH_SLOT)) REP(PH_SLOT) { LAUNDER_TID(); (void)lane; (void)wave; phase_slot(args, lds, tid); } SEAM(PH_SLOT);
    if (IN(PH_G1)) REP(PH_G1) { const int nT0 = ((const int*)(ws + WS_MISC))[8192 + 2 * HTILES], nT1 = ((const int*)(ws + WS_MISC))[8192 + 2 * HTILES + 1]; const int* tl = (const int*)(ws + WS_TOKL); const int* te = (const int*)(ws + WS_MISC) + 8192;
        OpsG1 O{(const char*)(ws + WS_X2Q), (const char*)(ws + WS_WGU), tl, te, 1024u, 1024u, SC_ONE, SC_W, nT0}; StaticOrder S; S.init_tiles(nT0 + nT1, 8, G, bx);
        EpiG1 E{(unsigned char*)(ws + WS_H), (const float*)(ws + WS_RSS), tl, te, args.in[I_B_GU], DRY(PH_G1), nT0, lds + RING_OFF + RING_BYTES + 4096};
        gemm_phase<EpiG1, StaticOrder, OpsG1, true>(lds + RING_OFF, O, 512, S, E); } SEAM(PH_G1);
    if (IN(PH_G2)) REP(PH_G2) { const int nT0 = ((const int*)(ws + WS_MISC))[8192 + 2 * HTILES], nT1 = ((const int*)(ws + WS_MISC))[8192 + 2 * HTILES + 1]; const int* te = (const int*)(ws + WS_MISC) + 8192;
        OpsG2 O{(const char*)(ws + WS_H), (const char*)(ws + WS_WDN), te, 1024u, 1024u, SC_ONE, SC_W, nT0}; StaticOrder S; S.init_tiles(nT0 + nT1, 4, G, bx);
        EpiG2 E{(unsigned char*)(ws + WS_Y), te, args.in[I_B_DN], DRY(PH_G2), nT0, lds + RING_OFF + RING_BYTES + 4096};
        gemm_phase<EpiG2, StaticOrder, OpsG2, true>(lds + RING_OFF, O, 512, S, E); } SEAM(PH_G2);
    if (IN(PH_CB)) REP(PH_CB) { LAUNDER_TID(); (void)tid; phase_combine(args, lane, wave, vcu, G, DRY(PH_CB)); }
#endif
#endif
#endif
#undef IN
#undef SEAM
}

#ifndef MK_ONE_LAUNCH
#define MK_ONE_LAUNCH 0
#endif
extern "C" void kernel_launch(void* const* d_in, const int* in_sizes, int n_in, void* d_out, int out_size, void* d_ws, size_t ws_size, hipStream_t stream) {
    static int grid = 0;
    if (grid == 0) {
        if (n_in != N_INPUTS || out_size != T * D || ws_size < WS_END) { fprintf(stderr, "kernel_launch: unexpected shapes (n_in %d, out %d, ws %zu)\n", n_in, out_size, ws_size); grid = -1; return; }
        int dev = 0, cus = 0, per_cu = 0;
        if (hipGetDevice(&dev) != hipSuccess || hipDeviceGetAttribute(&cus, hipDeviceAttributeMultiprocessorCount, dev) != hipSuccess) { grid = -1; return; }
        if (hipFuncSetAttribute((const void*)fwd_kernel, hipFuncAttributeMaxDynamicSharedMemorySize, LDS_BYTES) != hipSuccess) { fprintf(stderr, "kernel_launch: hipFuncSetAttribute failed\n"); grid = -1; return; }
        if (hipOccupancyMaxActiveBlocksPerMultiprocessor(&per_cu, (const void*)fwd_kernel, NWAVES * 64, LDS_BYTES) != hipSuccess || per_cu < 1) fprintf(stderr, "kernel_launch: occupancy query reports %d\n", per_cu);
        (void)hipGetLastError();
        grid = cus;
    }
    if (grid < 0) return;
    (void)hipMemsetAsync((char*)d_ws + WS_CTL, 0, CTL_ZERO_BYTES, stream);
    Args a{};
    for (int i = 0; i < N_INPUTS; ++i) a.in[i] = (const float*)d_in[i];
    a.out = (float*)d_out; a.ws = (unsigned char*)d_ws;
#if MK_ONE_LAUNCH
    a.ph_lo = 0; a.ph_hi = N_PHASES;
    hipLaunchKernelGGL(fwd_kernel, dim3(grid), dim3(NWAVES * 64), LDS_BYTES, stream, a);
#else
    for (int p = 0; p < N_PHASES; ++p) { a.ph_lo = p; a.ph_hi = p + 1; hipLaunchKernelGGL(fwd_kernel, dim3(grid), dim3(NWAVES * 64), LDS_BYTES, stream, a); }
#endif
}
```
